# Optimizing an MI355X kernel written in HIP

```python
import math
import jax, jax.numpy as jnp
from jax import lax
import numpy as np

D_MODEL = 2048
BATCH = 4
SEQ = 8192
DEPTH = 2

N_A_LAYERS = DEPTH // 2
N_B_LAYERS = DEPTH - N_A_LAYERS
MIX_WIDTH = D_MODEL
MEM_SLOTS = 256
MEM_HEADS = 4
MEM_WIDTH = MIX_WIDTH // 4
MEM_HEAD_DIM = MEM_WIDTH // MEM_HEADS
MLSTM_HEADS = 6
MLSTM_DV = (MIX_WIDTH - MEM_WIDTH) // MLSTM_HEADS
MLSTM_DQK = MLSTM_DV // 2
MLSTM_CHUNK = 128
DIFF_HEADS = 12
DIFF_HD = (MIX_WIDTH - MEM_WIDTH) // DIFF_HEADS // 2
DIFF_DV = 2 * DIFF_HD
Q_BLOCK = 128
ROPE_THETA = 10000.0
N_GROUPS = 4
EXPERTS_PER_GROUP = 8
N_EXPERTS = N_GROUPS * EXPERTS_PER_GROUP
TOP_K = 2
D_FF_EXPERT = 1024
MOE_BLOCK = 128
EPS = 1e-6

A_QK = MLSTM_HEADS * MLSTM_DQK
A_V = MLSTM_HEADS * MLSTM_DV
A_IN = 2 * A_QK + 2 * A_V + 2 * MLSTM_HEADS + MEM_WIDTH
A_SPLITS = [A_QK, 2 * A_QK, 2 * A_QK + A_V, 2 * A_QK + 2 * A_V, 2 * A_QK + 2 * A_V + 2 * MLSTM_HEADS]
DIFF_QK = 2 * DIFF_HEADS * DIFF_HD
B_IN = DIFF_QK + MEM_WIDTH
KV_WIDTH = DIFF_QK + DIFF_HEADS * DIFF_DV
A_OUT = A_V + MEM_WIDTH
B_OUT = DIFF_HEADS * DIFF_DV + MEM_WIDTH

kernel_name = "yoco_mlstm_diffattn_hmoe"


def rms_norm(x, w):
    xf = x.astype(jnp.float32)
    y = xf * lax.rsqrt(jnp.mean(xf * xf, axis=-1, keepdims=True) + EPS)
    return (y * w.astype(jnp.float32)).astype(x.dtype)


def rope(t, positions):
    half = t.shape[-1] // 2
    inv_freq = ROPE_THETA ** (-jnp.arange(half, dtype=jnp.float32) / half)
    ang = positions.astype(jnp.float32)[..., None] * inv_freq
    ang = ang.reshape(ang.shape[:2] + (1,) * (t.ndim - 3) + (half,))
    cos, sin = jnp.cos(ang), jnp.sin(ang)
    t1 = t[..., :half].astype(jnp.float32)
    t2 = t[..., half:].astype(jnp.float32)
    return jnp.concatenate([t1 * cos - t2 * sin, t1 * sin + t2 * cos], axis=-1).astype(t.dtype)


def mlstm_chunkwise(q, k, v, i_pre, f_pre):
    B, H, S, DQK = q.shape
    DV = v.shape[-1]
    L = MLSTM_CHUNK
    NC = S // L
    f32 = jnp.float32
    q = q.astype(f32) * (DQK ** -0.5)
    k = k.astype(f32)
    v = v.astype(f32)
    logi = i_pre.astype(f32)
    logf = jax.nn.log_sigmoid(f_pre.astype(f32))

    def to_chunks(t):
        t = t.reshape(t.shape[:2] + (NC, L) + t.shape[3:])
        return jnp.moveaxis(t, 2, 0)

    xs = (to_chunks(q), to_chunks(k), to_chunks(v), to_chunks(logi), to_chunks(logf))
    causal = jnp.tril(jnp.ones((L, L), dtype=bool))

    def step(carry, inp):
        C, n, m = carry
        qj, kj, vj, ij, fj = inp
        b = jnp.cumsum(fj, axis=-1)
        d_log = jnp.where(causal, b[..., :, None] - b[..., None, :] + ij[..., None, :], -jnp.inf)
        inter = b + m[..., None]
        m_t = jnp.maximum(inter, jnp.max(d_log, axis=-1))
        w_intra = jnp.exp(d_log - m_t[..., None])
        w_inter = jnp.exp(inter - m_t)
        s = jnp.einsum('bhtd,bhsd->bhts', qj, kj) * w_intra
        num = jnp.einsum('bhts,bhsv->bhtv', s, vj) + w_inter[..., None] * jnp.einsum('bhtd,bhdv->bhtv', qj, C)
        den = jnp.sum(s, axis=-1) + w_inter * jnp.einsum('bhtd,bhd->bht', qj, n)
        h = num / jnp.maximum(jnp.abs(den), jnp.exp(-m_t))[..., None]
        b_last = b[..., -1]
        st_log = b_last[..., None] - b + ij
        m_new = jnp.maximum(b_last + m, jnp.max(st_log, axis=-1))
        w_st = jnp.exp(st_log - m_new[..., None])
        decay = jnp.exp(b_last + m - m_new)
        C_new = decay[..., None, None] * C + jnp.einsum('bhsd,bhsv->bhdv', kj * w_st[..., None], vj)
        n_new = decay[..., None] * n + jnp.einsum('bhs,bhsd->bhd', w_st, kj)
        return (C_new, n_new, m_new), h

    init = (jnp.zeros((B, H, DQK, DV), f32), jnp.zeros((B, H, DQK), f32), jnp.zeros((B, H), f32))
    _, hs = lax.scan(step, init, xs)
    return jnp.moveaxis(hs, 0, 2).reshape(B, H, S, DV)


def mem_kv(mem, norm_w, w_kv, knorm):
    B, M, _ = mem.shape
    kv = rms_norm(mem, norm_w) @ w_kv
    k, v = jnp.split(kv, [MEM_WIDTH], axis=-1)
    k = rms_norm(k.reshape(B, M, MEM_HEADS, MEM_HEAD_DIM), knorm)
    return k, v.reshape(B, M, MEM_HEADS, MEM_HEAD_DIM)


def mem_attention(mq, mem_k, mem_v, qnorm):
    B, S, _ = mq.shape
    q = rms_norm(mq.reshape(B, S, MEM_HEADS, MEM_HEAD_DIM), qnorm)
    s = jnp.einsum('bshd,bmhd->bhsm', q, mem_k, preferred_element_type=jnp.float32) * (MEM_HEAD_DIM ** -0.5)
    p = jax.nn.softmax(s, axis=-1).astype(mem_v.dtype)
    return jnp.einsum('bhsm,bmhd->bshd', p, mem_v).reshape(B, S, MEM_WIDTH)


def a_mixer(h, mk, mv, w_in, gate_bias, head_norm, mem_qnorm, w_out):
    B, S, _ = h.shape
    q, k, v, o, g, mq = jnp.split(h @ w_in, A_SPLITS, axis=-1)
    g = g.astype(jnp.float32) + gate_bias.astype(jnp.float32)
    i_pre = g[..., :MLSTM_HEADS].transpose(0, 2, 1)
    f_pre = g[..., MLSTM_HEADS:].transpose(0, 2, 1)

    def heads(t, d):
        return t.reshape(B, S, MLSTM_HEADS, d).transpose(0, 2, 1, 3)

    hm = mlstm_chunkwise(heads(q, MLSTM_DQK), heads(k, MLSTM_DQK), heads(v, MLSTM_DV), i_pre, f_pre)
    hm = hm.transpose(0, 2, 1, 3).astype(h.dtype)
    hm = rms_norm(hm, head_norm) * jax.nn.sigmoid(o).reshape(B, S, MLSTM_HEADS, MLSTM_DV)
    mo = mem_attention(mq, mk, mv, mem_qnorm)
    return jnp.concatenate([hm.reshape(B, S, A_V), mo], axis=-1) @ w_out


def shared_kv(x, positions, kv_norm, kv_w, kv_knorm):
    B, S, _ = x.shape
    k, v = jnp.split(rms_norm(x, kv_norm) @ kv_w, [DIFF_QK], axis=-1)
    k = rope(rms_norm(k.reshape(B, S, DIFF_HEADS, 2, DIFF_HD), kv_knorm), positions)
    return k, v.reshape(B, S, DIFF_HEADS, DIFF_DV)


def diff_attention(q, k, v, lam):
    B, S = q.shape[:2]
    nb = S // Q_BLOCK
    qb = jnp.moveaxis(q.reshape((B, nb, Q_BLOCK) + q.shape[2:]), 1, 0)
    kpos = jnp.arange(S)
    scale = DIFF_HD ** -0.5

    def one_block(args):
        qblk, blk = args
        s = jnp.einsum('bqhcd,bkhcd->bhcqk', qblk, k, preferred_element_type=jnp.float32) * scale
        qpos = blk * Q_BLOCK + jnp.arange(Q_BLOCK)
        s = jnp.where(kpos[None, :] <= qpos[:, None], s, -jnp.inf)
        p = jax.nn.softmax(s, axis=-1)
        a = (p[:, :, 0] - lam * p[:, :, 1]).astype(v.dtype)
        return jnp.einsum('bhqk,bkhv->bqhv', a, v)

    out = lax.map(one_block, (qb, jnp.arange(nb)))
    return jnp.moveaxis(out, 0, 1).reshape(B, S, DIFF_HEADS, DIFF_DV)


def b_mixer(h, positions, k_sh, v_sh, mk, mv, w_in, qnorm, lam_vecs, subln, lambda_init, mem_qnorm, w_out):
    B, S, _ = h.shape
    q, mq = jnp.split(h @ w_in, [DIFF_QK], axis=-1)
    q = rope(rms_norm(q.reshape(B, S, DIFF_HEADS, 2, DIFF_HD), qnorm), positions)
    lv = lam_vecs.astype(jnp.float32)
    lam = jnp.exp(jnp.sum(lv[0] * lv[1])) - jnp.exp(jnp.sum(lv[2] * lv[3])) + lambda_init
    o = diff_attention(q, k_sh, v_sh, lam)
    o = rms_norm(o, subln) * (1.0 - lambda_init)
    mo = mem_attention(mq, mk, mv, mem_qnorm)
    return jnp.concatenate([o.reshape(B, S, DIFF_HEADS * DIFF_DV), mo], axis=-1) @ w_out


def hier_moe(h, w_group, b_group, w_expert, b_expert, w_gate, w_up, w_down):
    B, S, D = h.shape
    T = B * S
    xt = h.reshape(T, D)
    g_prob = jax.nn.softmax(jnp.dot(xt, w_group, preferred_element_type=jnp.float32) + b_group, axis=-1)
    g_w, g_idx = lax.top_k(g_prob, 1)
    e_logits = (jnp.dot(xt, w_expert, preferred_element_type=jnp.float32) + b_expert).reshape(T, N_GROUPS, EXPERTS_PER_GROUP)
    e_logits = e_logits[jnp.arange(T), g_idx[:, 0]]
    e_w, e_idx = lax.top_k(jax.nn.softmax(e_logits, axis=-1), TOP_K)
    e_w = e_w / jnp.sum(e_w, axis=-1, keepdims=True)
    weights = (g_w * e_w).reshape(-1)
    eid = (g_idx * EXPERTS_PER_GROUP + e_idx).reshape(-1)
    A = T * TOP_K
    tok = jnp.repeat(jnp.arange(T, dtype=jnp.int32), TOP_K)
    order = jnp.argsort(eid)
    eid_s = eid[order]
    counts = jnp.bincount(eid, length=N_EXPERTS)
    padded = (counts + MOE_BLOCK - 1) // MOE_BLOCK * MOE_BLOCK
    start = jnp.cumsum(counts) - counts
    pend = jnp.cumsum(padded)
    pstart = pend - padded
    dest = pstart[eid_s] + jnp.arange(A) - start[eid_s]
    n_blocks = -(-A // MOE_BLOCK) + N_EXPERTS
    P = n_blocks * MOE_BLOCK
    tok_buf = jnp.full((P,), T, jnp.int32).at[dest].set(tok[order])
    wt_buf = jnp.zeros((P,), jnp.float32).at[dest].set(weights[order])
    blk_exp = jnp.minimum(jnp.searchsorted(pend, jnp.arange(n_blocks) * MOE_BLOCK, side='right'), N_EXPERTS - 1)
    x_pad = jnp.concatenate([xt, jnp.zeros((1, D), xt.dtype)], axis=0)

    def expert_block(args):
        idx, wt, e = args
        xb = x_pad[idx]
        a = jax.nn.silu(xb @ w_gate[e]) * (xb @ w_up[e])
        return ((a @ w_down[e]).astype(jnp.float32) * wt[:, None]).astype(xt.dtype)

    yb = lax.map(expert_block, (tok_buf.reshape(n_blocks, MOE_BLOCK), wt_buf.reshape(n_blocks, MOE_BLOCK), blk_exp))
    dest_unsorted = jnp.zeros((A,), dest.dtype).at[order].set(dest)
    out = yb.reshape(P, D)[dest_unsorted].reshape(T, TOP_K, D).sum(axis=1)
    return out.reshape(B, S, D)


def setup_inputs(seed: int = 0) -> dict:
    key = jax.random.key(seed)
    ks = iter(jax.random.split(key, 40))
    f32 = jnp.float32

    def nrm(shape, scale):
        return scale * jax.random.normal(next(ks), shape, f32)

    def gain(shape):
        return 1.0 + 0.02 * jax.random.normal(next(ks), shape, f32)

    x = nrm((BATCH, SEQ, D_MODEL), 1.0)
    mem = nrm((BATCH, MEM_SLOTS, D_MODEL), 1.0)
    offset = jax.random.randint(next(ks), (BATCH, 1), 0, 1024, dtype=jnp.int32)
    positions = offset + jnp.arange(SEQ, dtype=jnp.int32)[None, :]
    gate_bias = jnp.concatenate([
        nrm((N_A_LAYERS, MLSTM_HEADS), 0.1),
        jnp.linspace(3.0, 6.0, MLSTM_HEADS, dtype=f32)[None, :] + nrm((N_A_LAYERS, MLSTM_HEADS), 0.01)], axis=-1)
    return {
        "x": x,
        "mem": mem,
        "positions": positions,
        "attn_norm": gain((DEPTH, D_MODEL)),
        "mem_norm": gain((DEPTH, D_MODEL)),
        "mem_w_kv": nrm((DEPTH, D_MODEL, 2 * MEM_WIDTH), D_MODEL ** -0.5),
        "mem_qnorm": gain((DEPTH, MEM_HEAD_DIM)),
        "mem_knorm": gain((DEPTH, MEM_HEAD_DIM)),
        "a_w_in": nrm((N_A_LAYERS, D_MODEL, A_IN), D_MODEL ** -0.5),
        "a_gate_bias": gate_bias,
        "a_head_norm": gain((N_A_LAYERS, MLSTM_HEADS, MLSTM_DV)),
        "a_w_out": nrm((N_A_LAYERS, A_OUT, D_MODEL), A_OUT ** -0.5),
        "kv_norm": gain((D_MODEL,)),
        "kv_w": nrm((D_MODEL, KV_WIDTH), D_MODEL ** -0.5),
        "kv_knorm": gain((DIFF_HD,)),
        "b_w_in": nrm((N_B_LAYERS, D_MODEL, B_IN), D_MODEL ** -0.5),
        "b_qnorm": gain((N_B_LAYERS, DIFF_HD)),
        "b_lambda": nrm((N_B_LAYERS, 4, DIFF_HD), 0.1),
        "b_subln": gain((N_B_LAYERS, DIFF_DV)),
        "b_w_out": nrm((N_B_LAYERS, B_OUT, D_MODEL), B_OUT ** -0.5),
        "ffn_norm": gain((DEPTH, D_MODEL)),
        "moe_w_group": nrm((DEPTH, D_MODEL, N_GROUPS), D_MODEL ** -0.5),
        "moe_b_group": nrm((DEPTH, N_GROUPS), 0.01),
        "moe_w_expert": nrm((DEPTH, D_MODEL, N_EXPERTS), D_MODEL ** -0.5),
        "moe_b_expert": nrm((DEPTH, N_EXPERTS), 0.01),
        "moe_w_gate": nrm((DEPTH, N_EXPERTS, D_MODEL, D_FF_EXPERT), D_MODEL ** -0.5),
        "moe_w_up": nrm((DEPTH, N_EXPERTS, D_MODEL, D_FF_EXPERT), D_MODEL ** -0.5),
        "moe_w_down": nrm((DEPTH, N_EXPERTS, D_FF_EXPERT, D_MODEL), D_FF_EXPERT ** -0.5),
    }


def reference(x, mem, positions, attn_norm, mem_norm, mem_w_kv, mem_qnorm, mem_knorm,
              a_w_in, a_gate_bias, a_head_norm, a_w_out, kv_norm, kv_w, kv_knorm,
              b_w_in, b_qnorm, b_lambda, b_subln, b_w_out, ffn_norm,
              moe_w_group, moe_b_group, moe_w_expert, moe_b_expert, moe_w_gate, moe_w_up, moe_w_down):
    k_sh = None
    v_sh = None
    for l in range(DEPTH):
        h = rms_norm(x, attn_norm[l])
        mk, mv = mem_kv(mem, mem_norm[l], mem_w_kv[l], mem_knorm[l])
        if l < N_A_LAYERS:
            x = x + a_mixer(h, mk, mv, a_w_in[l], a_gate_bias[l], a_head_norm[l], mem_qnorm[l], a_w_out[l])
        else:
            j = l - N_A_LAYERS
            lambda_init = 0.8 - 0.6 * math.exp(-0.3 * l)
            x = x + b_mixer(h, positions, k_sh, v_sh, mk, mv, b_w_in[j], b_qnorm[j], b_lambda[j],
                            b_subln[j], lambda_init, mem_qnorm[l], b_w_out[j])
        x = x + hier_moe(rms_norm(x, ffn_norm[l]), moe_w_group[l], moe_b_group[l], moe_w_expert[l],
                         moe_b_expert[l], moe_w_gate[l], moe_w_up[l], moe_w_down[l])
        if l == N_A_LAYERS - 1:
            k_sh, v_sh = shared_kv(x, positions, kv_norm, kv_w, kv_knorm)
    return x
```

```cpp
#include <hip/hip_runtime.h>
#include <cstdio>
#include <cstdint>

#define LAS __attribute__((address_space(3)))
#define GAS __attribute__((address_space(1)))
typedef unsigned short bf16_t;
typedef short bf16x8 __attribute__((ext_vector_type(8)));
typedef short s16x4 __attribute__((ext_vector_type(4)));
typedef float f32x4 __attribute__((ext_vector_type(4)));
typedef float f32x2 __attribute__((ext_vector_type(2)));
typedef float f32x16 __attribute__((ext_vector_type(16)));
typedef unsigned u32x4 __attribute__((ext_vector_type(4)));
typedef unsigned u32x2 __attribute__((ext_vector_type(2)));
typedef __bf16 bf16x2_t __attribute__((ext_vector_type(2)));

constexpr int T = 32768, D = 2048, NB = 4, SEQ = 8192;
constexpr int MEMS = 256, MEMH = 4, MEMW = 512, MEMHD = 128;
constexpr int LH = 6, LDV = 256, LDQK = 128, LCH = 128, LNC = 64;
constexpr int DH = 12, DHD = 64, DDV = 128;
constexpr int NE = 32, NG = 4, EPG = 8, DFF = 1024;
constexpr float EPS = 1e-6f;
constexpr int A_IN = 5132;
constexpr int NA = 5120;
constexpr int NL1 = 5120;
constexpr int MAXSLOT = 73728;
constexpr float LAMBDA_INIT = 0.35550906759310784f;
constexpr float LOG2E = 1.4426950408889634f;

constexpr size_t MiB = 1u << 20;
constexpr size_t WS_CTL = 0, CTL_BYTES = 1 * MiB;
constexpr size_t WS_RSTD = 1 * MiB;
constexpr size_t WS_GATES = 2 * MiB;
constexpr size_t WS_ROPE = 4 * MiB;
constexpr size_t WS_MEMKV = 12 * MiB;
constexpr size_t WS_MISC = 20 * MiB;
constexpr size_t WS_LIST = 23 * MiB;
constexpr size_t WS_MEMB = 36 * MiB;
constexpr size_t WS_WINA = 40 * MiB;
constexpr size_t WS_WOUTA = 60 * MiB;
constexpr size_t WS_WL1 = 68 * MiB;
constexpr size_t WS_WOUTB = 88 * MiB;
constexpr size_t WS_WMEM = 96 * MiB;
constexpr size_t WS_WGU = 104 * MiB;
constexpr size_t WS_WD = 616 * MiB;
constexpr size_t WS_S0 = 872 * MiB;
constexpr size_t WS_S1 = 1002 * MiB;
constexpr size_t WS_S2 = 1132 * MiB;
constexpr size_t WS_BIG = 1262 * MiB;
constexpr size_t WS_END = 1774 * MiB;
constexpr size_t BG_QN = 0, BG_KN = 48 * MiB, BG_VT = 96 * MiB, BG_ON = 192 * MiB, BG_MQ = 288 * MiB, BG_DCT = 320 * MiB, BG_CT = 416 * MiB;
constexpr size_t BG_ACT = 0, BG_YB = 144 * MiB;
constexpr size_t BG_KR = 0, BG_VN = 96 * MiB, BG_QR = 192 * MiB, BG_MQ2 = 288 * MiB, BG_O1 = 320 * MiB, BG_O2 = 416 * MiB;
constexpr size_t MS_RSTDMEM = 0;
constexpr size_t MS_BL = 8192, MS_ML = 8192 + 6144, MS_MST = 8192 + 2 * 6144;
constexpr size_t MS_DN = 32768;
constexpr size_t MS_NST = 32768 + 786432;
constexpr size_t MS_WR = 32768 + 2 * 786432;
constexpr size_t MS_WG = MS_WR + 786432;
static_assert(MS_WG + 131072 <= 3 * MiB, "misc");
constexpr int CW_BAR = 4096;
constexpr int CW_CNT = 16384;

constexpr int LDS_BYTES = 147456;
constexpr int MISC_OFF = 147456 - 1024;

__device__ __forceinline__ unsigned cvtpk(float lo, float hi) { f32x2 v = {lo, hi}; bf16x2_t b = __builtin_convertvector(v, bf16x2_t); return __builtin_bit_cast(unsigned, b); }
__device__ __forceinline__ float bf2f(unsigned short b) { return __uint_as_float(((unsigned)b) << 16); }
__device__ __forceinline__ float bflo(unsigned w) { return __uint_as_float(w << 16); }
__device__ __forceinline__ float bfhi(unsigned w) { return __uint_as_float(w & 0xffff0000u); }
__device__ __forceinline__ unsigned short f2bf(float f) { return (unsigned short)(cvtpk(f, 0.f) & 0xffffu); }
__device__ __forceinline__ float wave_sum(float v) {
#pragma unroll
    for (int o = 1; o < 64; o <<= 1) v += __shfl_xor(v, o);
    return v;
}
#define LDS_WAIT() asm volatile("s_waitcnt lgkmcnt(0)" ::: "memory")
#define VM_WAIT() asm volatile("s_waitcnt vmcnt(0)" ::: "memory")

#define XB_TMO      128
#define XB_XCNT(j)  (256  + 64 * (j))
#define XB_XSUB(j)  (1280 + 64 * (j))
#define XB_XGEN(j)  (2304 + 64 * (j))
#define XB_TOP      3328
#define XB_TOPGEN   3392
#define XCD_BAR_WORDS 3456
#define XB_SPIN_CAP (1u << 18)
__device__ __forceinline__ unsigned xb_ld(unsigned* p)              { return __hip_atomic_load(p, __ATOMIC_RELAXED, __HIP_MEMORY_SCOPE_AGENT); }
__device__ __forceinline__ unsigned xb_add(unsigned* p, unsigned v) { return __hip_atomic_fetch_add(p, v, __ATOMIC_RELAXED, __HIP_MEMORY_SCOPE_AGENT); }
__device__ __forceinline__ unsigned xb_xcc_id() { return (unsigned)__builtin_amdgcn_s_getreg((3 << 11) | 20) & 0xFu; }
#define XB_SPIN(cond, bar) do { unsigned _sp = 0; while (cond) { __builtin_amdgcn_s_sleep(1); \
    if ((++_sp & 255u) == 0u) { if (xb_ld(&(bar)[XB_TMO])) break; if (_sp > XB_SPIN_CAP) { atomicAdd(&(bar)[XB_TMO], 1u); break; } } } } while (0)
struct XcdBarrier { unsigned* bar; unsigned x; volatile LAS unsigned* st; };
__device__ __forceinline__ XcdBarrier xcd_barrier_post(unsigned* bar, volatile LAS unsigned* st) {
    XcdBarrier b; b.bar = bar; b.x = xb_xcc_id(); b.st = st;
    if (threadIdx.x == 0) (void)xb_add(&bar[XB_XCNT(b.x)], 1u);
    return b;
}
__device__ __forceinline__ void xcd_barrier_complete(unsigned* bar, unsigned x, unsigned& nloc, unsigned& nx) {
    const unsigned G = gridDim.x * gridDim.y * gridDim.z;
    unsigned sum, cnt, mine, sp = 0u;
    for (;;) {
        sum = 0u; cnt = 0u; mine = 0u;
#pragma unroll
        for (unsigned j = 0; j < 16; ++j) { const unsigned c = xb_ld(&bar[XB_XCNT(j)]); sum += c; cnt += (c > 0u) ? 1u : 0u; mine = (j == x) ? c : mine; }
        if (sum == G) break;
        __builtin_amdgcn_s_sleep(1);
        if ((++sp & 255u) == 0u) { if (xb_ld(&bar[XB_TMO])) break; if (sp > XB_SPIN_CAP) { atomicAdd(&bar[XB_TMO], 1u); break; } }
    }
    nloc = mine > 0u ? mine : 1u; nx = cnt > 0u ? cnt : 1u;
}
__device__ __forceinline__ void xcd_barrier(const XcdBarrier& b) {
    asm volatile("s_waitcnt vmcnt(0)" ::: "memory");
    __syncthreads();
    if (threadIdx.x == 0) {
        unsigned* bar = b.bar;
        __builtin_amdgcn_s_waitcnt(0);
        unsigned nloc = b.st[0], nx = b.st[1];
        if (nloc == 0u) { xcd_barrier_complete(bar, b.x, nloc, nx); b.st[0] = nloc; b.st[1] = nx; }
        const unsigned old = xb_add(&bar[XB_XSUB(b.x)], 1u);
        const unsigned gen = old / nloc;
        if (old + 1u == (gen + 1u) * nloc) {
            __builtin_amdgcn_fence(__ATOMIC_RELEASE, "agent");
            asm volatile("s_waitcnt vmcnt(0)" ::: "memory");
            const unsigned og = xb_add(&bar[XB_TOP], 1u);
            const unsigned tg = og / nx;
            if (og + 1u == (tg + 1u) * nx) xb_add(&bar[XB_TOPGEN], 1u);
            else XB_SPIN(xb_ld(&bar[XB_TOPGEN]) == tg, bar);
            __builtin_amdgcn_fence(__ATOMIC_ACQUIRE, "agent");
            xb_add(&bar[XB_XGEN(b.x)], 1u);
            asm volatile("s_waitcnt vmcnt(0)" ::: "memory");
        } else {
            XB_SPIN(xb_ld(&bar[XB_XGEN(b.x)]) == gen, bar);
            __builtin_amdgcn_fence(__ATOMIC_ACQUIRE, "agent");
            asm volatile("s_waitcnt vmcnt(0)" ::: "memory");
        }
    }
    __syncthreads();
}
namespace gm {
constexpr int BM = 256, BK = 64, HALF = 128, HTB = HALF * BK * 2, STAGE_BYTES = 8 * HTB, NXCD = 8, WGM = 8;
__host__ __device__ __forceinline__ int lds_byte(int r, int c) { const int st = (r >> 4) * 2 + (c >> 5), rr = r & 15, cc = c & 31, ob = rr * 64 + cc * 2; return st * 1024 + (ob ^ (((ob >> 9) & 1) << 5)); }
__host__ __device__ __forceinline__ void stage_rc(int b, int& R, int& C) { const int st = b / 1024, sb = b % 1024, swz = sb ^ (((sb >> 9) & 1) << 5); R = (st >> 1) * 16 + swz / 64; C = (st & 1) * 32 + (swz % 64) / 2; }
__host__ __device__ __forceinline__ int perm32(int rho) { const int n = rho >> 4, i = rho & 15; return 8 * (i >> 2) + 4 * n + (i & 3); }

struct Unit { const char* a; const char* b; int pm, pn, e, x; };

struct Order {
    int nM, nN, nwg, G, c; unsigned* tk; LAS int* slot;
    __device__ __forceinline__ void init(int nM_, int nN_, int G_, int c_, unsigned* tk_ = nullptr, LAS int* slot_ = nullptr) { nM = nM_; nN = nN_; nwg = nM * nN; G = G_; c = c_; tk = tk_; slot = slot_; }
    __device__ __forceinline__ long pick(int i) const {
        long L = (long)i * G + c;
        if (tk) {
            if (i >= 2) L = slot[i & 1];
            if (i >= 1 && threadIdx.x == 0) { int v = nwg;
#pragma unroll 1
                for (int j = 0; j < 8 && v >= nwg; ++j) { const int lb = (c + j) & 7; const unsigned t = __hip_atomic_fetch_add(tk + lb * 64, 1u, __ATOMIC_RELAXED, __HIP_MEMORY_SCOPE_AGENT); v = 2 * G + 8 * (int)t + lb; }
                slot[(i + 1) & 1] = v; }
        }
        return L;
    }
    __device__ __forceinline__ bool get(int i, int& pm, int& pn) const {
        const long L = pick(i); if (L >= nwg) return false;
        int wgid = (int)L; { const int q = nwg / NXCD, r = nwg % NXCD, xcd = wgid % NXCD, off = wgid / NXCD; wgid = (xcd < r ? xcd * (q + 1) : r * (q + 1) + (xcd - r) * q) + off; }
        const int nig = WGM * nN, gid = wgid / nig, fm = gid * WGM, gsz = (nM - fm) < WGM ? (nM - fm) : WGM;
        pm = fm + ((wgid % nig) % gsz); pn = (wgid % nig) / gsz; return true;
    }
};

template <class P>
__device__ __forceinline__ void gemm_phase(LAS unsigned char* lds, const P& p) {
    const int tid = threadIdx.x, wid = __builtin_amdgcn_readfirstlane(tid >> 6), lane = tid & 63, wr = wid >> 2, wc = wid & 3, fr = lane & 15, fq = lane >> 4;
    constexpr int K = P::K, nt = K / BK;
    unsigned voffA[2], voffB[2];
#pragma unroll
    for (int i = 0; i < 2; ++i) { int R, C; stage_rc(tid * 16 + i * 8192, R, C); const int Rb = (R & ~31) + perm32(R & 31);
        voffA[i] = (unsigned)(R * K + C) * 2u; voffB[i] = (unsigned)(Rb * K + C) * 2u; }
    constexpr size_t kstep = (size_t)(BK * 2);
    constexpr size_t hstep = (size_t)HALF * K * 2;
    const unsigned ldsw = (unsigned)wid * 1024u;
    const int aoff = lds_byte(wr * 64 + fr, fq * 8), boff = lds_byte(wc * 32 + fr, fq * 8);
#define GM_SA(b, h) (((b) * 2 + (h)) * HTB)
#define GM_SB(b, h) ((4 + (b) * 2 + (h)) * HTB)
#define GM_STAGE_B(bufoff, kbase, h) do { const char* _g = (kbase) + (size_t)(h) * hstep; _Pragma("unroll") for (int _i = 0; _i < 2; ++_i) \
        __builtin_amdgcn_global_load_lds((const unsigned*)(_g + voffB[_i]), (LAS unsigned*)(lds + (bufoff) + ldsw + _i * 8192), 16, 0, 0); } while (0)
#define GM_STAGE_A(bufoff, kbase, h, VV) do { const char* _g = (kbase) + (P::GATHER ? (size_t)0 : (size_t)(h) * hstep); _Pragma("unroll") for (int _i = 0; _i < 2; ++_i) { \
        const unsigned _o = P::GATHER ? VV[h][_i] : voffA[_i]; \
        __builtin_amdgcn_global_load_lds((const unsigned*)(_g + _o), (LAS unsigned*)(lds + (bufoff) + ldsw + _i * 8192), 16, 0, 0); } } while (0)
#define GM_LDA(dst, b, h) do { _Pragma("unroll") for (int m = 0; m < 4; ++m) _Pragma("unroll") for (int k = 0; k < 2; ++k) dst[m][k] = *(const LAS bf16x8*)(lds + GM_SA(b, h) + aoff + m * 2048 + k * 1024); } while (0)
#define GM_LDB(dst, b, h) do { _Pragma("unroll") for (int n = 0; n < 2; ++n) _Pragma("unroll") for (int k = 0; k < 2; ++k) dst[n][k] = *(const LAS bf16x8*)(lds + GM_SB(b, h) + boff + n * 2048 + k * 1024); } while (0)
#define GM_MMA(ai, bj, At, Bt) do { __builtin_amdgcn_s_setprio(1); _Pragma("unroll") for (int k = 0; k < 2; ++k) _Pragma("unroll") for (int m = 0; m < 4; ++m) _Pragma("unroll") for (int n = 0; n < 2; ++n) \
        acc[ai][bj][m][n] = __builtin_amdgcn_mfma_f32_16x16x32_bf16(Bt[n][k], At[m][k], acc[ai][bj][m][n], 0, 0, 0); __builtin_amdgcn_s_setprio(0); } while (0)
#define GM_WAIT_V(n) asm volatile("s_waitcnt vmcnt(" #n ")" ::: "memory")
#define GM_WAIT_L(n) asm volatile("s_waitcnt lgkmcnt(" #n ")" ::: "memory")
#define GM_BAR __builtin_amdgcn_s_barrier()
#define GM_SCHED __builtin_amdgcn_sched_barrier(0)
#define GM_GATHER_LOAD(VV, U) do { _Pragma("unroll") for (int _h = 0; _h < 2; ++_h) _Pragma("unroll") for (int _i = 0; _i < 2; ++_i) { int R, C; stage_rc(tid * 16 + _i * 8192, R, C); \
        VV[_h][_i] = p.row_off(U, _h * HALF + R) + (unsigned)C * 2u; } GM_WAIT_V(0); } while (0)
    Unit cur, nxt; int ui = 0;
    if (!p.next(0, cur)) return;
    f32x4 acc[2][2][4][2];
#pragma unroll
    for (int a = 0; a < 2; ++a)
#pragma unroll
        for (int b = 0; b < 2; ++b)
#pragma unroll
            for (int m = 0; m < 4; ++m)
#pragma unroll
                for (int n = 0; n < 2; ++n) acc[a][b][m][n] = (f32x4){0.f, 0.f, 0.f, 0.f};
    bf16x8 At[4][2], B0[2][2], B1[2][2];
    const char* cA = cur.a; const char* cB = cur.b;
    unsigned vC[2][2] = {{0u, 0u}, {0u, 0u}};
    if constexpr (P::GATHER) { GM_GATHER_LOAD(vC, cur); }
    GM_STAGE_B(GM_SB(0, 0), cB, 0); GM_STAGE_B(GM_SB(0, 1), cB, 1); GM_STAGE_A(GM_SA(0, 0), cA, 0, vC); GM_STAGE_A(GM_SA(0, 1), cA, 1, vC);
    if (wr == 1) GM_BAR;
    GM_WAIT_V(2); GM_BAR;
    GM_STAGE_B(GM_SB(1, 0), cB + kstep, 0); GM_STAGE_A(GM_SA(1, 0), cA + kstep, 0, vC); GM_STAGE_B(GM_SB(1, 1), cB + kstep, 1);
    GM_WAIT_V(6); GM_BAR;
    for (;;) {
        const bool has_next = p.next(ui + 1, nxt);
        const char* nA = has_next ? nxt.a : cA; const char* nB = has_next ? nxt.b : cB;
#pragma unroll 1
        for (int t = 0; t < nt; t += 2) {
            const bool last = (t == nt - 2);
            const char* a1 = cA + (size_t)(t + 1) * kstep;
            const char* a2 = last ? nA : cA + (size_t)(t + 2) * kstep; const char* b2 = last ? nB : cB + (size_t)(t + 2) * kstep;
            const char* a3 = a2 + kstep; const char* b3 = b2 + kstep;
            GM_LDB(B0, 0, 0); GM_LDB(B1, 0, 1); GM_SCHED; GM_LDA(At, 0, 0); GM_STAGE_A(GM_SA(1, 1), a1, 1, vC);
            if constexpr (P::GATHER) { if (last && has_next) { GM_GATHER_LOAD(vC, nxt); } }
            GM_WAIT_V(8); GM_WAIT_L(0); GM_BAR; GM_MMA(0, 0, At, B0); GM_MMA(0, 1, At, B1); GM_BAR; GM_SCHED;
            GM_LDA(At, 0, 1); GM_STAGE_B(GM_SB(0, 0), b2, 0); GM_STAGE_B(GM_SB(0, 1), b2, 1); GM_STAGE_A(GM_SA(0, 0), a2, 0, vC);
            GM_WAIT_V(8); GM_WAIT_L(0); GM_BAR; GM_MMA(1, 0, At, B0); GM_MMA(1, 1, At, B1); GM_BAR; GM_SCHED;
            GM_LDB(B0, 1, 0); GM_LDB(B1, 1, 1); GM_SCHED; GM_LDA(At, 1, 0); GM_STAGE_A(GM_SA(0, 1), a2, 1, vC);
            GM_WAIT_V(8); GM_WAIT_L(0); GM_BAR; GM_MMA(0, 0, At, B0); GM_MMA(0, 1, At, B1); GM_BAR; GM_SCHED;
            GM_LDA(At, 1, 1); GM_STAGE_B(GM_SB(1, 0), b3, 0); GM_STAGE_B(GM_SB(1, 1), b3, 1); GM_STAGE_A(GM_SA(1, 0), a3, 0, vC);
            GM_WAIT_V(8); GM_WAIT_L(0); GM_BAR; GM_MMA(1, 0, At, B0); GM_MMA(1, 1, At, B1); GM_BAR; GM_SCHED;
        }
        if (wr == 0) GM_BAR;
        { int tz = threadIdx.x; asm volatile("" : "+v"(tz)); const int w2 = tz >> 6, l2 = tz & 63;
          p.epi(acc, cur, w2 >> 2, w2 & 3, l2 & 15, l2 >> 4); }
        if (!has_next) break;
#pragma unroll
        for (int a = 0; a < 2; ++a)
#pragma unroll
            for (int b = 0; b < 2; ++b)
#pragma unroll
                for (int m = 0; m < 4; ++m)
#pragma unroll
                    for (int n = 0; n < 2; ++n) acc[a][b][m][n] = (f32x4){0.f, 0.f, 0.f, 0.f};
        cur = nxt; cA = nA; cB = nB; ++ui;
        if (wr == 1) GM_BAR;
    }
    GM_WAIT_V(0);
    GM_BAR;
#undef GM_SA
#undef GM_SB
#undef GM_STAGE_A
#undef GM_STAGE_B
#undef GM_LDA
#undef GM_LDB
#undef GM_MMA
#undef GM_WAIT_V
#undef GM_WAIT_L
#undef GM_BAR
#undef GM_SCHED
#undef GM_GATHER_LOAD
}

__device__ __forceinline__ void store_tile_bf16(const f32x4 (&acc)[2][2][4][2], bf16_t* obase, size_t ldc, const float* rowscale, const float* colscale, bool act, int wr, int wc, int fr, int fq) {
    f32x4 cs[2][2];
#pragma unroll
    for (int bj = 0; bj < 2; ++bj)
#pragma unroll
        for (int n = 0; n < 2; ++n) cs[bj][n] = colscale ? *(const f32x4*)(colscale + bj * HALF + wc * 32 + 8 * fq + 4 * n) : (f32x4){1.f, 1.f, 1.f, 1.f};
    float rs8[8];
#pragma unroll
    for (int i = 0; i < 8; ++i) rs8[i] = rowscale ? rowscale[(i >> 2) * HALF + wr * 64 + (i & 3) * 16 + fr] : 1.f;
#pragma unroll
    for (int ai = 0; ai < 2; ++ai)
#pragma unroll
        for (int m = 0; m < 4; ++m) {
            const int r = ai * HALF + wr * 64 + m * 16 + fr; const float rs = rs8[ai * 4 + m];
            bf16_t* rowp = obase + (size_t)r * ldc + wc * 32 + 8 * fq;
#pragma unroll
            for (int bj = 0; bj < 2; ++bj) {
                f32x4 v0 = acc[ai][bj][m][0] * cs[bj][0] * rs, v1 = acc[ai][bj][m][1] * cs[bj][1] * rs;
                if (act) {
#pragma unroll
                    for (int j = 0; j < 4; ++j) { v0[j] = __builtin_amdgcn_rcpf(1.f + __builtin_amdgcn_exp2f(-LOG2E * v0[j])); v1[j] = __builtin_amdgcn_rcpf(1.f + __builtin_amdgcn_exp2f(-LOG2E * v1[j])); } }
                u32x4 w; w.x = cvtpk(v0[0], v0[1]); w.y = cvtpk(v0[2], v0[3]); w.z = cvtpk(v1[0], v1[1]); w.w = cvtpk(v1[2], v1[3]);
                *(u32x4*)(rowp + bj * HALF) = w; }
            asm volatile("" ::: "memory");
        }
}
}
namespace gm {
typedef int v8i_t __attribute__((ext_vector_type(8)));
__host__ __device__ __forceinline__ int perm32b(int rho) { return 16 * ((rho >> 2) & 1) + 4 * (rho >> 3) + (rho & 3); }
__host__ __device__ __forceinline__ int lds_byte8(int r, int c) { const int st = (r >> 4) * 2 + (c >> 5), rr = r & 15, cc = c & 31, ob = rr * 64 + cc * 2; return st * 1024 + (ob ^ (((ob >> 8) & 3) << 4)); }
__host__ __device__ __forceinline__ void stage_rc8(int b, int& R, int& C) { const int st = b / 1024, sb = b % 1024, swz = sb ^ (((sb >> 8) & 3) << 4); R = (st >> 1) * 16 + swz / 64; C = (st & 1) * 32 + (swz % 64) / 2; }
template <class P>
__device__ __forceinline__ void gemm_phase8(LAS unsigned char* lds, const P& p) {
    const int tid = threadIdx.x, wid = __builtin_amdgcn_readfirstlane(tid >> 6), lane = tid & 63, wr = wid >> 2, wc = wid & 3;
    constexpr int K = P::K, nt = K / BK;
    unsigned voffA[2], voffB[2];
#pragma unroll
    for (int i = 0; i < 2; ++i) { int R, C; stage_rc8(tid * 16 + i * 8192, R, C); const int Rb = (R & ~31) + perm32b(R & 31);
        voffA[i] = (unsigned)(R * K + C) * 2u; voffB[i] = (unsigned)(Rb * K + C) * 2u; }
    constexpr size_t kstep = (size_t)(BK * 2);
    constexpr size_t hstep = (size_t)HALF * K * 2;
    const unsigned ldsw = (unsigned)wid * 1024u;
    const int aoff = lds_byte8(wr * 64 + (lane & 31), 16 * (lane >> 5)), boff = lds_byte8(wc * 32 + (lane & 31), 16 * (lane >> 5));
#define GM_SA(b, h) (((b) * 2 + (h)) * HTB)
#define GM_SB(b, h) ((4 + (b) * 2 + (h)) * HTB)
#define GM_STAGE_B(bufoff, kbase, h) do { const char* _g = (kbase) + (size_t)(h) * hstep; _Pragma("unroll") for (int _i = 0; _i < 2; ++_i) \
        __builtin_amdgcn_global_load_lds((const unsigned*)(_g + voffB[_i]), (LAS unsigned*)(lds + (bufoff) + ldsw + _i * 8192), 16, 0, 0); } while (0)
#define GM_STAGE_A(bufoff, kbase, h, VV) do { const char* _g = (kbase) + (P::GATHER ? (size_t)0 : (size_t)(h) * hstep); _Pragma("unroll") for (int _i = 0; _i < 2; ++_i) { \
        const unsigned _o = P::GATHER ? VV[h][_i] : voffA[_i]; \
        __builtin_amdgcn_global_load_lds((const unsigned*)(_g + _o), (LAS unsigned*)(lds + (bufoff) + ldsw + _i * 8192), 16, 0, 0); } } while (0)
#define GM_LDA(dst, b, h) do { _Pragma("unroll") for (int m = 0; m < 4; ++m) _Pragma("unroll") for (int k = 0; k < 2; ++k) dst[m][k] = *(const LAS bf16x8*)(lds + GM_SA(b, h) + (aoff ^ (k * 16)) + (m >> 1) * 4096 + (m & 1) * 1024); } while (0)
#define GM_LDB(dst, b, h) do { _Pragma("unroll") for (int n = 0; n < 2; ++n) _Pragma("unroll") for (int k = 0; k < 2; ++k) dst[n][k] = *(const LAS bf16x8*)(lds + GM_SB(b, h) + (boff ^ (k * 16)) + n * 1024); } while (0)
#define GM_V8(lo, hi) __builtin_bit_cast(v8i_t, __builtin_shufflevector(lo, hi, 0, 1, 2, 3, 4, 5, 6, 7, 8, 9, 10, 11, 12, 13, 14, 15))
#define GM_MMA(ai, bj, At, Bt) do { __builtin_amdgcn_s_setprio(1); _Pragma("unroll") for (int s = 0; s < 2; ++s) _Pragma("unroll") for (int mb = 0; mb < 2; ++mb) \
        acc[ai][bj][mb] = __builtin_amdgcn_mfma_scale_f32_32x32x64_f8f6f4(GM_V8(Bt[s][0], Bt[s][1]), GM_V8(At[mb * 2 + s][0], At[mb * 2 + s][1]), acc[ai][bj][mb], 0, 0, 0, 0x7F7F7F7F, 0, 0x7F7F7F7F); \
        __builtin_amdgcn_s_setprio(0); } while (0)
#define GM_WAIT_V(n) asm volatile("s_waitcnt vmcnt(" #n ")" ::: "memory")
#define GM_WAIT_L(n) asm volatile("s_waitcnt lgkmcnt(" #n ")" ::: "memory")
#define GM_BAR __builtin_amdgcn_s_barrier()
#define GM_SCHED __builtin_amdgcn_sched_barrier(0)
#define GM_GATHER_LOAD(VV, U) do { _Pragma("unroll") for (int _h = 0; _h < 2; ++_h) _Pragma("unroll") for (int _i = 0; _i < 2; ++_i) { int R, C; stage_rc8(tid * 16 + _i * 8192, R, C); \
        VV[_h][_i] = p.row_off(U, _h * HALF + R) + (unsigned)C * 2u; } GM_WAIT_V(0); } while (0)
    Unit cur, nxt; int ui = 0;
    if (!p.next(0, cur)) return;
    f32x16 acc[2][2][2];
#pragma unroll
    for (int a = 0; a < 2; ++a)
#pragma unroll
        for (int b = 0; b < 2; ++b)
#pragma unroll
            for (int m = 0; m < 2; ++m) acc[a][b][m] = f32x16{};
    bf16x8 At[4][2], B0[2][2], B1[2][2];
    const char* cA = cur.a; const char* cB = cur.b;
    unsigned vC[2][2] = {{0u, 0u}, {0u, 0u}};
    if constexpr (P::GATHER) { GM_GATHER_LOAD(vC, cur); }
    GM_STAGE_B(GM_SB(0, 0), cB, 0); GM_STAGE_B(GM_SB(0, 1), cB, 1); GM_STAGE_A(GM_SA(0, 0), cA, 0, vC); GM_STAGE_A(GM_SA(0, 1), cA, 1, vC);
    if (wr == 1) GM_BAR;
    GM_WAIT_V(2); GM_BAR;
    GM_STAGE_B(GM_SB(1, 0), cB + kstep, 0); GM_STAGE_A(GM_SA(1, 0), cA + kstep, 0, vC); GM_STAGE_B(GM_SB(1, 1), cB + kstep, 1);
    GM_WAIT_V(6); GM_BAR;
    for (;;) {
        const bool has_next = p.next(ui + 1, nxt);
        const char* nA = has_next ? nxt.a : cA; const char* nB = has_next ? nxt.b : cB;
#pragma unroll 1
        for (int t = 0; t < nt; t += 2) {
            const bool last = (t == nt - 2);
            const char* a1 = cA + (size_t)(t + 1) * kstep;
            const char* a2 = last ? nA : cA + (size_t)(t + 2) * kstep; const char* b2 = last ? nB : cB + (size_t)(t + 2) * kstep;
            const char* a3 = a2 + kstep; const char* b3 = b2 + kstep;
            GM_LDB(B0, 0, 0); GM_LDB(B1, 0, 1); GM_SCHED; GM_LDA(At, 0, 0); GM_STAGE_A(GM_SA(1, 1), a1, 1, vC);
            if constexpr (P::GATHER) { if (last && has_next) { GM_GATHER_LOAD(vC, nxt); } }
            GM_WAIT_V(8); GM_WAIT_L(0); GM_BAR; GM_MMA(0, 0, At, B0); GM_MMA(0, 1, At, B1); GM_BAR; GM_SCHED;
            GM_LDA(At, 0, 1); GM_STAGE_B(GM_SB(0, 0), b2, 0); GM_STAGE_B(GM_SB(0, 1), b2, 1); GM_STAGE_A(GM_SA(0, 0), a2, 0, vC);
            GM_WAIT_V(8); GM_WAIT_L(0); GM_BAR; GM_MMA(1, 0, At, B0); GM_MMA(1, 1, At, B1); GM_BAR; GM_SCHED;
            GM_LDB(B0, 1, 0); GM_LDB(B1, 1, 1); GM_SCHED; GM_LDA(At, 1, 0); GM_STAGE_A(GM_SA(0, 1), a2, 1, vC);
            GM_WAIT_V(8); GM_WAIT_L(0); GM_BAR; GM_MMA(0, 0, At, B0); GM_MMA(0, 1, At, B1); GM_BAR; GM_SCHED;
            GM_LDA(At, 1, 1); GM_STAGE_B(GM_SB(1, 0), b3, 0); GM_STAGE_B(GM_SB(1, 1), b3, 1); GM_STAGE_A(GM_SA(1, 0), a3, 0, vC);
            GM_WAIT_V(8); GM_WAIT_L(0); GM_BAR; GM_MMA(1, 0, At, B0); GM_MMA(1, 1, At, B1); GM_BAR; GM_SCHED;
        }
        if (wr == 0) GM_BAR;
        { int tz = threadIdx.x; asm volatile("" : "+v"(tz)); const int w2 = tz >> 6, l2 = tz & 63;
          p.epi8(acc, cur, w2 >> 2, w2 & 3, l2 & 31, l2 >> 5); }
        if (!has_next) break;
#pragma unroll
        for (int a = 0; a < 2; ++a)
#pragma unroll
            for (int b = 0; b < 2; ++b)
#pragma unroll
                for (int m = 0; m < 2; ++m) acc[a][b][m] = f32x16{};
        cur = nxt; cA = nA; cB = nB; ++ui;
        if (wr == 1) GM_BAR;
    }
    GM_WAIT_V(0);
    GM_BAR;
#undef GM_SA
#undef GM_SB
#undef GM_STAGE_A
#undef GM_STAGE_B
#undef GM_LDA
#undef GM_LDB
#undef GM_V8
#undef GM_MMA
#undef GM_WAIT_V
#undef GM_WAIT_L
#undef GM_BAR
#undef GM_SCHED
#undef GM_GATHER_LOAD
}
__device__ __forceinline__ unsigned pk_fp8x4(float a, float b, float c, float d) {
    a = fminf(fmaxf(a, -448.f), 448.f); b = fminf(fmaxf(b, -448.f), 448.f); c = fminf(fmaxf(c, -448.f), 448.f); d = fminf(fmaxf(d, -448.f), 448.f);
    int w = 0; w = __builtin_amdgcn_cvt_pk_fp8_f32(a, b, w, false); w = __builtin_amdgcn_cvt_pk_fp8_f32(c, d, w, true); return (unsigned)w;
}
}
typedef __attribute__((address_space(4))) const unsigned long long* karg_t;
typedef __attribute__((address_space(4))) const unsigned long long* karg_t;
struct Ctx {
    karg_t ka;
    float* out; unsigned char* ws;
    LAS unsigned char* lds;
    int tid, lane, wave, G, vcu, bid;
    __device__ __forceinline__ const float* in(int k) const { karg_t p = ka; asm volatile("" : "+s"(p)); return (const float*)(const GAS float*)p[k]; }
};
#define WSP(T_, off) ((T_*)(C.ws + (off)))

struct ProbInA {
    static constexpr bool GATHER = false; static constexpr int K = 2048;
    gm::Order ord; const char* xb; const char* w; unsigned char* big; const float* rstd; int pm0;
    __device__ __forceinline__ bool next(int i, gm::Unit& u) const {
        int pm, pn; if (!ord.get(i, pm, pn)) return false; pm += pm0; u.pm = pm; u.pn = pn; u.e = 0; u.x = 0;
        const bool sw = (pn >= 6 && pn < 12);
        const char* xa = xb + (size_t)pm * 256 * K * 2; const char* wa = w + (size_t)pn * 256 * K * 2;
        u.a = sw ? wa : xa; u.b = sw ? xa : wa; return true;
    }
    __device__ __forceinline__ unsigned row_off(const gm::Unit&, int) const { return 0u; }
    __device__ __forceinline__ void epi(const f32x4 (&acc)[2][2][4][2], const gm::Unit& u, int wr, int wc, int fr, int fq) const {
        const int pm = u.pm, pn = u.pn;
        bf16_t* ob; size_t ldc; const float* rsp = rstd + pm * 256; const float* csp = nullptr; bool act = false;
        if (pn >= 6 && pn < 12) {
            const int b = pm >> 5, hd = pn - 6;
            ob = (bf16_t*)(big + BG_VT) + ((size_t)((b * LH + hd) * LDV)) * SEQ + (size_t)(pm & 31) * 256; ldc = SEQ; csp = rsp; rsp = nullptr;
        } else if (pn < 3) { ob = (bf16_t*)(big + BG_QN) + (size_t)pm * 256 * 768 + pn * 256; ldc = 768; }
        else if (pn < 6) { ob = (bf16_t*)(big + BG_KN) + (size_t)pm * 256 * 768 + (pn - 3) * 256; ldc = 768; }
        else if (pn < 18) { ob = (bf16_t*)(big + BG_ON) + (size_t)pm * 256 * 1536 + (pn - 12) * 256; ldc = 1536; act = true; }
        else { ob = (bf16_t*)(big + BG_MQ) + (size_t)pm * 256 * 512 + (pn - 18) * 256; ldc = 512; }
        gm::store_tile_bf16(acc, ob, ldc, rsp, csp, act, wr, wc, fr, fq);
    }
};
struct ProbMemKV {
    static constexpr bool GATHER = false; static constexpr int K = 2048;
    int G, c; const char* memb; const char* w; float* outp; const float* rstd;
    __device__ __forceinline__ bool next(int i, gm::Unit& u) const {
        const int L = i * G + c; if (L >= 32) return false;
        const int l = L >> 4, pm = (L >> 2) & 3, pn = L & 3; u.pm = pm; u.pn = pn; u.e = l; u.x = 0;
        u.a = memb + (size_t)pm * 256 * K * 2; u.b = w + ((size_t)l * 1024 + pn * 256) * K * 2; return true;
    }
    __device__ __forceinline__ unsigned row_off(const gm::Unit&, int) const { return 0u; }
    __device__ __forceinline__ void epi(const f32x4 (&acc)[2][2][4][2], const gm::Unit& u, int wr, int wc, int fr, int fq) const {
        float* ob = outp + ((size_t)u.e * 1024 + u.pm * 256) * 1024 + u.pn * 256;
        float rs8[8];
#pragma unroll
        for (int i = 0; i < 8; ++i) rs8[i] = rstd[u.pm * 256 + (i >> 2) * 128 + wr * 64 + (i & 3) * 16 + fr];
#pragma unroll
        for (int ai = 0; ai < 2; ++ai)
#pragma unroll
            for (int m = 0; m < 4; ++m) { const int r = ai * 128 + wr * 64 + m * 16 + fr; const float rs = rs8[ai * 4 + m]; float* rowp = ob + (size_t)r * 1024 + wc * 32 + 8 * fq;
#pragma unroll
                for (int bj = 0; bj < 2; ++bj) { *(f32x4*)(rowp + bj * 128) = acc[ai][bj][m][0] * rs; *(f32x4*)(rowp + bj * 128 + 4) = acc[ai][bj][m][1] * rs; } }
    }
};
template <bool RESID_F32> struct ProbOut {
    static constexpr bool GATHER = false; static constexpr int K = 2048;
    gm::Order ord; const char* a; const char* w; const void* resid; bf16_t* outp;
    __device__ __forceinline__ bool next(int i, gm::Unit& u) const {
        int pm, pn; if (!ord.get(i, pm, pn)) return false; u.pm = pm; u.pn = pn; u.e = 0; u.x = 0;
        u.a = a + (size_t)pm * 256 * K * 2; u.b = w + (size_t)pn * 256 * K * 2; return true;
    }
    __device__ __forceinline__ unsigned row_off(const gm::Unit&, int) const { return 0u; }
    __device__ __forceinline__ void epi(const f32x4 (&acc)[2][2][4][2], const gm::Unit& u, int wr, int wc, int fr, int fq) const {
#pragma unroll
        for (int ai = 0; ai < 2; ++ai) {
            const size_t off0 = ((size_t)u.pm * 256 + ai * 128 + wr * 64 + fr) * D + u.pn * 256 + wc * 32 + 8 * fq;
            f32x4 rf[4][2][2]; u32x4 rb[4][2];
#pragma unroll
            for (int m = 0; m < 4; ++m)
#pragma unroll
                for (int bj = 0; bj < 2; ++bj) {
                    if (RESID_F32) { const float* rp = (const float*)resid + off0 + (size_t)m * 16 * D + bj * 128; rf[m][bj][0] = *(const f32x4*)rp; rf[m][bj][1] = *(const f32x4*)(rp + 4); }
                    else rb[m][bj] = *(const u32x4*)((const bf16_t*)resid + off0 + (size_t)m * 16 * D + bj * 128); }
#pragma unroll
            for (int m = 0; m < 4; ++m)
#pragma unroll
                for (int bj = 0; bj < 2; ++bj) {
                    f32x4 v0 = acc[ai][bj][m][0], v1 = acc[ai][bj][m][1];
                    if (RESID_F32) { v0 += rf[m][bj][0]; v1 += rf[m][bj][1]; }
                    else { const u32x4 rw = rb[m][bj]; v0 += (f32x4){bflo(rw.x), bfhi(rw.x), bflo(rw.y), bfhi(rw.y)}; v1 += (f32x4){bflo(rw.z), bfhi(rw.z), bflo(rw.w), bfhi(rw.w)}; }
                    u32x4 w4; w4.x = cvtpk(v0[0], v0[1]); w4.y = cvtpk(v0[2], v0[3]); w4.z = cvtpk(v1[0], v1[1]); w4.w = cvtpk(v1[2], v1[3]);
                    *(u32x4*)(outp + off0 + (size_t)m * 16 * D + bj * 128) = w4; }
            asm volatile("" ::: "memory");
        }
    }
};
__device__ __forceinline__ LAS int* moe_tb(LAS unsigned char* lds) { return (LAS int*)(lds + MISC_OFF + 128); }
__device__ __forceinline__ void moe_tables(const Ctx& C, int layer) {
    LAS int* tb = moe_tb(C.lds);
    if (C.tid < 64) { const unsigned* cw = (const unsigned*)(C.ws + WS_CTL) + CW_CNT + layer * 32 * 64; const int e = C.tid & 31;
        const int c = (int)__hip_atomic_load(cw + e * 64, __ATOMIC_RELAXED, __HIP_MEMORY_SCOPE_AGENT);
        int incl = (c + 255) >> 8;
#pragma unroll
        for (int o = 1; o < 32; o <<= 1) { const int t = __shfl_up(incl, o); if (e >= o) incl += t; }
        if (C.tid < 32) { tb[40 + e] = c; tb[e] = incl - ((c + 255) >> 8); if (e == 31) tb[32] = incl; } }
    __syncthreads();
}
__device__ __forceinline__ bool moe_unit(LAS int* tb, int i, int G, int c, gm::Unit& u) {
    int g, pn;
    if ((G & 63) == 0) { const int x = c & 7, j = c >> 3; g = i * (G >> 3) + x * (G >> 6) + (j >> 3); pn = j & 7; }
    else { const int L = i * G + c; g = L >> 3; pn = L & 7; }
    if (g >= tb[32]) return false;
    int e = 0;
#pragma unroll 1
    for (int k = 16; k >= 1; k >>= 1) if (tb[e + k] <= g) e += k;
    u.e = e; u.x = g - tb[e]; u.pm = g; u.pn = pn; return true;
}
struct ProbGU {
    static constexpr bool GATHER = true; static constexpr int K = 2048;
    int G, c; LAS int* tb; const char* xb; const char* w; const int* ltok; const float* lrs; bf16_t* act;
    __device__ __forceinline__ bool next(int i, gm::Unit& u) const {
        if (!moe_unit(tb, i, G, c, u)) return false;
        u.a = xb; u.b = w + ((size_t)u.e * 2048 + u.pn * 256) * K * 2; return true;
    }
    __device__ __forceinline__ unsigned row_off(const gm::Unit& u, int r) const {
        const int slot = u.x * 256 + r; const int idx = slot < tb[40 + u.e] ? ltok[(size_t)u.e * T + slot] : T; return (unsigned)idx * (unsigned)(K * 2);
    }
    __device__ __forceinline__ void epi(const f32x4 (&acc)[2][2][4][2], const gm::Unit& u, int wr, int wc, int fr, int fq) const {
        const int cnt = tb[40 + u.e];
        float rs8[8];
#pragma unroll
        for (int i = 0; i < 8; ++i) { const int slot = u.x * 256 + (i >> 2) * 128 + wr * 64 + (i & 3) * 16 + fr; rs8[i] = slot < cnt ? lrs[(size_t)u.e * T + slot] : 0.f; }
#pragma unroll
        for (int ai = 0; ai < 2; ++ai)
#pragma unroll
            for (int m = 0; m < 4; ++m) { const int r = ai * 128 + wr * 64 + m * 16 + fr; const float rs = rs8[ai * 4 + m];
                float o[8];
#pragma unroll
                for (int n = 0; n < 2; ++n)
#pragma unroll
                    for (int j = 0; j < 4; ++j) { const float g = acc[ai][0][m][n][j] * rs, uu = acc[ai][1][m][n][j] * rs; o[n * 4 + j] = g * __builtin_amdgcn_rcpf(1.f + __builtin_amdgcn_exp2f(-LOG2E * g)) * uu; }
                u32x4 w4; w4.x = cvtpk(o[0], o[1]); w4.y = cvtpk(o[2], o[3]); w4.z = cvtpk(o[4], o[5]); w4.w = cvtpk(o[6], o[7]);
                *(u32x4*)(act + ((size_t)u.pm * 256 + r) * DFF + u.pn * 128 + wc * 32 + 8 * fq) = w4; asm volatile("" ::: "memory"); }
    }
};
struct ProbDown {
    static constexpr bool GATHER = false; static constexpr int K = 1024;
    int G, c; LAS int* tb; const char* act; const char* w; const float* lw; bf16_t* yb;
    __device__ __forceinline__ bool next(int i, gm::Unit& u) const {
        if (!moe_unit(tb, i, G, c, u)) return false;
        u.a = act + (size_t)u.pm * 256 * K * 2; u.b = w + ((size_t)u.e * 2048 + u.pn * 256) * K * 2; return true;
    }
    __device__ __forceinline__ unsigned row_off(const gm::Unit&, int) const { return 0u; }
    __device__ __forceinline__ void epi(const f32x4 (&acc)[2][2][4][2], const gm::Unit& u, int wr, int wc, int fr, int fq) const {
        const int cnt = tb[40 + u.e];
#pragma unroll
        for (int ai = 0; ai < 2; ++ai)
#pragma unroll
            for (int m = 0; m < 4; ++m) { const int r = ai * 128 + wr * 64 + m * 16 + fr; const int slot = u.x * 256 + r; const float ws = slot < cnt ? lw[(size_t)u.e * T + slot] : 0.f;
                bf16_t* rowp = yb + ((size_t)u.pm * 256 + r) * D + u.pn * 256 + wc * 32 + 8 * fq;
#pragma unroll
                for (int bj = 0; bj < 2; ++bj) { const f32x4 v0 = acc[ai][bj][m][0] * ws, v1 = acc[ai][bj][m][1] * ws;
                    u32x4 w4; w4.x = cvtpk(v0[0], v0[1]); w4.y = cvtpk(v0[2], v0[3]); w4.z = cvtpk(v1[0], v1[1]); w4.w = cvtpk(v1[2], v1[3]);
                    *(u32x4*)(rowp + bj * 128) = w4; } }
    }
};
struct ProbL1 {
    static constexpr bool GATHER = false; static constexpr int K = 2048;
    gm::Order ord; const char* xb; const char* w; unsigned char* big; const float* rstd; const int* pos; const float* kgain; const float* qgain;
    __device__ __forceinline__ bool next(int i, gm::Unit& u) const {
        int pm, pn; if (!ord.get(i, pm, pn)) return false; pn = pn < 6 ? pn : pn + 6;
        u.pm = pm; u.pn = pn; u.e = 0; u.x = 0;
        u.a = xb + (size_t)pm * 256 * K * 2; u.b = w + (size_t)pn * 256 * K * 2; return true;
    }
    __device__ __forceinline__ unsigned row_off(const gm::Unit&, int) const { return 0u; }
    __device__ __forceinline__ void epi(const f32x4 (&acc)[2][2][4][2], const gm::Unit& u, int wr, int wc, int fr, int fq) const {
        const int pm = u.pm, pn = u.pn;
        if (pn >= 18) { gm::store_tile_bf16(acc, (bf16_t*)(big + BG_MQ2) + (size_t)pm * 256 * 512 + (pn - 18) * 256, 512, rstd + pm * 256, nullptr, false, wr, wc, fr, fq); return; }
        const bool isq = pn >= 12; const int pl = isq ? pn - 12 : pn;
        bf16_t* ob = (bf16_t*)(big + (isq ? BG_QR : BG_KR)); const float* gain = isq ? qgain : kgain; const float osc = isq ? 0.125f * LOG2E : 1.f;
        float rs8[8]; int ps8[8];
#pragma unroll
        for (int i = 0; i < 8; ++i) { const size_t tok = (size_t)pm * 256 + (i >> 2) * 128 + wr * 64 + (i & 3) * 16 + fr; rs8[i] = rstd[tok]; ps8[i] = pos[tok]; }
        f32x4 g1[2], g2[2], invf[2];
#pragma unroll
        for (int n = 0; n < 2; ++n) { g1[n] = *(const f32x4*)(gain + 8 * fq + 4 * n); g2[n] = *(const f32x4*)(gain + 32 + 8 * fq + 4 * n);
#pragma unroll
            for (int j = 0; j < 4; ++j) invf[n][j] = exp2f(-(float)(8 * fq + 4 * n + j) * (13.287712379549449f / 32.f)) * 0.15915494309189535f; }
#pragma unroll
        for (int ai = 0; ai < 2; ++ai)
#pragma unroll
            for (int m = 0; m < 4; ++m) { const size_t tok = (size_t)pm * 256 + ai * 128 + wr * 64 + m * 16 + fr; const float rs = rs8[ai * 4 + m]; const float pf = (float)ps8[ai * 4 + m];
                float ss = 0.f;
#pragma unroll
                for (int n = 0; n < 2; ++n) { const f32x4 a1 = acc[ai][0][m][n], a2 = acc[ai][1][m][n];
                    ss += (a1[0] * a1[0] + a1[1] * a1[1]) + (a1[2] * a1[2] + a1[3] * a1[3]) + (a2[0] * a2[0] + a2[1] * a2[1]) + (a2[2] * a2[2] + a2[3] * a2[3]); }
                ss *= rs * rs; ss += __shfl_xor(ss, 16); ss += __shfl_xor(ss, 32);
                const float rn = rs * osc * __builtin_amdgcn_rsqf(ss * (1.f / 64.f) + EPS);
                u32x4 w1, w2; unsigned* pw1 = (unsigned*)&w1; unsigned* pw2 = (unsigned*)&w2;
#pragma unroll
                for (int n = 0; n < 2; ++n) { f32x4 cc, sn;
#pragma unroll
                    for (int j = 0; j < 4; ++j) { const float fr_ = __builtin_amdgcn_fractf(pf * invf[n][j]); cc[j] = __builtin_amdgcn_cosf(fr_); sn[j] = __builtin_amdgcn_sinf(fr_); }
                    const f32x4 y1 = acc[ai][0][m][n] * rn * g1[n], y2 = acc[ai][1][m][n] * rn * g2[n];
                    const f32x4 o1 = y1 * cc - y2 * sn, o2 = y1 * sn + y2 * cc;
                    pw1[2 * n] = cvtpk(o1[0], o1[1]); pw1[2 * n + 1] = cvtpk(o1[2], o1[3]); pw2[2 * n] = cvtpk(o2[0], o2[1]); pw2[2 * n + 1] = cvtpk(o2[2], o2[3]); }
                bf16_t* rowp = ob + tok * 1536 + pl * 256 + wc * 64 + 8 * fq;
                *(u32x4*)rowp = w1; *(u32x4*)(rowp + 32) = w2; }
    }
};
constexpr float SX8 = 4.f, SW8 = 256.f, SA8 = 8.f, SD8 = 128.f, SY8 = 64.f;
constexpr float SC8 = 16.f, SWO8 = 256.f;
constexpr size_t WS_X8 = WS_END;
constexpr size_t WS_END8 = WS_END + 66 * MiB;
constexpr size_t WS_MEMB8 = WS_END8;
constexpr size_t WS_END9 = WS_END8 + 2 * MiB;
struct ProbGU8 {
    static constexpr bool GATHER = true; static constexpr int K = 1024;
    int G, c; LAS int* tb; const char* xb; const char* w; const int* ltok; const float* lrs; unsigned char* act;
    __device__ __forceinline__ bool next(int i, gm::Unit& u) const {
        if (!moe_unit(tb, i, G, c, u)) return false;
        u.a = xb; u.b = w + ((size_t)u.e * 2048 + u.pn * 256) * 2048; return true;
    }
    __device__ __forceinline__ unsigned row_off(const gm::Unit& u, int r) const {
        const int slot = u.x * 256 + r, cnt = tb[40 + u.e]; const int v = ltok[(size_t)u.e * T + (slot < cnt ? slot : cnt - 1)];
        return (unsigned)(slot < cnt ? v : T) * 2048u;
    }
    __device__ __forceinline__ void epi8(const f32x16 (&acc)[2][2][2], const gm::Unit& u, int wr, int wc, int c32, int h) const {
        const int cnt = tb[40 + u.e];
        float rs4[4];
#pragma unroll
        for (int i = 0; i < 4; ++i) { const int slot = u.x * 256 + (i >> 1) * 128 + wr * 64 + (i & 1) * 32 + c32; const float v = lrs[(size_t)u.e * T + (slot < cnt ? slot : cnt - 1)]; rs4[i] = slot < cnt ? v * (1.0f / (SX8 * SW8)) : 0.f; }
#pragma unroll
        for (int ai = 0; ai < 2; ++ai)
#pragma unroll
            for (int mb = 0; mb < 2; ++mb) { const int r = ai * 128 + wr * 64 + mb * 32 + c32; const float rs = rs4[ai * 2 + mb];
                float o[16];
#pragma unroll
                for (int i = 0; i < 16; ++i) { const float g = acc[ai][0][mb][i] * rs, uu = acc[ai][1][mb][i] * rs; o[i] = g * __builtin_amdgcn_rcpf(1.f + __builtin_amdgcn_exp2f(-LOG2E * g)) * uu * SA8; }
                u32x4 w4; w4.x = gm::pk_fp8x4(o[0], o[1], o[2], o[3]); w4.y = gm::pk_fp8x4(o[4], o[5], o[6], o[7]); w4.z = gm::pk_fp8x4(o[8], o[9], o[10], o[11]); w4.w = gm::pk_fp8x4(o[12], o[13], o[14], o[15]);
                *(u32x4*)(act + ((size_t)u.pm * 256 + r) * DFF + u.pn * 128 + wc * 32 + 16 * h) = w4; }
    }
};
struct ProbDown8 {
    static constexpr bool GATHER = false; static constexpr int K = 512;
    int G, c; LAS int* tb; const char* act; const char* w; const float* lw; bf16_t* yb;
    __device__ __forceinline__ bool next(int i, gm::Unit& u) const {
        if (!moe_unit(tb, i, G, c, u)) return false;
        u.a = act + (size_t)u.pm * 256 * 1024; u.b = w + ((size_t)u.e * 2048 + u.pn * 256) * 1024; return true;
    }
    __device__ __forceinline__ unsigned row_off(const gm::Unit&, int) const { return 0u; }
    __device__ __forceinline__ void epi8(const f32x16 (&acc)[2][2][2], const gm::Unit& u, int wr, int wc, int c32, int h) const {
        const int cnt = tb[40 + u.e];
        float ws4[4];
#pragma unroll
        for (int i = 0; i < 4; ++i) { const int slot = u.x * 256 + (i >> 1) * 128 + wr * 64 + (i & 1) * 32 + c32; const float v = lw[(size_t)u.e * T + (slot < cnt ? slot : cnt - 1)]; ws4[i] = slot < cnt ? v * (SY8 / (SA8 * SD8)) : 0.f; }
#pragma unroll
        for (int ai = 0; ai < 2; ++ai)
#pragma unroll
            for (int mb = 0; mb < 2; ++mb) { const int r = ai * 128 + wr * 64 + mb * 32 + c32; const float ws = ws4[ai * 2 + mb];
                unsigned char* rowp = (unsigned char*)yb + ((size_t)u.pm * 256 + r) * D + u.pn * 256 + wc * 32 + 16 * h;
#pragma unroll
                for (int bj = 0; bj < 2; ++bj) { u32x4 w0;
                    w0.x = gm::pk_fp8x4(acc[ai][bj][mb][0] * ws, acc[ai][bj][mb][1] * ws, acc[ai][bj][mb][2] * ws, acc[ai][bj][mb][3] * ws);
                    w0.y = gm::pk_fp8x4(acc[ai][bj][mb][4] * ws, acc[ai][bj][mb][5] * ws, acc[ai][bj][mb][6] * ws, acc[ai][bj][mb][7] * ws);
                    w0.z = gm::pk_fp8x4(acc[ai][bj][mb][8] * ws, acc[ai][bj][mb][9] * ws, acc[ai][bj][mb][10] * ws, acc[ai][bj][mb][11] * ws);
                    w0.w = gm::pk_fp8x4(acc[ai][bj][mb][12] * ws, acc[ai][bj][mb][13] * ws, acc[ai][bj][mb][14] * ws, acc[ai][bj][mb][15] * ws);
                    *(u32x4*)(rowp + bj * 128) = w0; }
                asm volatile("" ::: "memory"); }
    }
};

struct ProbOut8 {
    static constexpr bool GATHER = false; static constexpr int K = 1024;
    gm::Order ord; const char* a; const char* w; const bf16_t* resid; bf16_t* outp;
    __device__ __forceinline__ bool next(int i, gm::Unit& u) const {
        int pm, pn; if (!ord.get(i, pm, pn)) return false; u.pm = pm; u.pn = pn; u.e = 0; u.x = 0;
        u.a = a + (size_t)pm * 256 * 2048; u.b = w + (size_t)pn * 256 * 2048; return true;
    }
    __device__ __forceinline__ unsigned row_off(const gm::Unit&, int) const { return 0u; }
    __device__ __forceinline__ void epi8(const f32x16 (&acc)[2][2][2], const gm::Unit& u, int wr, int wc, int c32, int h) const {
        constexpr float sc = 1.0f / (SC8 * SWO8);
#pragma unroll
        for (int ai = 0; ai < 2; ++ai) {
            const size_t off0 = ((size_t)u.pm * 256 + ai * 128 + wr * 64 + c32) * D + u.pn * 256 + wc * 32 + 16 * h;
            u32x4 rb[2][2][2];
#pragma unroll
            for (int mb = 0; mb < 2; ++mb)
#pragma unroll
                for (int bj = 0; bj < 2; ++bj) { const bf16_t* rp = resid + off0 + (size_t)mb * 32 * D + bj * 128; rb[mb][bj][0] = *(const u32x4*)rp; rb[mb][bj][1] = *(const u32x4*)(rp + 8); }
#pragma unroll
            for (int mb = 0; mb < 2; ++mb)
#pragma unroll
                for (int bj = 0; bj < 2; ++bj) { bf16_t* op = outp + off0 + (size_t)mb * 32 * D + bj * 128;
#pragma unroll
                    for (int q = 0; q < 2; ++q) { const u32x4 rw = rb[mb][bj][q]; const f32x16& a = acc[ai][bj][mb];
                        u32x4 w4; w4.x = cvtpk(a[8 * q + 0] * sc + bflo(rw.x), a[8 * q + 1] * sc + bfhi(rw.x)); w4.y = cvtpk(a[8 * q + 2] * sc + bflo(rw.y), a[8 * q + 3] * sc + bfhi(rw.y));
                        w4.z = cvtpk(a[8 * q + 4] * sc + bflo(rw.z), a[8 * q + 5] * sc + bfhi(rw.z)); w4.w = cvtpk(a[8 * q + 6] * sc + bflo(rw.w), a[8 * q + 7] * sc + bfhi(rw.w));
                        *(u32x4*)(op + 8 * q) = w4; } }
            asm volatile("" ::: "memory");
        }
    }
};

struct ProbL1V8 {
    static constexpr bool GATHER = false; static constexpr int K = 1024;
    gm::Order ord; const char* a; const char* w; bf16_t* vn; bf16_t* mq; const float* rstd;
    __device__ __forceinline__ bool next(int i, gm::Unit& u) const {
        int pm, pn; if (!ord.get(i, pm, pn)) return false; u.pm = pm; u.pn = pn; u.e = 0; u.x = 0;
        u.a = a + (size_t)pm * 256 * 2048; u.b = w + (size_t)pn * 256 * 2048; return true;
    }
    __device__ __forceinline__ unsigned row_off(const gm::Unit&, int) const { return 0u; }
    __device__ __forceinline__ void epi8(const f32x16 (&acc)[2][2][2], const gm::Unit& u, int wr, int wc, int c32, int h) const {
        float rs4[4];
#pragma unroll
        for (int i = 0; i < 4; ++i) rs4[i] = rstd[(size_t)u.pm * 256 + (i >> 1) * 128 + wr * 64 + (i & 1) * 32 + c32] * (1.0f / (SX8 * SW8));
#pragma unroll
        for (int ai = 0; ai < 2; ++ai)
#pragma unroll
            for (int mb = 0; mb < 2; ++mb) { const float rs = rs4[ai * 2 + mb];
                const size_t row = (size_t)u.pm * 256 + ai * 128 + wr * 64 + mb * 32 + c32;
                bf16_t* rowp = (u.pn < 6 ? vn + row * 1536 + u.pn * 256 : mq + row * 512 + (u.pn - 6) * 256) + wc * 32 + 16 * h;
#pragma unroll
                for (int bj = 0; bj < 2; ++bj) { const f32x16& a = acc[ai][bj][mb];
#pragma unroll
                    for (int q = 0; q < 2; ++q) { u32x4 w4; w4.x = cvtpk(a[8 * q + 0] * rs, a[8 * q + 1] * rs); w4.y = cvtpk(a[8 * q + 2] * rs, a[8 * q + 3] * rs); w4.z = cvtpk(a[8 * q + 4] * rs, a[8 * q + 5] * rs); w4.w = cvtpk(a[8 * q + 6] * rs, a[8 * q + 7] * rs);
                        *(u32x4*)(rowp + bj * 128 + 8 * q) = w4; } }
                asm volatile("" ::: "memory"); }
    }
};

struct ProbL1F8 {
    static constexpr bool GATHER = false; static constexpr int K = 1024;
    gm::Order ord; const char* a; const char* w; unsigned char* big; const float* rstd; const int* pos; const float* kgain; const float* qgain;
    __device__ __forceinline__ bool next(int i, gm::Unit& u) const {
        int pm, pn; if (!ord.get(i, pm, pn)) return false; u.pm = pm; u.pn = pn; u.e = 0; u.x = 0;
        u.a = a + (size_t)pm * 256 * 2048; u.b = w + (size_t)pn * 256 * 2048; return true;
    }
    __device__ __forceinline__ unsigned row_off(const gm::Unit&, int) const { return 0u; }
    __device__ __forceinline__ void epi8(const f32x16 (&acc)[2][2][2], const gm::Unit& u, int wr, int wc, int c32, int h) const {
        const int pm = u.pm, pn = u.pn;
        float rs4[4];
#pragma unroll
        for (int i = 0; i < 4; ++i) rs4[i] = rstd[(size_t)pm * 256 + (i >> 1) * 128 + wr * 64 + (i & 1) * 32 + c32] * (1.0f / (SX8 * SW8));
        const bool isv = pn >= 6 && pn < 12, ismq = pn >= 18;
        if (isv || ismq) {
#pragma unroll
            for (int ai = 0; ai < 2; ++ai)
#pragma unroll
                for (int mb = 0; mb < 2; ++mb) { const float rs = rs4[ai * 2 + mb];
                    const size_t row = (size_t)pm * 256 + ai * 128 + wr * 64 + mb * 32 + c32;
                    bf16_t* rowp = (isv ? (bf16_t*)(big + BG_VN) + row * 1536 + (pn - 6) * 256 : (bf16_t*)(big + BG_MQ2) + row * 512 + (pn - 18) * 256) + wc * 32 + 16 * h;
#pragma unroll
                    for (int bj = 0; bj < 2; ++bj) { const f32x16& a = acc[ai][bj][mb];
#pragma unroll
                        for (int q = 0; q < 2; ++q) { u32x4 w4; w4.x = cvtpk(a[8 * q + 0] * rs, a[8 * q + 1] * rs); w4.y = cvtpk(a[8 * q + 2] * rs, a[8 * q + 3] * rs); w4.z = cvtpk(a[8 * q + 4] * rs, a[8 * q + 5] * rs); w4.w = cvtpk(a[8 * q + 6] * rs, a[8 * q + 7] * rs);
                            *(u32x4*)(rowp + bj * 128 + 8 * q) = w4; } }
                    asm volatile("" ::: "memory"); }
            return;
        }
        const bool isq = pn >= 12; const int pl = isq ? pn - 12 : pn;
        bf16_t* ob = (bf16_t*)(big + (isq ? BG_QR : BG_KR)); const float* gain = isq ? qgain : kgain; const float osc = isq ? 0.125f * LOG2E : 1.f;
        int ps4[4];
#pragma unroll
        for (int i = 0; i < 4; ++i) ps4[i] = pos[(size_t)pm * 256 + (i >> 1) * 128 + wr * 64 + (i & 1) * 32 + c32];
        f32x4 g1[4], g2[4];
#pragma unroll
        for (int q = 0; q < 4; ++q) { g1[q] = *(const f32x4*)(gain + 16 * h + 4 * q); g2[q] = *(const f32x4*)(gain + 32 + 16 * h + 4 * q); }
        const float fbase = (float)(16 * h) * (13.287712379549449f / 32.f);
#pragma unroll
        for (int ai = 0; ai < 2; ++ai)
#pragma unroll
            for (int mb = 0; mb < 2; ++mb) { const float rs = rs4[ai * 2 + mb]; const float pf = (float)ps4[ai * 2 + mb] * 0.15915494309189535f;
                const size_t tok = (size_t)pm * 256 + ai * 128 + wr * 64 + mb * 32 + c32;
                const f32x16& a1 = acc[ai][0][mb]; const f32x16& a2 = acc[ai][1][mb];
                float ss = 0.f;
#pragma unroll
                for (int i = 0; i < 16; ++i) ss += a1[i] * a1[i] + a2[i] * a2[i];
                ss *= rs * rs; ss += __shfl_xor(ss, 32);
                const float rn = rs * osc * __builtin_amdgcn_rsqf(ss * (1.f / 64.f) + EPS);
                bf16_t* rowp = ob + tok * 1536 + pl * 256 + wc * 64 + 16 * h;
#pragma unroll
                for (int q = 0; q < 2; ++q) { float o1[8], o2[8];
#pragma unroll
                    for (int j = 0; j < 8; ++j) { const int i = 8 * q + j;
                        const float fr_ = __builtin_amdgcn_fractf(pf * __builtin_amdgcn_exp2f(-(fbase + (float)i * (13.287712379549449f / 32.f)))); const float cc = __builtin_amdgcn_cosf(fr_), sn = __builtin_amdgcn_sinf(fr_);
                        const float y1 = a1[i] * rn * g1[i >> 2][i & 3], y2 = a2[i] * rn * g2[i >> 2][i & 3]; o1[j] = y1 * cc - y2 * sn; o2[j] = y1 * sn + y2 * cc; }
                    u32x4 w1, w2;
                    w1.x = cvtpk(o1[0], o1[1]); w1.y = cvtpk(o1[2], o1[3]); w1.z = cvtpk(o1[4], o1[5]); w1.w = cvtpk(o1[6], o1[7]);
                    w2.x = cvtpk(o2[0], o2[1]); w2.y = cvtpk(o2[2], o2[3]); w2.z = cvtpk(o2[4], o2[5]); w2.w = cvtpk(o2[6], o2[7]);
                    *(u32x4*)(rowp + 8 * q) = w1; *(u32x4*)(rowp + 32 + 8 * q) = w2; }
                asm volatile("" ::: "memory"); }
    }
};

struct ProbInA8 {
    static constexpr bool GATHER = false; static constexpr int K = 1024;
    gm::Order ord; const char* a; const char* w; unsigned char* big; const float* rstd;
    __device__ __forceinline__ bool next(int i, gm::Unit& u) const {
        int pm, pn; if (!ord.get(i, pm, pn)) return false; u.pm = pm; u.pn = pn; u.e = 0; u.x = 0;
        u.a = a + (size_t)pm * 256 * 2048; u.b = w + (size_t)pn * 256 * 2048; return true;
    }
    __device__ __forceinline__ unsigned row_off(const gm::Unit&, int) const { return 0u; }
    __device__ __forceinline__ void epi8(const f32x16 (&acc)[2][2][2], const gm::Unit& u, int wr, int wc, int c32, int h) const {
        const int pm = u.pm, pn = u.pn; const bool isg = pn < 6;
        float rs4[4];
#pragma unroll
        for (int i = 0; i < 4; ++i) rs4[i] = rstd[(size_t)pm * 256 + (i >> 1) * 128 + wr * 64 + (i & 1) * 32 + c32] * (1.0f / (SX8 * SW8));
#pragma unroll
        for (int ai = 0; ai < 2; ++ai)
#pragma unroll
            for (int mb = 0; mb < 2; ++mb) { const float rs = rs4[ai * 2 + mb];
                const size_t row = (size_t)pm * 256 + ai * 128 + wr * 64 + mb * 32 + c32;
                bf16_t* rowp = (isg ? (bf16_t*)(big + BG_ON) + row * 1536 + pn * 256 : (bf16_t*)(big + BG_MQ) + row * 512 + (pn - 6) * 256) + wc * 32 + 16 * h;
#pragma unroll
                for (int bj = 0; bj < 2; ++bj) { const f32x16& a = acc[ai][bj][mb];
#pragma unroll
                    for (int q = 0; q < 2; ++q) { float v[8];
#pragma unroll
                        for (int j = 0; j < 8; ++j) { const float t = a[8 * q + j] * rs; v[j] = isg ? __builtin_amdgcn_rcpf(1.f + __builtin_amdgcn_exp2f(-LOG2E * t)) : t; }
                        u32x4 w4; w4.x = cvtpk(v[0], v[1]); w4.y = cvtpk(v[2], v[3]); w4.z = cvtpk(v[4], v[5]); w4.w = cvtpk(v[6], v[7]);
                        *(u32x4*)(rowp + bj * 128 + 8 * q) = w4; } }
                asm volatile("" ::: "memory"); }
    }
};

struct ProbMemKV8 {
    static constexpr bool GATHER = false; static constexpr int K = 1024;
    int G, c; const char* memb; const char* w; float* outp; const float* rstd;
    __device__ __forceinline__ bool next(int i, gm::Unit& u) const {
        const int L = i * G + c; if (L >= 32) return false;
        const int l = L >> 4, pm = (L >> 2) & 3, pn = L & 3; u.pm = pm; u.pn = pn; u.e = l; u.x = 0;
        u.a = memb + (size_t)pm * 256 * 2048; u.b = w + ((size_t)l * 1024 + pn * 256) * 2048; return true;
    }
    __device__ __forceinline__ unsigned row_off(const gm::Unit&, int) const { return 0u; }
    __device__ __forceinline__ void epi8(const f32x16 (&acc)[2][2][2], const gm::Unit& u, int wr, int wc, int c32, int h) const {
        float* ob = outp + ((size_t)u.e * 1024 + u.pm * 256) * 1024 + u.pn * 256;
        float rs4[4];
#pragma unroll
        for (int i = 0; i < 4; ++i) rs4[i] = rstd[u.pm * 256 + (i >> 1) * 128 + wr * 64 + (i & 1) * 32 + c32] * (1.0f / (SX8 * SW8));
#pragma unroll
        for (int ai = 0; ai < 2; ++ai)
#pragma unroll
            for (int mb = 0; mb < 2; ++mb) { const float rs = rs4[ai * 2 + mb]; float* rowp = ob + (size_t)(ai * 128 + wr * 64 + mb * 32 + c32) * 1024 + wc * 32 + 16 * h;
#pragma unroll
                for (int bj = 0; bj < 2; ++bj) { const f32x16& a = acc[ai][bj][mb];
#pragma unroll
                    for (int q = 0; q < 4; ++q) *(f32x4*)(rowp + bj * 128 + 4 * q) = (f32x4){a[4 * q] * rs, a[4 * q + 1] * rs, a[4 * q + 2] * rs, a[4 * q + 3] * rs}; }
                asm volatile("" ::: "memory"); }
    }
};
__device__ __forceinline__ void xpose_item(const float* W, size_t ld, int k0, int n0, bf16_t* dst, int dstep, int Kd, const float* scale, float mul, LAS float* scr, int lane) {
    const int kr = lane >> 4, q = lane & 15;
    f32x4 v[16];
#pragma unroll
    for (int i = 0; i < 16; ++i) v[i] = __builtin_nontemporal_load((const f32x4*)(W + (size_t)(k0 + 4 * i + kr) * ld + n0 + 4 * q));
#pragma unroll
    for (int i = 0; i < 16; ++i) { const int k = 4 * i + kr; const float s = scale ? scale[k0 + k] * mul : mul; *(LAS f32x4*)(scr + k * 64 + 4 * (q ^ ((k >> 3) & 7))) = v[i] * s; }
    LDS_WAIT(); asm volatile("" ::: "memory");
    const int c = lane & 7;
#pragma unroll
    for (int j = 0; j < 8; ++j) { const int n = (lane >> 3) + 8 * j; const LAS float* sp = scr + (8 * c) * 64 + 4 * ((n >> 2) ^ c) + (n & 3);
        u32x4 o; o.x = cvtpk(sp[0], sp[64]); o.y = cvtpk(sp[128], sp[192]); o.z = cvtpk(sp[256], sp[320]); o.w = cvtpk(sp[384], sp[448]);
        *(u32x4*)(dst + (size_t)((n & 31) + (n >> 5) * dstep) * Kd + k0 + 8 * c) = o; }
    LDS_WAIT(); asm volatile("" ::: "memory");
}
__device__ __forceinline__ void xpose_item8(const float* W, size_t ld, int k0, int n0, unsigned char* dst, int Kd, const float* scale, float mul, LAS float* scr, int lane) {
    const int kr = lane >> 4, q = lane & 15;
    f32x4 v[16];
#pragma unroll
    for (int i = 0; i < 16; ++i) v[i] = __builtin_nontemporal_load((const f32x4*)(W + (size_t)(k0 + 4 * i + kr) * ld + n0 + 4 * q));
#pragma unroll
    for (int i = 0; i < 16; ++i) { const int k = 4 * i + kr; const float s = scale ? scale[k0 + k] * mul : mul; *(LAS f32x4*)(scr + k * 64 + 4 * (q ^ ((k >> 3) & 7))) = v[i] * s; }
    LDS_WAIT(); asm volatile("" ::: "memory");
    const int c = lane & 7;
#pragma unroll
    for (int j = 0; j < 8; ++j) { const int n = (lane >> 3) + 8 * j; const LAS float* sp = scr + (8 * c) * 64 + 4 * ((n >> 2) ^ c) + (n & 3);
        u32x2 o; o.x = gm::pk_fp8x4(sp[0], sp[64], sp[128], sp[192]); o.y = gm::pk_fp8x4(sp[256], sp[320], sp[384], sp[448]);
        *(u32x2*)(dst + (size_t)n * Kd + k0 + 8 * c) = o; }
    LDS_WAIT(); asm volatile("" ::: "memory");
}
__device__ __forceinline__ void cast_row(const float* xrow, bf16_t* orow, float* rstd_out, int lane, unsigned char* e8) {
    const f32x4* xr = (const f32x4*)xrow + lane; f32x4 v[8]; float s = 0.f;
#pragma unroll
    for (int j = 0; j < 8; ++j) { v[j] = xr[64 * j]; s += (v[j].x * v[j].x + v[j].y * v[j].y) + (v[j].z * v[j].z + v[j].w * v[j].w); }
    s = wave_sum(s);
    u32x2* o8 = (u32x2*)orow + lane;
#pragma unroll
    for (int j = 0; j < 8; ++j) { u32x2 w; w.x = cvtpk(v[j].x, v[j].y); w.y = cvtpk(v[j].z, v[j].w); o8[64 * j] = w; ((unsigned*)e8 + lane)[64 * j] = gm::pk_fp8x4(v[j].x * 4.f, v[j].y * 4.f, v[j].z * 4.f, v[j].w * 4.f); }
    if (lane == 0) *rstd_out = 1.0f / sqrtf(s * (1.f / D) + EPS);
}
__device__ __forceinline__ void cast_row2(const float* xr0, const float* xr1, bf16_t* o0, bf16_t* o1, float* r0, float* r1, int lane, unsigned char* e0, unsigned char* e1) {
    const f32x4* p0 = (const f32x4*)xr0 + lane; const f32x4* p1 = (const f32x4*)xr1 + lane; f32x4 v[8], w[8]; float s0 = 0.f, s1 = 0.f;
#pragma unroll
    for (int j = 0; j < 8; ++j) { v[j] = p0[64 * j]; w[j] = p1[64 * j]; }
#pragma unroll
    for (int j = 0; j < 8; ++j) { s0 += (v[j].x * v[j].x + v[j].y * v[j].y) + (v[j].z * v[j].z + v[j].w * v[j].w); s1 += (w[j].x * w[j].x + w[j].y * w[j].y) + (w[j].z * w[j].z + w[j].w * w[j].w); }
    s0 = wave_sum(s0); s1 = wave_sum(s1);
    u32x2* q0 = (u32x2*)o0 + lane; u32x2* q1 = (u32x2*)o1 + lane;
#pragma unroll
    for (int j = 0; j < 8; ++j) { u32x2 a; a.x = cvtpk(v[j].x, v[j].y); a.y = cvtpk(v[j].z, v[j].w); q0[64 * j] = a; u32x2 b; b.x = cvtpk(w[j].x, w[j].y); b.y = cvtpk(w[j].z, w[j].w); q1[64 * j] = b; }
#pragma unroll
    for (int j = 0; j < 8; ++j) { ((unsigned*)e0 + lane)[64 * j] = gm::pk_fp8x4(v[j].x * 4.f, v[j].y * 4.f, v[j].z * 4.f, v[j].w * 4.f); ((unsigned*)e1 + lane)[64 * j] = gm::pk_fp8x4(w[j].x * 4.f, w[j].y * 4.f, w[j].z * 4.f, w[j].w * 4.f); }
    if (lane == 0) { *r0 = 1.0f / sqrtf(s0 * (1.f / D) + EPS); *r1 = 1.0f / sqrtf(s1 * (1.f / D) + EPS); }
}
__device__ __forceinline__ void p0_prologue(const Ctx& C) {
    LAS float* scr = (LAS float*)(C.lds + C.wave * 16384);
    const int gw = C.vcu * 8 + C.wave, NGW = C.G * 8, lane = C.lane;
    { bf16_t* xb = WSP(bf16_t, WS_S0); float* rstd0 = WSP(float, WS_RSTD);
      for (int m = gw; m < T / 2; m += NGW) cast_row2(C.in(0) + (size_t)m * D, C.in(0) + (size_t)(m + T / 2) * D, xb + (size_t)m * D, xb + (size_t)(m + T / 2) * D, rstd0 + m, rstd0 + m + T / 2, lane, C.ws + WS_END + (size_t)m * D, C.ws + WS_END + (size_t)(m + T / 2) * D);
      bf16_t* memb = WSP(bf16_t, WS_MEMB); float* rsm = WSP(float, WS_MISC + MS_RSTDMEM);
      for (int m = gw; m < NB * MEMS; m += NGW) cast_row(C.in(1) + (size_t)m * D, memb + (size_t)m * D, rsm + m, lane, C.ws + WS_MEMB8 + (size_t)m * D); }
    { const int gt = C.vcu * 512 + C.tid, NGT = C.G * 512;
      bf16_t* wr = WSP(bf16_t, WS_MISC + MS_WR);
      for (int i = gt; i < 2 * 48 * 2048; i += NGT) { const int l = i / (48 * 2048), n = (i / 2048) % 48, k = i % 2048; float v = 0.f;
          if (n < 4) v = C.in(21)[((size_t)l * D + k) * NG + n]; else if (n < 36) v = C.in(23)[((size_t)l * D + k) * NE + (n - 4)];
          v *= C.in(20)[l * D + k]; const unsigned short hi = f2bf(v); const unsigned short lo = f2bf(v - bf2f(hi));
          wr[(size_t)(l * 2 + 0) * 48 * 2048 + n * 2048 + k] = hi; wr[(size_t)(l * 2 + 1) * 48 * 2048 + n * 2048 + k] = lo; }
      bf16_t* wg = WSP(bf16_t, WS_MISC + MS_WG);
      for (int i = gt; i < 16 * 2048; i += NGT) { const int n = i / 2048, k = i % 2048; float v = 0.f; if (n < 12) v = C.in(8)[(size_t)k * A_IN + 4608 + n] * C.in(3)[k];
          const unsigned short hi = f2bf(v); const unsigned short lo = f2bf(v - bf2f(hi)); wg[n * 2048 + k] = hi; wg[16 * 2048 + n * 2048 + k] = lo; }
      unsigned* zr = (unsigned*)(WSP(bf16_t, WS_S2) + (size_t)T * D);
      for (int i = gt; i < 1024; i += NGT) zr[i] = 0u;
      unsigned* zr8 = (unsigned*)(C.ws + WS_X8 + (size_t)T * 2048);
      for (int i = gt; i < 512; i += NGT) zr8[i] = 0u; }
    constexpr int I_A = 32 * 80, I_O = 32 * 32, I_L = 32 * 80, I_M = 32 * 16, I_G = 32 * 16, I_D = 16 * 32;
    constexpr int N_SMALL = I_A + I_O + I_L + I_O + 2 * I_M;
    constexpr int NITEMS = N_SMALL + 64 * (2 * I_G + I_D);
    struct XP { const float* W; size_t ld; int k0, n0; unsigned char* dst; int dstep, Kd; const float* scale; float mul; int f8; };
    auto params = [&](int it) -> XP {
        XP x; int r = it; x.dstep = 32; x.f8 = 0; x.mul = 1.f; x.scale = nullptr;
        if (r < I_A) { const int kb = r / 80, nb = r % 80; const int dr = nb * 64; x.W = C.in(8); x.ld = A_IN; x.k0 = kb * 64; x.n0 = dr < 4608 ? dr : dr + 12; x.dst = C.ws + WS_WINA + (size_t)dr * D * 2; x.Kd = D; x.scale = C.in(3); x.mul = dr < 768 ? 0.08838834764831845f : 1.f;
            if (dr >= 3072) { x.f8 = 1; x.mul = 256.f; x.dst = C.ws + WS_WINA + (size_t)3072 * D * 2 + (size_t)(dr - 3072) * D; }
            return x; } r -= I_A;
        if (r < I_O) { const int kb = r / 32, nb = r % 32; x.W = C.in(11); x.ld = D; x.k0 = kb * 64; x.n0 = nb * 64; x.dst = C.ws + WS_WOUTA + (size_t)nb * 64 * D * 2; x.Kd = D; return x; } r -= I_O;
        if (r < I_L) { const int kb = r / 80, nb = r % 80; const int dr0 = nb * 64;
            const bool isk = dr0 < 1536, isv = dr0 >= 1536 && dr0 < 3072, isq = dr0 >= 3072 && dr0 < 4608;
            x.W = (isk || isv) ? C.in(13) : C.in(15); x.ld = (isk || isv) ? 3072 : 2048; x.n0 = (isk || isv) ? dr0 : dr0 - 3072; x.k0 = kb * 64;
            int dr = dr0;
            if (isk || isq) { const int base = isk ? 0 : 3072, loc = dr0 - base, tile = loc >> 8, wc = (loc >> 6) & 3; dr = base + tile * 256 + wc * 32; x.dstep = 128; }
            x.dst = C.ws + WS_WL1 + (size_t)dr * D; x.Kd = D; x.scale = (isk || isv) ? C.in(12) : C.in(3) + D; x.f8 = 1; x.mul = SW8;
            return x; } r -= I_L;
        if (r < I_O) { const int kb = r / 32, nb = r % 32; x.W = C.in(19); x.ld = D; x.k0 = kb * 64; x.n0 = nb * 64; x.dst = C.ws + WS_WOUTB + (size_t)nb * 64 * D; x.Kd = D; x.f8 = 1; x.mul = SWO8; return x; } r -= I_O;
        if (r < 2 * I_M) { const int l = r / I_M, q = r % I_M, kb = q / 16, nb = q % 16; x.W = C.in(5) + (size_t)l * D * 1024; x.ld = 1024; x.k0 = kb * 64; x.n0 = nb * 64; x.dst = C.ws + WS_WMEM + ((size_t)l * 1024 + nb * 64) * D; x.Kd = D; x.scale = C.in(4) + l * D; x.f8 = 1; x.mul = 256.f; return x; } r -= 2 * I_M;
        { const int le = r / (2 * I_G + I_D), q = r % (2 * I_G + I_D), l = le >> 5; x.f8 = 1;
          if (q < 2 * I_G) { const int up = q >= I_G, qq = q - up * I_G, kb = qq / 16, nb = qq % 16; const int h0 = nb * 64; const int dr = 256 * (h0 >> 7) + (h0 & 127) + up * 128;
              x.W = (up ? C.in(26) : C.in(25)) + (size_t)le * D * DFF; x.ld = DFF; x.k0 = kb * 64; x.n0 = h0; x.dst = C.ws + WS_WGU + ((size_t)le * 2048 + dr) * D; x.Kd = D; x.scale = C.in(20) + l * D; x.mul = SW8; }
          else { const int qq = q - 2 * I_G, kb = qq / 32, nb = qq % 32; x.W = C.in(27) + (size_t)le * DFF * D; x.ld = D; x.k0 = kb * 64; x.n0 = nb * 64; x.dst = C.ws + WS_WD + ((size_t)le * 2048 + nb * 64) * DFF; x.Kd = DFF; x.mul = SD8; } }
        return x;
    };
    const int kr = lane >> 4, q16 = lane & 15, c8 = lane & 7;
#define XP_LOAD(X, V) do { _Pragma("unroll") for (int i = 0; i < 16; ++i) V[i] = __builtin_nontemporal_load((const f32x4*)(X.W + (size_t)(X.k0 + 4 * i + kr) * X.ld + X.n0 + 4 * q16)); } while (0)
    auto xp_store = [&](const XP& x, const f32x4 (&v)[16]) {
#pragma unroll
        for (int i = 0; i < 16; ++i) { const int k = 4 * i + kr; const float sc = x.scale ? x.scale[x.k0 + k] * x.mul : x.mul; *(LAS f32x4*)(scr + k * 64 + 4 * (q16 ^ ((k >> 3) & 7))) = v[i] * sc; }
        LDS_WAIT(); asm volatile("" ::: "memory");
        if (x.f8) {
#pragma unroll
            for (int j = 0; j < 8; ++j) { const int n = (lane >> 3) + 8 * j; const LAS float* sp = scr + (8 * c8) * 64 + 4 * ((n >> 2) ^ c8) + (n & 3);
                u32x2 o; o.x = gm::pk_fp8x4(sp[0], sp[64], sp[128], sp[192]); o.y = gm::pk_fp8x4(sp[256], sp[320], sp[384], sp[448]);
                *(u32x2*)(x.dst + (size_t)((n & 31) + (n >> 5) * x.dstep) * x.Kd + x.k0 + 8 * c8) = o; }
        } else {
#pragma unroll
            for (int j = 0; j < 8; ++j) { const int n = (lane >> 3) + 8 * j; const LAS float* sp = scr + (8 * c8) * 64 + 4 * ((n >> 2) ^ c8) + (n & 3);
                u32x4 o; o.x = cvtpk(sp[0], sp[64]); o.y = cvtpk(sp[128], sp[192]); o.z = cvtpk(sp[256], sp[320]); o.w = cvtpk(sp[384], sp[448]);
                *(u32x4*)(x.dst + ((size_t)((n & 31) + (n >> 5) * x.dstep) * x.Kd + x.k0 + 8 * c8) * 2) = o; }
        }
        LDS_WAIT(); asm volatile("" ::: "memory");
    };
    if (gw < NITEMS) {
        auto remap = [&](int it) { return it < NITEMS - N_SMALL ? it + N_SMALL : it - (NITEMS - N_SMALL); };
        XP cur = params(remap(gw)); f32x4 v[16]; XP_LOAD(cur, v);
#pragma unroll 1
        for (int it = gw; it < NITEMS; it += NGW) {
            const int nit = it + NGW; const bool hn = nit < NITEMS;
            XP nx = cur; f32x4 w[16];
            if (hn) { nx = params(remap(nit)); XP_LOAD(nx, w); }
            xp_store(cur, v);
            if (hn) { cur = nx;
#pragma unroll
                for (int i = 0; i < 16; ++i) v[i] = w[i]; }
        }
    }
#undef XP_LOAD
}
template <int NBK>
__device__ __forceinline__ void skinny16(const bf16_t* xrows, const bf16_t* whi, const bf16_t* wlo, f32x4 (&acc)[NBK], float& ss, int lane, unsigned char* x8rows = nullptr) {
    const int t = lane & 15, g = lane >> 4;
    const bf16_t* xp = xrows + (size_t)t * D + 16 * g;
    const bf16_t* hp = whi + (size_t)t * D + 16 * g; const bf16_t* lp = wlo + (size_t)t * D + 16 * g;
#pragma unroll
    for (int nb = 0; nb < NBK; ++nb) acc[nb] = (f32x4){0.f, 0.f, 0.f, 0.f};
    float s = 0.f;
#define SK_LOAD(X, S_) do { xa##X = *(const u32x4*)(xp + 64 * (S_)); xc##X = *(const u32x4*)(xp + 64 * (S_) + 8); \
        _Pragma("unroll") for (int nb = 0; nb < NBK; ++nb) { h0##X[nb] = *(const bf16x8*)(hp + (size_t)nb * 16 * D + 64 * (S_)); h1##X[nb] = *(const bf16x8*)(hp + (size_t)nb * 16 * D + 64 * (S_) + 8); \
            l0##X[nb] = *(const bf16x8*)(lp + (size_t)nb * 16 * D + 64 * (S_)); l1##X[nb] = *(const bf16x8*)(lp + (size_t)nb * 16 * D + 64 * (S_) + 8); } } while (0)
#define SK_COMP(X, S_) do { const u32x4 xa = xa##X, xc = xc##X; \
        s += (bflo(xa.x) * bflo(xa.x) + bfhi(xa.x) * bfhi(xa.x)) + (bflo(xa.y) * bflo(xa.y) + bfhi(xa.y) * bfhi(xa.y)) + (bflo(xa.z) * bflo(xa.z) + bfhi(xa.z) * bfhi(xa.z)) + (bflo(xa.w) * bflo(xa.w) + bfhi(xa.w) * bfhi(xa.w)); \
        s += (bflo(xc.x) * bflo(xc.x) + bfhi(xc.x) * bfhi(xc.x)) + (bflo(xc.y) * bflo(xc.y) + bfhi(xc.y) * bfhi(xc.y)) + (bflo(xc.z) * bflo(xc.z) + bfhi(xc.z) * bfhi(xc.z)) + (bflo(xc.w) * bflo(xc.w) + bfhi(xc.w) * bfhi(xc.w)); \
        const bf16x8 fa = __builtin_bit_cast(bf16x8, xa), fc = __builtin_bit_cast(bf16x8, xc); \
        if (x8rows) { u32x4 q8; q8.x = gm::pk_fp8x4(bflo(xa.x) * SX8, bfhi(xa.x) * SX8, bflo(xa.y) * SX8, bfhi(xa.y) * SX8); q8.y = gm::pk_fp8x4(bflo(xa.z) * SX8, bfhi(xa.z) * SX8, bflo(xa.w) * SX8, bfhi(xa.w) * SX8); \
            q8.z = gm::pk_fp8x4(bflo(xc.x) * SX8, bfhi(xc.x) * SX8, bflo(xc.y) * SX8, bfhi(xc.y) * SX8); q8.w = gm::pk_fp8x4(bflo(xc.z) * SX8, bfhi(xc.z) * SX8, bflo(xc.w) * SX8, bfhi(xc.w) * SX8); \
            *(u32x4*)(x8rows + (size_t)t * D + 16 * g + 64 * (S_)) = q8; } \
        _Pragma("unroll") for (int nb = 0; nb < NBK; ++nb) { \
            acc[nb] = __builtin_amdgcn_mfma_f32_16x16x32_bf16(h0##X[nb], fa, acc[nb], 0, 0, 0); acc[nb] = __builtin_amdgcn_mfma_f32_16x16x32_bf16(h1##X[nb], fc, acc[nb], 0, 0, 0); \
            acc[nb] = __builtin_amdgcn_mfma_f32_16x16x32_bf16(l0##X[nb], fa, acc[nb], 0, 0, 0); acc[nb] = __builtin_amdgcn_mfma_f32_16x16x32_bf16(l1##X[nb], fc, acc[nb], 0, 0, 0); } } while (0)
    u32x4 xaA, xcA, xaB, xcB; bf16x8 h0A[NBK], h1A[NBK], l0A[NBK], l1A[NBK], h0B[NBK], h1B[NBK], l0B[NBK], l1B[NBK];
    SK_LOAD(A, 0);
#pragma unroll 1
    for (int S = 0; S < 32; S += 2) {
        SK_LOAD(B, S + 1);
        SK_COMP(A, S);
        if (S + 2 < 32) SK_LOAD(A, S + 2);
        SK_COMP(B, S + 1);
    }
#undef SK_LOAD
#undef SK_COMP
    s += __shfl_xor(s, 16); s += __shfl_xor(s, 32); ss = s;
}
__device__ __forceinline__ void gates_phase(const Ctx& C, int w0, int nw) {
    const bf16_t* xb = WSP(bf16_t, WS_S0); const bf16_t* wg = WSP(bf16_t, WS_MISC + MS_WG); const float* rstd0 = WSP(float, WS_RSTD); float* gates = WSP(float, WS_GATES);
    const int lane = C.lane, t = lane & 15, g = lane >> 4;
    for (int tile = w0; tile < T / 16; tile += nw) {
        f32x4 acc[1]; float ss; skinny16<1>(xb + (size_t)tile * 16 * D, wg, wg + 16 * 2048, acc, ss, lane);
        const int tok = tile * 16 + t; const float rs = rstd0[tok];
        if (g < 3) { f32x4 o;
#pragma unroll
            for (int r = 0; r < 4; ++r) o[r] = acc[0][r] * rs + C.in(9)[4 * g + r];
            *(f32x4*)(gates + (size_t)tok * 16 + 4 * g) = o; }
    }
}
__device__ __forceinline__ void router_logits(const Ctx& C, const bf16_t* xrows, const bf16_t* whi, const bf16_t* wlo, LAS unsigned char* Wb, f32x4 (&acc)[3], float& ss, unsigned char* x8rows) {
    const int lane = C.lane, tid = C.tid, t = lane & 15, g = lane >> 4;
    const bf16_t* xp = xrows + (size_t)t * D + 16 * g;
#pragma unroll
    for (int nb = 0; nb < 3; ++nb) acc[nb] = (f32x4){0.f, 0.f, 0.f, 0.f};
    float s = 0.f;
    u32x4 wreg[6];
#define RL_WLOAD(c_) do { _Pragma("unroll") for (int j = 0; j < 6; ++j) { const int p = tid + 512 * j, hl = p / 1536, rem = p % 1536, n = rem >> 5, q = rem & 31; \
        wreg[j] = *(const u32x4*)((hl ? wlo : whi) + (size_t)n * D + 256 * (c_) + 8 * q); } } while (0)
    RL_WLOAD(0);
#pragma unroll 1
    for (int c = 0; c < 8; ++c) {
        u32x4 xa[4], xc[4];
#pragma unroll
        for (int S = 0; S < 4; ++S) { xa[S] = *(const u32x4*)(xp + 256 * c + 64 * S); xc[S] = *(const u32x4*)(xp + 256 * c + 64 * S + 8); }
        __syncthreads();
#pragma unroll
        for (int j = 0; j < 6; ++j) { const int p = tid + 512 * j, hl = p / 1536, rem = p % 1536, n = rem >> 5, q = rem & 31; *(LAS u32x4*)(Wb + hl * (48 * 528) + n * 528 + q * 16) = wreg[j]; }
        if (c + 1 < 8) RL_WLOAD(c + 1);
        __syncthreads();
#pragma unroll
        for (int S = 0; S < 4; ++S) {
            const u32x4 a = xa[S], b = xc[S];
            s += (bflo(a.x) * bflo(a.x) + bfhi(a.x) * bfhi(a.x)) + (bflo(a.y) * bflo(a.y) + bfhi(a.y) * bfhi(a.y)) + (bflo(a.z) * bflo(a.z) + bfhi(a.z) * bfhi(a.z)) + (bflo(a.w) * bflo(a.w) + bfhi(a.w) * bfhi(a.w));
            s += (bflo(b.x) * bflo(b.x) + bfhi(b.x) * bfhi(b.x)) + (bflo(b.y) * bflo(b.y) + bfhi(b.y) * bfhi(b.y)) + (bflo(b.z) * bflo(b.z) + bfhi(b.z) * bfhi(b.z)) + (bflo(b.w) * bflo(b.w) + bfhi(b.w) * bfhi(b.w));
            const bf16x8 fa = __builtin_bit_cast(bf16x8, a), fc = __builtin_bit_cast(bf16x8, b);
            { u32x4 q8; q8.x = gm::pk_fp8x4(bflo(a.x) * SX8, bfhi(a.x) * SX8, bflo(a.y) * SX8, bfhi(a.y) * SX8); q8.y = gm::pk_fp8x4(bflo(a.z) * SX8, bfhi(a.z) * SX8, bflo(a.w) * SX8, bfhi(a.w) * SX8);
              q8.z = gm::pk_fp8x4(bflo(b.x) * SX8, bfhi(b.x) * SX8, bflo(b.y) * SX8, bfhi(b.y) * SX8); q8.w = gm::pk_fp8x4(bflo(b.z) * SX8, bfhi(b.z) * SX8, bflo(b.w) * SX8, bfhi(b.w) * SX8);
              *(u32x4*)(x8rows + (size_t)t * D + 16 * g + 256 * c + 64 * S) = q8; }
#pragma unroll
            for (int nb = 0; nb < 3; ++nb) { const LAS unsigned char* wp = Wb + (16 * nb + t) * 528 + (64 * S + 16 * g) * 2;
                const bf16x8 h0 = *(const LAS bf16x8*)wp, h1 = *(const LAS bf16x8*)(wp + 16), l0 = *(const LAS bf16x8*)(wp + 48 * 528), l1 = *(const LAS bf16x8*)(wp + 48 * 528 + 16);
                acc[nb] = __builtin_amdgcn_mfma_f32_16x16x32_bf16(h0, fa, acc[nb], 0, 0, 0); acc[nb] = __builtin_amdgcn_mfma_f32_16x16x32_bf16(h1, fc, acc[nb], 0, 0, 0);
                acc[nb] = __builtin_amdgcn_mfma_f32_16x16x32_bf16(l0, fa, acc[nb], 0, 0, 0); acc[nb] = __builtin_amdgcn_mfma_f32_16x16x32_bf16(l1, fc, acc[nb], 0, 0, 0); }
        }
    }
#undef RL_WLOAD
    s += __shfl_xor(s, 16); s += __shfl_xor(s, 32); ss = s;
}
__device__ __forceinline__ void router_phase(const Ctx& C, int layer, const bf16_t* xb, float* rstd_out, int cslot) {
    const bf16_t* whi = WSP(bf16_t, WS_MISC + MS_WR) + (size_t)layer * 2 * 48 * 2048; const bf16_t* wlo = whi + 48 * 2048;
    const float* bg = C.in(22) + layer * NG; const float* be = C.in(24) + layer * NE;
    int* ltok = WSP(int, WS_LIST); float* lw = WSP(float, WS_LIST + 4 * MiB); float* lrs = WSP(float, WS_LIST + 8 * MiB); int* tokslot = WSP(int, WS_LIST + 12 * MiB);
    unsigned* cw = (unsigned*)(C.ws + WS_CTL) + CW_CNT + cslot * 32 * 64;
    LAS float* scr = (LAS float*)(C.lds + C.wave * 3200); LAS int* lcnt = (LAS int*)(C.lds + 25600); LAS int* lbase = lcnt + 32;
    const int lane = C.lane, t = lane & 15, g = lane >> 4;
    for (int tile = C.bid; tile < T / 128; tile += C.G) {
        if (C.tid < 32) lcnt[C.tid] = 0;
        __syncthreads();
        const int tok0 = tile * 128 + C.wave * 16;
        f32x4 acc[3]; float ss; router_logits(C, xb + (size_t)tok0 * D, whi, wlo, C.lds + 26112, acc, ss, C.ws + WS_X8 + (size_t)tok0 * D);
#pragma unroll
        for (int nb = 0; nb < 3; ++nb)
#pragma unroll
            for (int r = 0; r < 4; ++r) scr[t * 49 + 16 * nb + 4 * g + r] = acc[nb][r];
        LDS_WAIT(); asm volatile("" ::: "memory");
        int e1 = 0, e2 = 0, lp1 = 0, lp2 = 0; float w1 = 0.f, w2 = 0.f, rs = 0.f;
        if (lane < 16) {
            rs = 1.0f / sqrtf(ss * (1.f / D) + EPS);
            const LAS float* row = scr + lane * 49;
            float lg0 = row[0] * rs + bg[0], lg1 = row[1] * rs + bg[1], lg2 = row[2] * rs + bg[2], lg3 = row[3] * rs + bg[3];
            int gi = 0; float gm = lg0; if (lg1 > gm) { gm = lg1; gi = 1; } if (lg2 > gm) { gm = lg2; gi = 2; } if (lg3 > gm) { gm = lg3; gi = 3; }
            const float gsum = expf(lg0 - gm) + expf(lg1 - gm) + expf(lg2 - gm) + expf(lg3 - gm); const float gw = 1.0f / gsum;
            float le[8];
#pragma unroll
            for (int i = 0; i < 8; ++i) le[i] = row[4 + 8 * gi + i] * rs + be[8 * gi + i];
            int i1 = 0; float m1 = le[0];
#pragma unroll
            for (int i = 1; i < 8; ++i) if (le[i] > m1) { m1 = le[i]; i1 = i; }
            int i2 = -1; float m2 = -INFINITY;
#pragma unroll
            for (int i = 0; i < 8; ++i) if (i != i1 && le[i] > m2) { m2 = le[i]; i2 = i; }
            const float d = expf(m2 - m1); const float ew1 = 1.0f / (1.0f + d), ew2 = d / (1.0f + d);
            e1 = 8 * gi + i1; e2 = 8 * gi + i2; w1 = gw * ew1; w2 = gw * ew2;
            lp1 = atomicAdd((int*)(lcnt + e1), 1); lp2 = atomicAdd((int*)(lcnt + e2), 1);
            rstd_out[tok0 + lane] = rs;
        }
        __syncthreads();
        if (C.tid < 32) { const int c = lcnt[C.tid]; int b = 0; if (c > 0) b = (int)__hip_atomic_fetch_add(cw + C.tid * 64, (unsigned)c, __ATOMIC_RELAXED, __HIP_MEMORY_SCOPE_AGENT); lbase[C.tid] = b; }
        __syncthreads();
        if (lane < 16) { const int tok = tok0 + lane; const int p1 = lbase[e1] + lp1, p2 = lbase[e2] + lp2;
            ltok[(size_t)e1 * T + p1] = tok; lw[(size_t)e1 * T + p1] = w1; lrs[(size_t)e1 * T + p1] = rs;
            ltok[(size_t)e2 * T + p2] = tok; lw[(size_t)e2 * T + p2] = w2; lrs[(size_t)e2 * T + p2] = rs;
            tokslot[2 * tok] = (e1 << 16) | p1; tokslot[2 * tok + 1] = (e2 << 16) | p2; }
    }
}
template <bool F32OUT>
__device__ __forceinline__ void combine_phase(const Ctx& C, const bf16_t* xold, const bf16_t* yb, bf16_t* xnew, float* rstd_out, float* outf) {
    LAS int* tb = moe_tb(C.lds); const int* tokslot = WSP(int, WS_LIST + 12 * MiB);
    const int gw = C.vcu * 8 + C.wave, NGW = C.G * 8, lane = C.lane;
    int tok = gw; if (tok >= T) return;
    int s0 = tokslot[2 * tok], s1 = tokslot[2 * tok + 1];
#pragma unroll 1
    for (; tok < T; tok += NGW) {
        const size_t r0 = (size_t)tb[s0 >> 16] * 256 + (s0 & 0xffff), r1 = (size_t)tb[s1 >> 16] * 256 + (s1 & 0xffff);
        const u32x4* px = (const u32x4*)(xold + (size_t)tok * D) + lane; const u32x2* p0 = (const u32x2*)((const unsigned char*)yb + r0 * D) + lane; const u32x2* p1 = (const u32x2*)((const unsigned char*)yb + r1 * D) + lane;
        u32x4 a[4]; u32x2 b[4], c[4];
#pragma unroll
        for (int j = 0; j < 4; ++j) { a[j] = px[64 * j]; b[j] = p0[64 * j]; c[j] = p1[64 * j]; }
        const int tn = tok + NGW; if (tn < T) { s0 = tokslot[2 * tn]; s1 = tokslot[2 * tn + 1]; }
        __builtin_amdgcn_sched_barrier(0);
        float ss = 0.f;
#pragma unroll
        for (int j = 0; j < 4; ++j) { float v[8];
            const f32x2 b0 = __builtin_amdgcn_cvt_pk_f32_fp8((int)b[j].x, false), b1 = __builtin_amdgcn_cvt_pk_f32_fp8((int)b[j].x, true), b2 = __builtin_amdgcn_cvt_pk_f32_fp8((int)b[j].y, false), b3 = __builtin_amdgcn_cvt_pk_f32_fp8((int)b[j].y, true);
            const f32x2 c0 = __builtin_amdgcn_cvt_pk_f32_fp8((int)c[j].x, false), c1 = __builtin_amdgcn_cvt_pk_f32_fp8((int)c[j].x, true), c2 = __builtin_amdgcn_cvt_pk_f32_fp8((int)c[j].y, false), c3 = __builtin_amdgcn_cvt_pk_f32_fp8((int)c[j].y, true);
            constexpr float iy = 1.0f / SY8;
            v[0] = bflo(a[j].x) + (b0.x + c0.x) * iy; v[1] = bfhi(a[j].x) + (b0.y + c0.y) * iy; v[2] = bflo(a[j].y) + (b1.x + c1.x) * iy; v[3] = bfhi(a[j].y) + (b1.y + c1.y) * iy;
            v[4] = bflo(a[j].z) + (b2.x + c2.x) * iy; v[5] = bfhi(a[j].z) + (b2.y + c2.y) * iy; v[6] = bflo(a[j].w) + (b3.x + c3.x) * iy; v[7] = bfhi(a[j].w) + (b3.y + c3.y) * iy;
            if (F32OUT) { float* o = outf + (size_t)tok * D + (64 * j + lane) * 8; *(f32x4*)o = (f32x4){v[0], v[1], v[2], v[3]}; *(f32x4*)(o + 4) = (f32x4){v[4], v[5], v[6], v[7]}; }
            else { u32x4 w; w.x = cvtpk(v[0], v[1]); w.y = cvtpk(v[2], v[3]); w.z = cvtpk(v[4], v[5]); w.w = cvtpk(v[6], v[7]);
                ss += (bflo(w.x) * bflo(w.x) + bfhi(w.x) * bfhi(w.x)) + (bflo(w.y) * bflo(w.y) + bfhi(w.y) * bfhi(w.y)) + (bflo(w.z) * bflo(w.z) + bfhi(w.z) * bfhi(w.z)) + (bflo(w.w) * bflo(w.w) + bfhi(w.w) * bfhi(w.w));
                ((u32x4*)(xnew + (size_t)tok * D) + lane)[64 * j] = w;
                u32x2 w8; w8.x = gm::pk_fp8x4(v[0] * SX8, v[1] * SX8, v[2] * SX8, v[3] * SX8); w8.y = gm::pk_fp8x4(v[4] * SX8, v[5] * SX8, v[6] * SX8, v[7] * SX8);
                ((u32x2*)(C.ws + WS_X8 + (size_t)tok * D) + lane)[64 * j] = w8; } }
        if (!F32OUT) { ss = wave_sum(ss); if (lane == 0) rstd_out[tok] = 1.0f / sqrtf(ss * (1.f / D) + EPS); }
    }
}
__device__ __forceinline__ float logsigmoidf(float f) { return fminf(f, 0.f) - log1pf(expf(-fabsf(f))); }
__device__ __forceinline__ float wave_incl_sum(float v, int lane) {
#pragma unroll
    for (int o = 1; o < 64; o <<= 1) { const float t = __shfl_up(v, o); if (lane >= o) v += t; }
    return v;
}
__device__ __forceinline__ float wave_incl_max(float v, int lane) {
#pragma unroll
    for (int o = 1; o < 64; o <<= 1) { const float t = __shfl_up(v, o); if (lane >= o) v = fmaxf(v, t); }
    return v;
}
__device__ __forceinline__ float wave_max(float v) {
#pragma unroll
    for (int o = 1; o < 64; o <<= 1) v = fmaxf(v, __shfl_xor(v, o));
    return v;
}
constexpr int LROW = 272;
__device__ __forceinline__ void mlstm_a(const Ctx& C) {
    const float* gates = WSP(float, WS_GATES); const bf16_t* Kn = WSP(bf16_t, WS_BIG + BG_KN); const bf16_t* VT = WSP(bf16_t, WS_BIG + BG_VT);
    bf16_t* dCT = WSP(bf16_t, WS_BIG + BG_DCT); float* bl = WSP(float, WS_MISC + MS_BL); float* ml = WSP(float, WS_MISC + MS_ML); float* dn = WSP(float, WS_MISC + MS_DN);
    LAS unsigned char* KwT = C.lds; LAS float* wst = (LAS float*)(C.lds + 128 * LROW);
    float* gsa = WSP(float, WS_ROPE); float* gsb = gsa + 24 * LNC * 128; float* gspm = gsb + 24 * LNC * 128;
    const int tid = C.tid, lane = C.lane, wave = C.wave, fr = lane & 15, g = lane >> 4;
    for (int u = C.bid; u < 24 * LNC; u += C.G) {
        const int bh = u >> 6, j = u & 63, b = bh / LH, h = bh % LH; const size_t tok0 = (size_t)b * SEQ + j * LCH;
        if (wave == 0) {
            const float* gp = gates + (tok0 + 2 * lane) * 16;
            const float i0 = gp[h], i1 = gp[16 + h], x0 = logsigmoidf(gp[6 + h]), x1 = logsigmoidf(gp[16 + 6 + h]);
            const float ps = x0 + x1, incl = wave_incl_sum(ps, lane), excl = incl - ps, b0 = excl + x0, b1 = excl + ps;
            const float blast = __shfl(incl, 63);
            const float st0 = blast - b0 + i0, st1 = blast - b1 + i1; const float mloc = wave_max(fmaxf(st0, st1));
            wst[2 * lane] = expf(st0 - mloc); wst[2 * lane + 1] = expf(st1 - mloc);
            if (lane == 0) { bl[u] = blast; ml[u] = mloc; }
            { const float a0 = i0 - b0, a1 = i1 - b1; const float pmx = wave_incl_max(fmaxf(a0, a1), lane); const float pprev = __shfl_up(pmx, 1); const float pm0 = lane > 0 ? fmaxf(pprev, a0) : a0;
              *(f32x2*)(gsa + (size_t)u * 128 + 2 * lane) = (f32x2){a0, a1}; *(f32x2*)(gsb + (size_t)u * 128 + 2 * lane) = (f32x2){b0, b1}; *(f32x2*)(gspm + (size_t)u * 128 + 2 * lane) = (f32x2){pm0, pmx}; }
        }
        __syncthreads();
        { const int s = tid >> 2, dq = tid & 3; const float w = wst[s]; const bf16_t* kp = Kn + (tok0 + s) * 768 + h * 128 + dq * 32;
#pragma unroll
          for (int i = 0; i < 4; ++i) { const u32x4 kv = *(const u32x4*)(kp + 8 * i); const unsigned kw[4] = {kv.x, kv.y, kv.z, kv.w};
#pragma unroll
              for (int q = 0; q < 4; ++q) { const int d = dq * 32 + 8 * i + 2 * q; const unsigned pk = cvtpk(bflo(kw[q]) * w, bfhi(kw[q]) * w);
                  *(LAS unsigned short*)(KwT + d * LROW + s * 2) = (unsigned short)(pk & 0xffffu); *(LAS unsigned short*)(KwT + (d + 1) * LROW + s * 2) = (unsigned short)(pk >> 16); } } }
        __syncthreads();
        if (tid < 128) { float s = 0.f;
#pragma unroll
            for (int i = 0; i < 16; ++i) { const u32x4 v = *(const LAS u32x4*)(KwT + tid * LROW + i * 16); s += (bflo(v.x) + bfhi(v.x)) + (bflo(v.y) + bfhi(v.y)) + (bflo(v.z) + bfhi(v.z)) + (bflo(v.w) + bfhi(v.w)); }
            dn[(size_t)u * 128 + tid] = s; }
        bf16x8 vf[2][4];
#pragma unroll
        for (int vi = 0; vi < 2; ++vi)
#pragma unroll
            for (int ks = 0; ks < 4; ++ks) vf[vi][ks] = *(const bf16x8*)(VT + ((size_t)bh * LDV + 16 * (2 * wave + vi) + fr) * SEQ + j * LCH + 32 * ks + 8 * g);
#pragma unroll
        for (int db = 0; db < 8; ++db) {
            bf16x8 kf[4];
#pragma unroll
            for (int ks = 0; ks < 4; ++ks) kf[ks] = *(const LAS bf16x8*)(KwT + (16 * db + fr) * LROW + (32 * ks + 8 * g) * 2);
#pragma unroll
            for (int vi = 0; vi < 2; ++vi) { f32x4 a = {0.f, 0.f, 0.f, 0.f};
#pragma unroll
                for (int ks = 0; ks < 4; ++ks) a = __builtin_amdgcn_mfma_f32_16x16x32_bf16(kf[ks], vf[vi][ks], a, 0, 0, 0);
                u32x2 w; w.x = cvtpk(a[0], a[1]); w.y = cvtpk(a[2], a[3]);
                *(u32x2*)(dCT + (((size_t)u * LDV) + 16 * (2 * wave + vi) + fr) * 128 + 16 * db + 4 * g) = w; }
        }
        __syncthreads();
    }
}
__device__ __forceinline__ void mlstm_b(const Ctx& C) {
    const bf16_t* dCT = WSP(bf16_t, WS_BIG + BG_DCT); bf16_t* CT = WSP(bf16_t, WS_BIG + BG_CT);
    const float* bl = WSP(float, WS_MISC + MS_BL); const float* ml = WSP(float, WS_MISC + MS_ML); float* mst = WSP(float, WS_MISC + MS_MST);
    const float* dn = WSP(float, WS_MISC + MS_DN); float* nst = WSP(float, WS_MISC + MS_NST);
    LAS float* sdec = (LAS float*)C.lds; LAS float* swg = sdec + 64; LAS float* sbl = sdec + 128; LAS float* sml = sdec + 192;
    const int tid = C.tid;
    for (int blk = C.vcu; blk < 24 * 8; blk += C.G) {
        const int bh = blk >> 3;
        if (tid < 64) { sbl[tid] = bl[bh * LNC + tid]; sml[tid] = ml[bh * LNC + tid]; }
        __syncthreads();
        if (tid == 0) { float m = 0.f;
            for (int j = 0; j < LNC; ++j) { if ((blk & 7) == 0) mst[bh * LNC + j] = m; const float mn = fmaxf(sbl[j] + m, sml[j]); sdec[j] = expf(sbl[j] + m - mn); swg[j] = expf(sml[j] - mn); m = mn; } }
        __syncthreads();
        const size_t base = (size_t)bh * LNC * 4096 + (blk & 7) * 512 + tid;
        float c[8] = {0.f, 0.f, 0.f, 0.f, 0.f, 0.f, 0.f, 0.f};
        u32x4 dr[8];
#pragma unroll
        for (int i = 0; i < 8; ++i) dr[i] = *((const u32x4*)dCT + base + (size_t)i * 4096);
#pragma unroll 1
        for (int j0 = 0; j0 < LNC; j0 += 8) {
#pragma unroll
            for (int i = 0; i < 8; ++i) { const int j = j0 + i; const u32x4 dv = dr[i];
                if (j + 8 < LNC) dr[i] = *((const u32x4*)dCT + base + (size_t)(j + 8) * 4096);
                u32x4 o; o.x = cvtpk(c[0], c[1]); o.y = cvtpk(c[2], c[3]); o.z = cvtpk(c[4], c[5]); o.w = cvtpk(c[6], c[7]);
                *((u32x4*)CT + base + (size_t)j * 4096) = o;
                const float dec = sdec[j], wg = swg[j];
                c[0] = dec * c[0] + wg * bflo(dv.x); c[1] = dec * c[1] + wg * bfhi(dv.x); c[2] = dec * c[2] + wg * bflo(dv.y); c[3] = dec * c[3] + wg * bfhi(dv.y);
                c[4] = dec * c[4] + wg * bflo(dv.z); c[5] = dec * c[5] + wg * bfhi(dv.z); c[6] = dec * c[6] + wg * bflo(dv.w); c[7] = dec * c[7] + wg * bfhi(dv.w); }
        }
        if (tid < 16) { const int d = (blk & 7) * 16 + tid; float n = 0.f; const float* dp = dn + (size_t)bh * LNC * 128 + d; float* np = nst + (size_t)bh * LNC * 128 + d;
            float dq[16];
#pragma unroll
            for (int i = 0; i < 16; ++i) dq[i] = dp[(size_t)i * 128];
#pragma unroll 1
            for (int j0 = 0; j0 < LNC; j0 += 16) {
#pragma unroll
                for (int i = 0; i < 16; ++i) { const int j = j0 + i; const float dv = dq[i]; if (j + 16 < LNC) dq[i] = dp[(size_t)(j + 16) * 128]; np[(size_t)j * 128] = n; n = sdec[j] * n + swg[j] * dv; } } }
        __syncthreads();
    }
}
__device__ __forceinline__ void mlstm_c(const Ctx& C) {
    const bf16_t* Qn = WSP(bf16_t, WS_BIG + BG_QN); const bf16_t* Kn = WSP(bf16_t, WS_BIG + BG_KN); const bf16_t* VT = WSP(bf16_t, WS_BIG + BG_VT);
    const bf16_t* On = WSP(bf16_t, WS_BIG + BG_ON); const bf16_t* CT = WSP(bf16_t, WS_BIG + BG_CT); const float* mst = WSP(float, WS_MISC + MS_MST); const float* nst = WSP(float, WS_MISC + MS_NST);
    bf16_t* cat = WSP(bf16_t, WS_S1); const float* gsa = WSP(float, WS_ROPE); const float* gsb = gsa + 24 * LNC * 128; const float* gspm = gsb + 24 * LNC * 128;
    LAS unsigned char* VTs = C.lds; LAS unsigned char* CTs = C.lds + 256 * LROW; LAS float* sa = (LAS float*)(C.lds + 512 * LROW); LAS float* sb = sa + 128; LAS float* spm = sb + 128; LAS float* sn = spm + 128;
    const int tid = C.tid, lane = C.lane, wave = C.wave, fr = lane & 15, g = lane >> 4;
    for (int u = C.bid; u < 24 * LNC; u += C.G) {
        const int bh = u >> 6, j = u & 63, b = bh / LH, h = bh % LH; const size_t tok0 = (size_t)b * SEQ + j * LCH;
        { const int q = tid >> 7, e = tid & 127; const float* src = q == 0 ? gsa : q == 1 ? gsb : q == 2 ? gspm : nst; LAS float* dst = q == 0 ? sa : q == 1 ? sb : q == 2 ? spm : sn;
          const int v = tid >> 1, hf = tid & 1; const bf16_t* vp = VT + ((size_t)bh * LDV + v) * SEQ + j * LCH + hf * 64; const bf16_t* cq = CT + ((size_t)u * LDV + v) * 128 + hf * 64;
          const float sv = src[(size_t)u * 128 + e]; u32x4 cc[8], vv[8];
#pragma unroll
          for (int i = 0; i < 8; ++i) { vv[i] = *(const u32x4*)(vp + 8 * i); cc[i] = *(const u32x4*)(cq + 8 * i); }
          __builtin_amdgcn_sched_barrier(0);
          dst[e] = sv;
#pragma unroll
          for (int i = 0; i < 8; ++i) { *(LAS u32x4*)(VTs + v * LROW + (hf * 64 + 8 * i) * 2) = vv[i]; *(LAS u32x4*)(CTs + v * LROW + (hf * 64 + 8 * i) * 2) = cc[i]; } }
        __syncthreads();
        {
            const int t = 16 * wave + fr; const size_t tok = tok0 + t;
            const float mprev = mst[u]; const float Mt = fmaxf(mprev, spm[t]); const float bt = sb[t]; const float winter = expf(mprev - Mt); const float mt = bt + Mt;
            bf16x8 bq[4]; float qn = 0.f;
#pragma unroll
            for (int ks = 0; ks < 4; ++ks) { const u32x4 qv = *(const u32x4*)(Qn + tok * 768 + h * 128 + 32 * ks + 8 * g); bq[ks] = __builtin_bit_cast(bf16x8, qv);
                const LAS float* np = sn + 32 * ks + 8 * g;
                qn += bflo(qv.x) * np[0] + bfhi(qv.x) * np[1] + bflo(qv.y) * np[2] + bfhi(qv.y) * np[3] + bflo(qv.z) * np[4] + bfhi(qv.z) * np[5] + bflo(qv.w) * np[6] + bfhi(qv.w) * np[7]; }
            qn += __shfl_xor(qn, 16); qn += __shfl_xor(qn, 32);
            f32x4 acc[16];
#pragma unroll
            for (int vb = 0; vb < 16; ++vb) { f32x4 a = {0.f, 0.f, 0.f, 0.f};
#pragma unroll
                for (int ks = 0; ks < 4; ++ks) { const bf16x8 cf = *(const LAS bf16x8*)(CTs + (16 * vb + fr) * LROW + (32 * ks + 8 * g) * 2); a = __builtin_amdgcn_mfma_f32_16x16x32_bf16(cf, bq[ks], a, 0, 0, 0); }
                acc[vb] = a * winter; if ((vb & 3) == 3) asm volatile("" ::: "memory"); }
            f32x4 sw[8]; float den = 0.f;
#pragma unroll
            for (int kh = 0; kh < 2; ++kh) {
                bf16x8 kfr[4][4];
#pragma unroll
                for (int k4 = 0; k4 < 4; ++k4) if (kh * 4 + k4 <= wave) {
#pragma unroll
                    for (int ks = 0; ks < 4; ++ks) kfr[k4][ks] = *(const bf16x8*)(Kn + (tok0 + 16 * (kh * 4 + k4) + fr) * 768 + h * 128 + 32 * ks + 8 * g); }
                __builtin_amdgcn_sched_barrier(0);
#pragma unroll
                for (int k4 = 0; k4 < 4; ++k4) { const int kb = kh * 4 + k4;
                    f32x4 s = {0.f, 0.f, 0.f, 0.f};
                    if (kb <= wave) {
#pragma unroll
                        for (int ks = 0; ks < 4; ++ks) s = __builtin_amdgcn_mfma_f32_16x16x32_bf16(kfr[k4][ks], bq[ks], s, 0, 0, 0);
                        const f32x4 av = *(const LAS f32x4*)(sa + 16 * kb + 4 * g);
#pragma unroll
                        for (int r = 0; r < 4; ++r) { const int sidx = 16 * kb + 4 * g + r; const float wgt = sidx <= t ? expf(av[r] - Mt) : 0.f; s[r] *= wgt; den += s[r]; }
                    }
                    sw[kb] = s; }
                __builtin_amdgcn_sched_barrier(0);
            }
            den += __shfl_xor(den, 16); den += __shfl_xor(den, 32);
            den += winter * qn;
#pragma unroll
            for (int kp = 0; kp < 4; ++kp) {
                if (2 * kp <= wave) {
                    u32x4 pw; pw.x = cvtpk(sw[2 * kp][0], sw[2 * kp][1]); pw.y = cvtpk(sw[2 * kp][2], sw[2 * kp][3]); pw.z = cvtpk(sw[2 * kp + 1][0], sw[2 * kp + 1][1]); pw.w = cvtpk(sw[2 * kp + 1][2], sw[2 * kp + 1][3]);
                    const bf16x8 pb = __builtin_bit_cast(bf16x8, pw);
#pragma unroll
                    for (int vb = 0; vb < 16; ++vb) { const LAS unsigned char* vp = VTs + (16 * vb + fr) * LROW + (32 * kp + 4 * g) * 2;
                        u32x4 vw; const u32x2 lo = *(const LAS u32x2*)vp, hi = *(const LAS u32x2*)(vp + 32); vw.x = lo.x; vw.y = lo.y; vw.z = hi.x; vw.w = hi.y;
                        acc[vb] = __builtin_amdgcn_mfma_f32_16x16x32_bf16(__builtin_bit_cast(bf16x8, vw), pb, acc[vb], 0, 0, 0); }
                }
            }
            const float dinv = 1.0f / fmaxf(fabsf(den), expf(-mt));
            float ss = 0.f;
#pragma unroll
            for (int vb = 0; vb < 16; ++vb) { acc[vb] = acc[vb] * dinv; ss += (acc[vb][0] * acc[vb][0] + acc[vb][1] * acc[vb][1]) + (acc[vb][2] * acc[vb][2] + acc[vb][3] * acc[vb][3]); }
            ss += __shfl_xor(ss, 16); ss += __shfl_xor(ss, 32);
            const float rn = 1.0f / sqrtf(ss * (1.f / LDV) + EPS);
#pragma unroll
            for (int hv = 0; hv < 2; ++hv) {
                f32x4 gnv[8]; u32x2 owv[8];
#pragma unroll
                for (int i = 0; i < 8; ++i) { const int v = 16 * (hv * 8 + i) + 4 * g; gnv[i] = *(const f32x4*)(C.in(10) + h * LDV + v); owv[i] = *(const u32x2*)(On + tok * 1536 + h * LDV + v); }
                __builtin_amdgcn_sched_barrier(0);
#pragma unroll
                for (int i = 0; i < 8; ++i) { const int vb = hv * 8 + i; const int v = 16 * vb + 4 * g; const f32x4 gn = gnv[i]; const u32x2 ow = owv[i];
                    const f32x4 o = {acc[vb][0] * rn * gn[0] * bflo(ow.x), acc[vb][1] * rn * gn[1] * bfhi(ow.x), acc[vb][2] * rn * gn[2] * bflo(ow.y), acc[vb][3] * rn * gn[3] * bfhi(ow.y)};
                    u32x2 w; w.x = cvtpk(o[0], o[1]); w.y = cvtpk(o[2], o[3]);
                    *(u32x2*)(cat + tok * D + h * LDV + v) = w; }
            }
        }
        __syncthreads();
    }
}
constexpr int VROW = 528;
__device__ __forceinline__ void memattn_phase(const Ctx& C, int layer, const bf16_t* MQ, bf16_t* cat) {
    const float* mkv = WSP(float, WS_MEMKV) + (size_t)layer * 1024 * 1024; const float* qgain = C.in(6) + layer * MEMHD; const float* kgain = C.in(7) + layer * MEMHD;
    LAS unsigned char* Kms = C.lds; LAS unsigned char* VTm = C.lds + 256 * LROW;
    const int tid = C.tid, lane = C.lane, wave = C.wave, fr = lane & 15, g = lane >> 4;
    for (int u = C.bid; u < 256; u += C.G) {
        const int b = u >> 6, hh = (u >> 4) & 3, qc = u & 15;
        { const int slot = tid >> 1, hf = tid & 1; const float* kp = mkv + ((size_t)b * MEMS + slot) * 1024 + hh * MEMHD + hf * 64; const float* vp = kp + MEMW;
          f32x4 kv[16], vv[16]; float ss = 0.f;
#pragma unroll
          for (int i = 0; i < 16; ++i) { kv[i] = *(const f32x4*)(kp + 4 * i); vv[i] = *(const f32x4*)(vp + 4 * i); }
          __builtin_amdgcn_sched_barrier(0);
#pragma unroll
          for (int i = 0; i < 16; ++i) ss += (kv[i][0] * kv[i][0] + kv[i][1] * kv[i][1]) + (kv[i][2] * kv[i][2] + kv[i][3] * kv[i][3]);
          ss += __shfl_xor(ss, 1); const float rn = 1.0f / sqrtf(ss * (1.f / MEMHD) + EPS);
#pragma unroll
          for (int i = 0; i < 8; ++i) { const f32x4 g0 = *(const f32x4*)(kgain + hf * 64 + 8 * i), g1 = *(const f32x4*)(kgain + hf * 64 + 8 * i + 4);
              const f32x4 a = kv[2 * i] * rn * g0, c = kv[2 * i + 1] * rn * g1;
              u32x4 w; w.x = cvtpk(a[0], a[1]); w.y = cvtpk(a[2], a[3]); w.z = cvtpk(c[0], c[1]); w.w = cvtpk(c[2], c[3]);
              *(LAS u32x4*)(Kms + slot * LROW + (hf * 64 + 8 * i) * 2) = w; }
#pragma unroll
          for (int i = 0; i < 16; ++i) {
#pragma unroll
              for (int q = 0; q < 4; ++q) *(LAS unsigned short*)(VTm + (hf * 64 + 4 * i + q) * VROW + slot * 2) = f2bf(vv[i][q]); } }
        __syncthreads();
#pragma unroll 1
        for (int it = 0; it < 4; ++it) {
            const size_t tok = (size_t)b * SEQ + qc * 512 + wave * 64 + it * 16 + fr;
            u32x4 qv[4]; float ss = 0.f;
#pragma unroll
            for (int ks = 0; ks < 4; ++ks) { qv[ks] = *(const u32x4*)(MQ + tok * MEMW + hh * MEMHD + 32 * ks + 8 * g);
                ss += (bflo(qv[ks].x) * bflo(qv[ks].x) + bfhi(qv[ks].x) * bfhi(qv[ks].x)) + (bflo(qv[ks].y) * bflo(qv[ks].y) + bfhi(qv[ks].y) * bfhi(qv[ks].y))
                    + (bflo(qv[ks].z) * bflo(qv[ks].z) + bfhi(qv[ks].z) * bfhi(qv[ks].z)) + (bflo(qv[ks].w) * bflo(qv[ks].w) + bfhi(qv[ks].w) * bfhi(qv[ks].w)); }
            ss += __shfl_xor(ss, 16); ss += __shfl_xor(ss, 32);
            const float qs = (1.0f / sqrtf(ss * (1.f / MEMHD) + EPS)) * (0.08838834764831845f * LOG2E);
            bf16x8 bq[4];
#pragma unroll
            for (int ks = 0; ks < 4; ++ks) { const f32x4 g0 = *(const f32x4*)(qgain + 32 * ks + 8 * g), g1 = *(const f32x4*)(qgain + 32 * ks + 8 * g + 4); u32x4 w;
                w.x = cvtpk(bflo(qv[ks].x) * qs * g0[0], bfhi(qv[ks].x) * qs * g0[1]); w.y = cvtpk(bflo(qv[ks].y) * qs * g0[2], bfhi(qv[ks].y) * qs * g0[3]);
                w.z = cvtpk(bflo(qv[ks].z) * qs * g1[0], bfhi(qv[ks].z) * qs * g1[1]); w.w = cvtpk(bflo(qv[ks].w) * qs * g1[2], bfhi(qv[ks].w) * qs * g1[3]);
                bq[ks] = __builtin_bit_cast(bf16x8, w); }
            f32x4 sacc[16]; float mx = -INFINITY;
#pragma unroll
            for (int kb = 0; kb < 16; ++kb) { f32x4 s = {0.f, 0.f, 0.f, 0.f};
#pragma unroll
                for (int ks = 0; ks < 4; ++ks) { const bf16x8 kf = *(const LAS bf16x8*)(Kms + (16 * kb + fr) * LROW + (32 * ks + 8 * g) * 2); s = __builtin_amdgcn_mfma_f32_16x16x32_bf16(kf, bq[ks], s, 0, 0, 0); }
                sacc[kb] = s; mx = fmaxf(fmaxf(mx, fmaxf(s[0], s[1])), fmaxf(s[2], s[3])); asm volatile("" ::: "memory"); }
            mx = fmaxf(mx, __shfl_xor(mx, 16)); mx = fmaxf(mx, __shfl_xor(mx, 32));
            float sum = 0.f;
#pragma unroll
            for (int kb = 0; kb < 16; ++kb) {
#pragma unroll
                for (int r = 0; r < 4; ++r) { sacc[kb][r] = __builtin_amdgcn_exp2f(sacc[kb][r] - mx); sum += sacc[kb][r]; } }
            sum += __shfl_xor(sum, 16); sum += __shfl_xor(sum, 32);
            f32x4 oacc[8];
#pragma unroll
            for (int db = 0; db < 8; ++db) oacc[db] = (f32x4){0.f, 0.f, 0.f, 0.f};
#pragma unroll
            for (int kp = 0; kp < 8; ++kp) {
                u32x4 pw; pw.x = cvtpk(sacc[2 * kp][0], sacc[2 * kp][1]); pw.y = cvtpk(sacc[2 * kp][2], sacc[2 * kp][3]); pw.z = cvtpk(sacc[2 * kp + 1][0], sacc[2 * kp + 1][1]); pw.w = cvtpk(sacc[2 * kp + 1][2], sacc[2 * kp + 1][3]);
                const bf16x8 pb = __builtin_bit_cast(bf16x8, pw);
#pragma unroll
                for (int db = 0; db < 8; ++db) { const LAS unsigned char* vp = VTm + (16 * db + fr) * VROW + (32 * kp + 4 * g) * 2;
                    u32x4 vw; const u32x2 lo = *(const LAS u32x2*)vp, hi = *(const LAS u32x2*)(vp + 32); vw.x = lo.x; vw.y = lo.y; vw.z = hi.x; vw.w = hi.y;
                    oacc[db] = __builtin_amdgcn_mfma_f32_16x16x32_bf16(__builtin_bit_cast(bf16x8, vw), pb, oacc[db], 0, 0, 0); }
                asm volatile("" ::: "memory");
            }
            const float inv = 1.0f / sum;
#pragma unroll
            for (int db = 0; db < 8; ++db) { u32x2 w; w.x = cvtpk(oacc[db][0] * inv, oacc[db][1] * inv); w.y = cvtpk(oacc[db][2] * inv, oacc[db][3] * inv);
                if (layer == 1) *(unsigned*)((unsigned char*)cat + tok * D + 1536 + hh * MEMHD + 16 * db + 4 * g) = gm::pk_fp8x4(oacc[db][0] * inv * SC8, oacc[db][1] * inv * SC8, oacc[db][2] * inv * SC8, oacc[db][3] * inv * SC8);
                else *(u32x2*)(cat + tok * D + 1536 + hh * MEMHD + 16 * db + 4 * g) = w; }
        }
        __syncthreads();
    }
}
#include <hip/hip_bf16.h>
#include <cmath>
namespace attn_body {
using bf16=__hip_bfloat16;
using bf16x8=__attribute__((ext_vector_type(8)))short;
using s16x4=__attribute__((ext_vector_type(4)))short;
using f32x16=__attribute__((ext_vector_type(16)))float;
using u32x4=__attribute__((ext_vector_type(4)))unsigned;
constexpr int BATCH=4,NHEAD=12,SEQ=8192,D=64,DM=1536;
constexpr int NW=8,QBLK=32,QB=QBLK*NW,KVBLK=64,NQB=SEQ/QB;
constexpr int ATTN_PITCH=DM, ATTN_UNIT_ROWS=QB;
__device__ __forceinline__ int crow(int r,int hi){return (r&3)+8*(r>>2)+4*hi;}
#define SBAR() __builtin_amdgcn_sched_barrier(0)
__device__ __forceinline__ void cmask(f32x16&p0,f32x16&p1,int jb,int qrel,int hi){
  const float NEG=-INFINITY; int kb=64*jb+4*hi;
  #pragma unroll
  for(int r=0;r<16;++r){int kv=kb+(r&3)+8*(r>>2); if(kv>qrel)p0[r]=NEG; if(kv+32>qrel)p1[r]=NEG;}
}

constexpr int NSLOT=3, SLOTB=8192;
constexpr int LDS_K=0, LDS_V=NSLOT*SLOTB, LDS_WS=2*NSLOT*SLOTB, LDS_OST=LDS_WS+NW*64*4, LDS_BYTES=LDS_OST+NW*4096;
constexpr float C2=0.125f*1.4426950408889634f;
__device__ __forceinline__ void glds16(const void*gsrc,unsigned lds_dst){unsigned keep;
  asm volatile("s_mov_b32 %0, m0\n\ts_mov_b32 m0, %2\n\ts_nop 0\n\tglobal_load_lds_dwordx4 %1, off\n\ts_mov_b32 m0, %0":"=&s"(keep):"v"(gsrc),"s"(lds_dst):"memory");}
__device__ __forceinline__ float max3f(float a,float b,float c){float r;asm("v_max3_f32 %0, %1, %2, %3":"=v"(r):"v"(a),"v"(b),"v"(c));return r;}
__device__ __forceinline__ float max2f(float a,float b){float r;asm("v_max_f32_e32 %0, %1, %2":"=v"(r):"v"(a),"v"(b));return r;}
__device__ __forceinline__ float fadd_s(float a,float b){float r;asm("v_add_f32_e32 %0, %1, %2":"=v"(r):"v"(a),"v"(b));return r;}
__device__ __forceinline__ float fsub_s(float a,float b){float r;asm("v_sub_f32_e32 %0, %1, %2":"=v"(r):"v"(a),"v"(b));return r;}
typedef float f32x2_t __attribute__((ext_vector_type(2))); typedef __bf16 bf16x2_t __attribute__((ext_vector_type(2)));
__device__ __forceinline__ unsigned cvtpk_s(float lo,float hi){f32x2_t v={lo,hi};bf16x2_t b=__builtin_convertvector(v,bf16x2_t);return __builtin_bit_cast(unsigned,b);}
#define WAIT_BAR(N) asm volatile("s_waitcnt vmcnt(" #N ") lgkmcnt(0)\n\ts_barrier":::"memory")

__device__ __forceinline__ void qkt(f32x16&p0,f32x16&p1,const char*Kslot,const bf16x8*qr,const f32x16&negm,int r32,int hi){
  const char*kb=Kslot+hi*1024+r32*16;
  #pragma unroll
  for(int d0=0;d0<4;++d0){
    const bf16x8 b0=*reinterpret_cast<const bf16x8*>(kb+d0*2048);
    const bf16x8 b1=*reinterpret_cast<const bf16x8*>(kb+d0*2048+512);
    if(d0==0){p0=__builtin_amdgcn_mfma_f32_32x32x16_bf16(b0,qr[0],negm,0,0,0);p1=__builtin_amdgcn_mfma_f32_32x32x16_bf16(b1,qr[0],negm,0,0,0);}
    else{p0=__builtin_amdgcn_mfma_f32_32x32x16_bf16(b0,qr[d0],p0,0,0,0);p1=__builtin_amdgcn_mfma_f32_32x32x16_bf16(b1,qr[d0],p1,0,0,0);}}
}
typedef __attribute__((address_space(3))) const char* lds_cptr;
typedef short v4i16_t __attribute__((ext_vector_type(4)));
__device__ __forceinline__ void kload8(bf16x8*kf,lds_cptr kp){
  kf[0]=*(const __attribute__((address_space(3))) bf16x8*)(kp);      kf[1]=*(const __attribute__((address_space(3))) bf16x8*)(kp+512);
  kf[2]=*(const __attribute__((address_space(3))) bf16x8*)(kp+2048); kf[3]=*(const __attribute__((address_space(3))) bf16x8*)(kp+2560);
  kf[4]=*(const __attribute__((address_space(3))) bf16x8*)(kp+4096); kf[5]=*(const __attribute__((address_space(3))) bf16x8*)(kp+4608);
  kf[6]=*(const __attribute__((address_space(3))) bf16x8*)(kp+6144); kf[7]=*(const __attribute__((address_space(3))) bf16x8*)(kp+6656);
}
__device__ __forceinline__ void kload2(bf16x8*kf,lds_cptr kp,int j){ kf[2*j]=*(const __attribute__((address_space(3))) bf16x8*)(kp+j*2048); kf[2*j+1]=*(const __attribute__((address_space(3))) bf16x8*)(kp+j*2048+512); }
__device__ __forceinline__ s16x4 vtr(lds_cptr p){ return __builtin_bit_cast(s16x4,__builtin_amdgcn_ds_read_tr16_b64_v4i16((__attribute__((address_space(3))) v4i16_t*)p)); }
__device__ __forceinline__ float rowmax(const f32x16&p0,const f32x16&p1){
  float a=max3f(p0[0],p0[1],p1[0]),b=max3f(p0[2],p0[3],p1[1]);a=max3f(a,p1[2],p1[3]);
  #pragma unroll
  for(int r=4;r<16;r+=4){a=max3f(a,p0[r],p0[r+1]);b=max3f(b,p0[r+2],p0[r+3]);a=max3f(a,p1[r],p1[r+1]);b=max3f(b,p1[r+2],p1[r+3]);}
  const float m=max2f(a,b);
  auto rr=__builtin_amdgcn_permlane32_swap(__float_as_uint(m),__float_as_uint(m),false,false);
  return max2f(__uint_as_float(rr[0]),__uint_as_float(rr[1]));
}
__device__ __forceinline__ void pv(f32x16*o,int vb,bf16x8 pa0,bf16x8 pa1,bf16x8 pa2,bf16x8 pa3){
  #pragma unroll
  for(int d0=0;d0<2;++d0){s16x4 lo[4],hi[4];
    #pragma unroll
    for(int ks=0;ks<4;++ks){
      asm volatile("ds_read_b64_tr_b16 %0,%1 offset:%c2":"=&v"(lo[ks]):"v"(vb),"i"(d0*4096+ks*1024):"memory");
      asm volatile("ds_read_b64_tr_b16 %0,%1 offset:%c2":"=&v"(hi[ks]):"v"(vb),"i"(d0*4096+ks*1024+512):"memory");}
    asm volatile("s_waitcnt lgkmcnt(0)":::"memory");SBAR();
    #define PK(k) (bf16x8){lo[k][0],lo[k][1],lo[k][2],lo[k][3],hi[k][0],hi[k][1],hi[k][2],hi[k][3]}
    o[d0]=__builtin_amdgcn_mfma_f32_32x32x16_bf16(pa0,PK(0),o[d0],0,0,0);
    o[d0]=__builtin_amdgcn_mfma_f32_32x32x16_bf16(pa1,PK(1),o[d0],0,0,0);
    o[d0]=__builtin_amdgcn_mfma_f32_32x32x16_bf16(pa2,PK(2),o[d0],0,0,0);
    o[d0]=__builtin_amdgcn_mfma_f32_32x32x16_bf16(pa3,PK(3),o[d0],0,0,0);
    #undef PK
  }
}

#ifndef ATTN_STORE16
#define ATTN_STORE16(p,v) (*(u32x4*)(p)=(v))
#endif
template<int THRL> __device__ __forceinline__ void attn_unit(int b,int qcol,int vcol,int qb,const bf16*Q,const bf16*__restrict__ K,const bf16*__restrict__ V,bf16*O,char*shm){
  const int tid=threadIdx.x,lane=tid&63,r32=lane&31,hi=lane>>5; const int wid=__builtin_amdgcn_readfirstlane(tid>>6);
  const long rowbase=(long)b*SEQ; const int q0=qb*QB;
  const bf16*Qw=Q+(rowbase+q0+wid*QBLK)*DM+qcol;
  const bf16*Kh=K+rowbase*DM+qcol,*Vh=V+rowbase*DM+vcol;
  const unsigned lds0=(unsigned)(uintptr_t)shm;
  float*wsf=(float*)(shm+LDS_WS)+wid*64;
  const bf16*ksrc=Kh+(long)lane*DM+wid*8;
  const bf16*vsrc=Vh+(long)(16*(wid&3)+(lane>>2))*DM+(wid>>2)*32+(lane&3)*8;
  const unsigned kdst=lds0+LDS_K+wid*1024, vdst=lds0+LDS_V+wid*1024;
  #define DMA_K(t,slot) glds16(ksrc+(long)(t)*KVBLK*DM,(unsigned)__builtin_amdgcn_readfirstlane(kdst+(slot)))
  #define DMA_V(t,slot) glds16(vsrc+(long)(t)*KVBLK*DM,(unsigned)__builtin_amdgcn_readfirstlane(vdst+(slot)))
  const int vb0=(int)(lds0+LDS_V)+((lane>>4)&1)*32+(lane&3)*8+(4*hi+((lane&15)>>2))*64;
  const char*Kbase=shm+LDS_K; bf16x8 kf[8];
  const lds_cptr shm3=(lds_cptr)shm; const lds_cptr kp0=shm3+LDS_K+hi*1024+r32*16; const lds_cptr vp0=shm3+LDS_V+((lane>>4)&1)*32+(lane&3)*8+(4*hi+((lane&15)>>2))*64;
  const int NT=(q0+QB)/KVBLK;
  DMA_K(0,0);DMA_V(0,0);DMA_K(1,SLOTB);
  bf16x8 qr[4];
  #pragma unroll
  for(int d0=0;d0<4;++d0)qr[d0]=*reinterpret_cast<const bf16x8*>(&Qw[(long)r32*DM+d0*16+hi*8]);
  float mhat=0.f,l_reg=0.f;f32x16 o[2];o[0]=f32x16{};o[1]=f32x16{};f32x16 negm=f32x16{};asm volatile("":"+v"(negm));
  const int qrel=wid*QBLK+r32;
  #define CMASK(P0,P1,t) do{int jb_=(t)-(NT-4); if(jb_>=0)cmask(P0,P1,jb_,qrel,hi);}while(0)
  bool resc=false;
  #define START(P0,P1) do{ const float rm=rowmax(P0,P1); resc=false; \
    { const float dl=rm; mhat=fadd_s(mhat,dl); \
      _Pragma("unroll") for(int r=0;r<16;++r){P0[r]=fsub_s(P0[r],dl);P1[r]=fsub_s(P1[r],dl);} \
      _Pragma("unroll") for(int r=0;r<16;++r)negm[r]=-mhat; asm volatile("":"+v"(negm)); } \
    _Pragma("unroll") for(int r=0;r<16;++r)P0[r]=__builtin_amdgcn_exp2f(P0[r]); }while(0)
  #define RESC() do{ if(resc){ asm volatile("s_waitcnt lgkmcnt(0)":::"memory"); \
      _Pragma("unroll") for(int d_=0;d_<2;++d_) _Pragma("unroll") for(int r=0;r<16;++r)o[d_][r]*=wsf[crow(r,hi)]; } }while(0)
  f32x16 pA0,pA1,pB0,pB1;
  int sl_prev=0,sl_cur=0,sl_next=SLOTB;
  #define ROT() do{sl_prev=sl_cur;sl_cur=sl_next;sl_next=(sl_next==(NSLOT-1)*SLOTB)?0:sl_next+SLOTB;}while(0)
  DMA_K(2,2*SLOTB);
  WAIT_BAR(3);
  qkt(pA0,pA1,Kbase,qr,negm,r32,hi);asm volatile("s_nop 15\n\ts_nop 7":"+v"(pA0),"+v"(pA1));CMASK(pA0,pA1,0);
  START(pA0,pA1);
  _Pragma("unroll") for(int r=0;r<16;++r)pA1[r]=__builtin_amdgcn_exp2f(pA1[r]);
  WAIT_BAR(0);
  DMA_K(3,0);DMA_V(1,SLOTB);
  ROT();
  kload8(kf,kp0+sl_cur);
  WAIT_BAR(2);
  s16x4 vlo[8],vhi[8]; u32x4 pw0,pw1,pw2,pw3;
  #define PKW(P,B) cvtpk_s(P[B],P[B+1])
  #define PAF(k) __builtin_bit_cast(bf16x8,pw##k)
  #define VFR(i) (bf16x8){vlo[i][0],vlo[i][1],vlo[i][2],vlo[i][3],vhi[i][0],vhi[i][1],vhi[i][2],vhi[i][3]}
  #define PIN(x) asm volatile("":"+v"(x))
  #define MX3(a,b,c) __builtin_fmaxf(__builtin_fmaxf((a),(b)),(c))
  #define GAPA(MF,A0,A1,A2,A3,W0,W1,PW) do{ MF; sacc+=A0; sacc+=A1; sacc+=A2; sacc+=A3; PIN(sacc); W0; W1; PIN(PW); SBAR(); }while(0)
  #define EX(v) __builtin_amdgcn_exp2f(v)
  #define GAPB(MF,X,B) do{ MF; X[B]=EX(X[B]); X[B+1]=EX(X[B+1]); X[B+2]=EX(X[B+2]); X[B+3]=EX(X[B+3]); PIN(X); SBAR(); }while(0)
  #define VRD(i) do{ vlo[i]=vtr(vp_+(((i)>>2)*4096+((i)&3)*1024)); vhi[i]=vtr(vp_+(((i)>>2)*4096+((i)&3)*1024+512)); }while(0)
  #define KRD(G,j) do{ if(G){ kload2(kf,kp0+sl_next,j); SBAR(); } }while(0)
  #define STEP(C0,C1,P0,P1,t,GK,GV,GL) do{ SBAR(); \
    const lds_cptr vp_=vp0+sl_prev; \
    VRD(0); SBAR(); float sacc=(P0[0]+P0[1]); \
    GAPA(C0=__builtin_amdgcn_mfma_f32_32x32x16_bf16(kf[0],qr[0],negm,0,0,0), P0[2],P0[3],P0[4],P0[5],     pw0[0]=PKW(P0,0), pw0[1]=PKW(P0,2), pw0); \
    VRD(4); SBAR(); GAPA(C1=__builtin_amdgcn_mfma_f32_32x32x16_bf16(kf[1],qr[0],negm,0,0,0), P0[6],P0[7],P0[8],P0[9],     pw0[2]=PKW(P0,4), pw0[3]=PKW(P0,6), pw0); \
    VRD(1); SBAR(); GAPA(C0=__builtin_amdgcn_mfma_f32_32x32x16_bf16(kf[2],qr[1],C0,0,0,0),   P0[10],P0[11],P0[12],P0[13], pw1[0]=PKW(P0,8), pw1[1]=PKW(P0,10), pw1); \
    VRD(5); SBAR(); GAPA(C1=__builtin_amdgcn_mfma_f32_32x32x16_bf16(kf[3],qr[1],C1,0,0,0),   P0[14],P0[15],P1[0],P1[1],   pw1[2]=PKW(P0,12),pw1[3]=PKW(P0,14), pw1); \
    VRD(2); SBAR(); GAPA(C0=__builtin_amdgcn_mfma_f32_32x32x16_bf16(kf[4],qr[2],C0,0,0,0),   P1[2],P1[3],P1[4],P1[5],     pw2[0]=PKW(P1,0), pw2[1]=PKW(P1,2), pw2); \
    VRD(6); SBAR(); GAPA(C1=__builtin_amdgcn_mfma_f32_32x32x16_bf16(kf[5],qr[2],C1,0,0,0),   P1[6],P1[7],P1[8],P1[9],     pw2[2]=PKW(P1,4), pw2[3]=PKW(P1,6), pw2); \
    VRD(3); SBAR(); GAPA(C0=__builtin_amdgcn_mfma_f32_32x32x16_bf16(kf[6],qr[3],C0,0,0,0),   P1[10],P1[11],P1[12],P1[13], pw3[0]=PKW(P1,8), pw3[1]=PKW(P1,10), pw3); \
    VRD(7); SBAR(); GAPA(C1=__builtin_amdgcn_mfma_f32_32x32x16_bf16(kf[7],qr[3],C1,0,0,0),   P1[14],P1[15],0.f,0.f,       pw3[2]=PKW(P1,12),pw3[3]=PKW(P1,14), pw3); \
    l_reg+=sacc; \
    if(GK){DMA_K((t)+3,sl_cur);} if(GV){DMA_V((t)+1,sl_next);} \
    CMASK(C0,C1,t); \
    { float a=MX3(C0[0],C0[1],C1[0]),b=MX3(C0[2],C0[3],C1[1]); a=MX3(a,C1[2],C1[3]); \
      _Pragma("unroll") for(int r=4;r<16;r+=4){a=MX3(a,C0[r],C0[r+1]);b=MX3(b,C0[r+2],C0[r+3]);a=MX3(a,C1[r],C1[r+1]);b=MX3(b,C1[r+2],C1[r+3]);} \
      float rm=__builtin_fmaxf(a,b); { auto rr=__builtin_amdgcn_permlane32_swap(__float_as_uint(rm),__float_as_uint(rm),false,false); rm=__builtin_fmaxf(__uint_as_float(rr[0]),__uint_as_float(rr[1])); } \
      resc=false; \
      if(__builtin_expect(__any(rm>(float)THRL),0)){ const float dl=__builtin_fmaxf(rm,0.f); mhat+=dl; \
        _Pragma("unroll") for(int r=0;r<16;++r){C0[r]-=dl;C1[r]-=dl;} \
        _Pragma("unroll") for(int r=0;r<16;++r)negm[r]=-mhat; asm volatile("":"+v"(negm)); \
        const float f=__builtin_amdgcn_exp2f(-dl); l_reg*=f; if(hi==0)wsf[r32]=f; resc=true; } } \
    SBAR(); \
    GAPB(o[0]=__builtin_amdgcn_mfma_f32_32x32x16_bf16(PAF(0),VFR(0),o[0],0,0,0), C0,0); \
    GAPB(o[1]=__builtin_amdgcn_mfma_f32_32x32x16_bf16(PAF(0),VFR(4),o[1],0,0,0), C0,4); \
    KRD(GL,0); GAPB(o[0]=__builtin_amdgcn_mfma_f32_32x32x16_bf16(PAF(1),VFR(1),o[0],0,0,0), C0,8); \
    KRD(GL,1); GAPB(o[1]=__builtin_amdgcn_mfma_f32_32x32x16_bf16(PAF(1),VFR(5),o[1],0,0,0), C0,12); \
    KRD(GL,2); GAPB(o[0]=__builtin_amdgcn_mfma_f32_32x32x16_bf16(PAF(2),VFR(2),o[0],0,0,0), C1,0); \
    KRD(GL,3); GAPB(o[1]=__builtin_amdgcn_mfma_f32_32x32x16_bf16(PAF(2),VFR(6),o[1],0,0,0), C1,4); \
    GAPB(o[0]=__builtin_amdgcn_mfma_f32_32x32x16_bf16(PAF(3),VFR(3),o[0],0,0,0), C1,8); \
    GAPB(o[1]=__builtin_amdgcn_mfma_f32_32x32x16_bf16(PAF(3),VFR(7),o[1],0,0,0), C1,12); \
    }while(0)
  int t=1;
  #undef CMASK
  #define CMASK(P0,P1,t) do{}while(0)
  for(;t+5<NT;t+=2){
    STEP(pB0,pB1,pA0,pA1,t,true,true,true);     WAIT_BAR(2); RESC(); ROT();
    STEP(pA0,pA1,pB0,pB1,t+1,true,true,true);   WAIT_BAR(2); RESC(); ROT();
  }
  #undef CMASK
  #define CMASK(P0,P1,t) do{int jb_=(t)-(NT-4); if(jb_>=0)cmask(P0,P1,jb_,qrel,hi);}while(0)
  #define ENDW(tt) do{ if((tt)+3<NT){WAIT_BAR(2);} else if((tt)+2<NT){WAIT_BAR(1);} else {WAIT_BAR(0);} }while(0)
  for(;t+1<NT;t+=2){
    STEP(pB0,pB1,pA0,pA1,t,(t+3<NT),(t+1<NT),(t+1<NT));       ENDW(t);   RESC(); ROT();
    STEP(pA0,pA1,pB0,pB1,t+1,(t+4<NT),(t+2<NT),(t+2<NT));     ENDW(t+1); RESC(); ROT();
  }
  STEP(pB0,pB1,pA0,pA1,NT-1,false,false,false); RESC();
  { float sacc=pB0[0]+pB0[1]; _Pragma("unroll") for(int r=2;r<16;++r)sacc+=pB0[r]; _Pragma("unroll") for(int r=0;r<16;++r)sacc+=pB1[r]; l_reg+=sacc;
    pw0=(u32x4){PKW(pB0,0),PKW(pB0,2),PKW(pB0,4),PKW(pB0,6)};pw1=(u32x4){PKW(pB0,8),PKW(pB0,10),PKW(pB0,12),PKW(pB0,14)};pw2=(u32x4){PKW(pB1,0),PKW(pB1,2),PKW(pB1,4),PKW(pB1,6)};pw3=(u32x4){PKW(pB1,8),PKW(pB1,10),PKW(pB1,12),PKW(pB1,14)};
    SBAR(); pv(o,vb0+sl_cur,PAF(0),PAF(1),PAF(2),PAF(3)); }
  #undef PKW
  #undef PAF
  #undef VFR
  #undef PIN
  #undef MX3
  #undef GAPA
  #undef GAPB
  #undef EX
  #undef VRD
  #undef KRD
  #undef STEP
  #undef ENDW
  {auto rr=__builtin_amdgcn_permlane32_swap(__float_as_uint(l_reg),__float_as_uint(l_reg),false,false);l_reg=__uint_as_float(rr[0])+__uint_as_float(rr[1]);}
  if(hi==0)wsf[32+r32]=l_reg;asm volatile("s_waitcnt lgkmcnt(0)":::"memory");
  float rli[16];
  #pragma unroll
  for(int r=0;r<16;++r)rli[r]=__builtin_amdgcn_rcpf(wsf[32+crow(r,hi)]);
  bf16*Ow=O+(rowbase+q0+wid*QBLK)*DM+vcol;
  { bf16*stg=(bf16*)(shm+LDS_OST)+wid*2048;
    #pragma unroll
    for(int r=0;r<16;++r){const int orow=crow(r,hi);
      #pragma unroll
      for(int d0=0;d0<2;++d0)stg[orow*64+d0*32+r32]=__float2bfloat16(o[d0][r]*rli[r]);}
    asm volatile("s_waitcnt lgkmcnt(0)":::"memory");
    #pragma unroll
    for(int i=0;i<4;++i){const int row=i*8+(lane>>3),ch=lane&7; const u32x4 v=*(const u32x4*)(stg+row*64+ch*8); ATTN_STORE16(Ow+(long)row*DM+ch*8,v);} }
  asm volatile("s_waitcnt lgkmcnt(0)\n\ts_barrier":::"memory");
  #undef DMA_K
  #undef DMA_V
  #undef CMASK
  #undef START
  #undef RESC
  #undef ROT
}
constexpr int ATTN_LDS_BYTES=LDS_BYTES;
template<int THRL=8> __device__ __forceinline__ void diff_attn_phase(char*lds,const bf16*Q,const bf16*K,const bf16*V,bf16*O1,bf16*O2,int G,int bid,int vcu){
  const bool bal=(G==256);
  for(int i=0;;++i){
    int vhd,qb;
    if(bal){ if(i>=24)break; const int rr=i>>2,ii=i&3,s=vcu&7; vhd=rr*32+(vcu>>3); qb=(ii==0)?s:(ii==1)?15-s:(ii==2)?16+s:31-s; }
    else{ const int id=bid+i*G; if(id>=192*NQB)break; vhd=id/NQB; qb=NQB-1-(id%NQB); }
    const int vh=vhd&1,c=(vhd>>1)&1,bh=vhd>>2,b=bh/NHEAD,h=bh%NHEAD;
    attn_unit<THRL>(b,h*128+64*c,h*128+64*vh,qb,Q,K,V,c?O2:O1,lds);
  }
}
#undef SBAR
#undef WAIT_BAR
}
namespace attn2 {
using bf16=__hip_bfloat16;
using bf16x8=__attribute__((ext_vector_type(8)))short;
using s16x4=__attribute__((ext_vector_type(4)))short;
using f32x16=__attribute__((ext_vector_type(16)))float;
using u32x4=__attribute__((ext_vector_type(4)))unsigned;
constexpr int NHEAD=12,SEQ=8192,D=64,DM=1536,OPITCH=2048;
constexpr int NW=8,QBLK=32,QB=QBLK*NW,KVBLK=64,NQB=SEQ/QB;
__device__ __forceinline__ int crow(int r,int hi){return (r&3)+8*(r>>2)+4*hi;}
#define SBAR() __builtin_amdgcn_sched_barrier(0)
__device__ __forceinline__ void cmask(f32x16&p0,f32x16&p1,int jb,int qrel,int hi){
  const float NEG=-INFINITY; int kb=64*jb+4*hi;
  #pragma unroll
  for(int r=0;r<16;++r){int kv=kb+(r&3)+8*(r>>2); if(kv>qrel)p0[r]=NEG; if(kv+32>qrel)p1[r]=NEG;}
}
constexpr int NSLOT=3, KSLOT=8192, VSLOT=16384;
constexpr int LDS_K=0, LDS_V=NSLOT*KSLOT, LDS_WS=LDS_V+NSLOT*VSLOT, LDS_OST=LDS_WS+NW*64*4, LDS_BYTES=LDS_OST+NW*8192;
__device__ __forceinline__ void glds16(const void*gsrc,unsigned lds_dst){unsigned keep;
  asm volatile("s_mov_b32 %0, m0\n\ts_mov_b32 m0, %2\n\ts_nop 0\n\tglobal_load_lds_dwordx4 %1, off\n\ts_mov_b32 m0, %0":"=&s"(keep):"v"(gsrc),"s"(lds_dst):"memory");}
typedef float f32x2_t __attribute__((ext_vector_type(2))); typedef __bf16 bf16x2_t __attribute__((ext_vector_type(2)));
__device__ __forceinline__ unsigned cvtpk_s(float lo,float hi){f32x2_t v={lo,hi};bf16x2_t b=__builtin_convertvector(v,bf16x2_t);return __builtin_bit_cast(unsigned,b);}
#define WAIT_BAR(N) asm volatile("s_waitcnt vmcnt(" #N ") lgkmcnt(0)\n\ts_barrier":::"memory")
__device__ __forceinline__ void qkt(f32x16&p0,f32x16&p1,const char*Kslot,const bf16x8*qr,int r32,int hi){
  const char*kb=Kslot+hi*1024+r32*16; const f32x16 z=f32x16{};
  #pragma unroll
  for(int d0=0;d0<4;++d0){
    const bf16x8 b0=*reinterpret_cast<const bf16x8*>(kb+d0*2048);
    const bf16x8 b1=*reinterpret_cast<const bf16x8*>(kb+d0*2048+512);
    if(d0==0){p0=__builtin_amdgcn_mfma_f32_32x32x16_bf16(b0,qr[0],z,0,0,0);p1=__builtin_amdgcn_mfma_f32_32x32x16_bf16(b1,qr[0],z,0,0,0);}
    else{p0=__builtin_amdgcn_mfma_f32_32x32x16_bf16(b0,qr[d0],p0,0,0,0);p1=__builtin_amdgcn_mfma_f32_32x32x16_bf16(b1,qr[d0],p1,0,0,0);}}
}
typedef __attribute__((address_space(3))) const char* lds_cptr;
typedef short v4i16_t __attribute__((ext_vector_type(4)));
__device__ __forceinline__ void kload8(bf16x8*kf,lds_cptr kp){
  kf[0]=*(const __attribute__((address_space(3))) bf16x8*)(kp);      kf[1]=*(const __attribute__((address_space(3))) bf16x8*)(kp+512);
  kf[2]=*(const __attribute__((address_space(3))) bf16x8*)(kp+2048); kf[3]=*(const __attribute__((address_space(3))) bf16x8*)(kp+2560);
  kf[4]=*(const __attribute__((address_space(3))) bf16x8*)(kp+4096); kf[5]=*(const __attribute__((address_space(3))) bf16x8*)(kp+4608);
  kf[6]=*(const __attribute__((address_space(3))) bf16x8*)(kp+6144); kf[7]=*(const __attribute__((address_space(3))) bf16x8*)(kp+6656);
}
__device__ __forceinline__ void kload2(bf16x8*kf,lds_cptr kp,int j){ kf[2*j]=*(const __attribute__((address_space(3))) bf16x8*)(kp+j*2048); kf[2*j+1]=*(const __attribute__((address_space(3))) bf16x8*)(kp+j*2048+512); }
__device__ __forceinline__ s16x4 vtr(lds_cptr p){ return __builtin_bit_cast(s16x4,__builtin_amdgcn_ds_read_tr16_b64_v4i16((__attribute__((address_space(3))) v4i16_t*)p)); }
__device__ __forceinline__ void pv4(f32x16*o,int vb,bf16x8 pa0,bf16x8 pa1,bf16x8 pa2,bf16x8 pa3){
  #pragma unroll
  for(int d0=0;d0<4;++d0){s16x4 lo[4],hi[4];
    #pragma unroll
    for(int ks=0;ks<4;++ks){
      asm volatile("ds_read_b64_tr_b16 %0,%1 offset:%c2":"=&v"(lo[ks]):"v"(vb),"i"(d0*4096+ks*1024):"memory");
      asm volatile("ds_read_b64_tr_b16 %0,%1 offset:%c2":"=&v"(hi[ks]):"v"(vb),"i"(d0*4096+ks*1024+512):"memory");}
    asm volatile("s_waitcnt lgkmcnt(0)":::"memory");SBAR();
    #define PK(k) (bf16x8){lo[k][0],lo[k][1],lo[k][2],lo[k][3],hi[k][0],hi[k][1],hi[k][2],hi[k][3]}
    o[d0]=__builtin_amdgcn_mfma_f32_32x32x16_bf16(pa0,PK(0),o[d0],0,0,0);
    o[d0]=__builtin_amdgcn_mfma_f32_32x32x16_bf16(pa1,PK(1),o[d0],0,0,0);
    o[d0]=__builtin_amdgcn_mfma_f32_32x32x16_bf16(pa2,PK(2),o[d0],0,0,0);
    o[d0]=__builtin_amdgcn_mfma_f32_32x32x16_bf16(pa3,PK(3),o[d0],0,0,0);
    #undef PK
  }
}
__device__ __forceinline__ void attn_unit(int b,int qcol,int vcol,int qb,int comp,float lam,const float*subln,int ocol,const bf16*Q,const bf16*__restrict__ K,const bf16*__restrict__ V,bf16*OUT,char*shm,bool first,bool has_next,int nb,int nqcol,int nvcol){
  int tid=threadIdx.x; asm volatile("":"+v"(tid));
  const int lane=tid&63,r32=lane&31,hi=lane>>5; const int wid=__builtin_amdgcn_readfirstlane(tid>>6);
  const long rowbase=(long)b*SEQ; const int q0=qb*QB;
  const bf16*Qw=Q+(rowbase+q0+wid*QBLK)*DM+qcol;
  const bf16*Kh=K+rowbase*DM+qcol,*Vh=V+rowbase*DM+vcol;
  const unsigned lds0=(unsigned)(uintptr_t)shm;
  const bf16*ksrc=Kh+(long)lane*DM+wid*8;
  const bf16*vsrc=Vh+(long)(16*(wid&3)+(lane>>2))*DM+(wid>>2)*32+(lane&3)*8;
  const unsigned kdst=lds0+LDS_K+wid*1024, vdst=lds0+LDS_V+wid*1024;
  #define DMA_K(t,slot) glds16(ksrc+(long)(t)*KVBLK*DM,(unsigned)__builtin_amdgcn_readfirstlane(kdst+(slot)))
  #define DMA_V(t,slot) do{ glds16(vsrc+(long)(t)*KVBLK*DM,(unsigned)__builtin_amdgcn_readfirstlane(vdst+2*(slot))); glds16(vsrc+64+(long)(t)*KVBLK*DM,(unsigned)__builtin_amdgcn_readfirstlane(vdst+8192+2*(slot))); }while(0)
  const int vb0=(int)(lds0+LDS_V)+((lane>>4)&1)*32+(lane&3)*8+(4*hi+((lane&15)>>2))*64;
  const char*Kbase=shm+LDS_K; bf16x8 kf[8];
  const lds_cptr shm3=(lds_cptr)shm; const lds_cptr kp0=shm3+LDS_K+hi*1024+r32*16; const lds_cptr vp0=shm3+LDS_V+((lane>>4)&1)*32+(lane&3)*8+(4*hi+((lane&15)>>2))*64;
  const int NT=(q0+QB)/KVBLK;
  if(first){DMA_K(0,0);DMA_V(0,0);DMA_K(1,KSLOT);}
  bf16x8 qr[4];
  #pragma unroll
  for(int d0=0;d0<4;++d0)qr[d0]=*reinterpret_cast<const bf16x8*>(&Qw[(long)r32*DM+d0*16+hi*8]);
  float l_reg=0.f;f32x16 o[4];o[0]=f32x16{};o[1]=f32x16{};o[2]=f32x16{};o[3]=f32x16{};
  const int qrel=wid*QBLK+r32;
  #define CMASK(P0,P1,t) do{int jb_=(t)-(NT-4); if(jb_>=0)cmask(P0,P1,jb_,qrel,hi);}while(0)
  f32x16 pA0,pA1,pB0,pB1;
  int sl_prev=0,sl_cur=0,sl_next=KSLOT;
  #define ROT() do{sl_prev=sl_cur;sl_cur=sl_next;sl_next=(sl_next==(NSLOT-1)*KSLOT)?0:sl_next+KSLOT;}while(0)
  DMA_K(2,2*KSLOT);
  WAIT_BAR(4);
  qkt(pA0,pA1,Kbase,qr,r32,hi);asm volatile("s_nop 15\n\ts_nop 7":"+v"(pA0),"+v"(pA1));CMASK(pA0,pA1,0);
  _Pragma("unroll") for(int r=0;r<16;++r){pA0[r]=__builtin_amdgcn_exp2f(pA0[r]);pA1[r]=__builtin_amdgcn_exp2f(pA1[r]);}
  WAIT_BAR(0);
  DMA_K(3,0);DMA_V(1,KSLOT);
  ROT();
  kload8(kf,kp0+sl_cur);
  WAIT_BAR(3);
  s16x4 vlo[8],vhi[8]; u32x4 pw0,pw1,pw2,pw3;
  const f32x16 zero16=f32x16{};
  #define PKW(P,B) cvtpk_s(P[B],P[B+1])
  #define PAF(k) __builtin_bit_cast(bf16x8,pw##k)
  #define VFR(i) (bf16x8){vlo[i][0],vlo[i][1],vlo[i][2],vlo[i][3],vhi[i][0],vhi[i][1],vhi[i][2],vhi[i][3]}
  #define PIN(x) asm volatile("":"+v"(x))
  #define GAPA(MF,A0,A1,A2,A3,W0,W1,PW) do{ MF; sacc+=A0; sacc+=A1; sacc+=A2; sacc+=A3; PIN(sacc); W0; W1; PIN(PW); SBAR(); }while(0)
  #define EX(v) __builtin_amdgcn_exp2f(v)
  #define GAPB(MF,X,B) do{ MF; X[B]=EX(X[B]); X[B+1]=EX(X[B+1]); PIN(X); SBAR(); }while(0)
  #define VRD(i) do{ vlo[i]=vtr(vp_+(((i)>>2)*4096+((i)&3)*1024)); vhi[i]=vtr(vp_+(((i)>>2)*4096+((i)&3)*1024+512)); }while(0)
  #define VRD2(i) do{ vlo[i]=vtr(vp_+((((i)>>2)+2)*4096+((i)&3)*1024)); vhi[i]=vtr(vp_+((((i)>>2)+2)*4096+((i)&3)*1024+512)); SBAR(); }while(0)
  #define KRD(G,j) do{ if(G){ kload2(kf,kp0+sl_next,j); SBAR(); } }while(0)
  #define STEP(C0,C1,P0,P1,t,GK,GV,GL) do{ SBAR(); \
    const lds_cptr vp_=vp0+2*sl_prev; \
    VRD(0); SBAR(); float sacc=(P0[0]+P0[1]); \
    GAPA(C0=__builtin_amdgcn_mfma_f32_32x32x16_bf16(kf[0],qr[0],zero16,0,0,0), P0[2],P0[3],P0[4],P0[5],     pw0[0]=PKW(P0,0), pw0[1]=PKW(P0,2), pw0); \
    VRD(4); SBAR(); GAPA(C1=__builtin_amdgcn_mfma_f32_32x32x16_bf16(kf[1],qr[0],zero16,0,0,0), P0[6],P0[7],P0[8],P0[9],     pw0[2]=PKW(P0,4), pw0[3]=PKW(P0,6), pw0); \
    VRD(1); SBAR(); GAPA(C0=__builtin_amdgcn_mfma_f32_32x32x16_bf16(kf[2],qr[1],C0,0,0,0),   P0[10],P0[11],P0[12],P0[13], pw1[0]=PKW(P0,8), pw1[1]=PKW(P0,10), pw1); \
    VRD(5); SBAR(); GAPA(C1=__builtin_amdgcn_mfma_f32_32x32x16_bf16(kf[3],qr[1],C1,0,0,0),   P0[14],P0[15],P1[0],P1[1],   pw1[2]=PKW(P0,12),pw1[3]=PKW(P0,14), pw1); \
    VRD(2); SBAR(); GAPA(C0=__builtin_amdgcn_mfma_f32_32x32x16_bf16(kf[4],qr[2],C0,0,0,0),   P1[2],P1[3],P1[4],P1[5],     pw2[0]=PKW(P1,0), pw2[1]=PKW(P1,2), pw2); \
    VRD(6); SBAR(); GAPA(C1=__builtin_amdgcn_mfma_f32_32x32x16_bf16(kf[5],qr[2],C1,0,0,0),   P1[6],P1[7],P1[8],P1[9],     pw2[2]=PKW(P1,4), pw2[3]=PKW(P1,6), pw2); \
    VRD(3); SBAR(); GAPA(C0=__builtin_amdgcn_mfma_f32_32x32x16_bf16(kf[6],qr[3],C0,0,0,0),   P1[10],P1[11],P1[12],P1[13], pw3[0]=PKW(P1,8), pw3[1]=PKW(P1,10), pw3); \
    VRD(7); SBAR(); GAPA(C1=__builtin_amdgcn_mfma_f32_32x32x16_bf16(kf[7],qr[3],C1,0,0,0),   P1[14],P1[15],0.f,0.f,       pw3[2]=PKW(P1,12),pw3[3]=PKW(P1,14), pw3); \
    l_reg+=sacc; \
    if(GK){DMA_K((t)+3,sl_cur);} if(GV){DMA_V((t)+1,sl_next);} \
    CMASK(C0,C1,t); \
    SBAR(); \
    GAPB(o[0]=__builtin_amdgcn_mfma_f32_32x32x16_bf16(PAF(0),VFR(0),o[0],0,0,0), C0,0); \
    VRD2(0); GAPB(o[1]=__builtin_amdgcn_mfma_f32_32x32x16_bf16(PAF(0),VFR(4),o[1],0,0,0), C0,2); \
    VRD2(4); KRD(GL,0); GAPB(o[0]=__builtin_amdgcn_mfma_f32_32x32x16_bf16(PAF(1),VFR(1),o[0],0,0,0), C0,4); \
    VRD2(1); KRD(GL,1); GAPB(o[1]=__builtin_amdgcn_mfma_f32_32x32x16_bf16(PAF(1),VFR(5),o[1],0,0,0), C0,6); \
    VRD2(5); KRD(GL,2); GAPB(o[0]=__builtin_amdgcn_mfma_f32_32x32x16_bf16(PAF(2),VFR(2),o[0],0,0,0), C0,8); \
    VRD2(2); KRD(GL,3); GAPB(o[1]=__builtin_amdgcn_mfma_f32_32x32x16_bf16(PAF(2),VFR(6),o[1],0,0,0), C0,10); \
    VRD2(6); GAPB(o[0]=__builtin_amdgcn_mfma_f32_32x32x16_bf16(PAF(3),VFR(3),o[0],0,0,0), C0,12); \
    VRD2(3); GAPB(o[1]=__builtin_amdgcn_mfma_f32_32x32x16_bf16(PAF(3),VFR(7),o[1],0,0,0), C0,14); \
    VRD2(7); \
    GAPB(o[2]=__builtin_amdgcn_mfma_f32_32x32x16_bf16(PAF(0),VFR(0),o[2],0,0,0), C1,0); \
    GAPB(o[3]=__builtin_amdgcn_mfma_f32_32x32x16_bf16(PAF(0),VFR(4),o[3],0,0,0), C1,2); \
    GAPB(o[2]=__builtin_amdgcn_mfma_f32_32x32x16_bf16(PAF(1),VFR(1),o[2],0,0,0), C1,4); \
    GAPB(o[3]=__builtin_amdgcn_mfma_f32_32x32x16_bf16(PAF(1),VFR(5),o[3],0,0,0), C1,6); \
    GAPB(o[2]=__builtin_amdgcn_mfma_f32_32x32x16_bf16(PAF(2),VFR(2),o[2],0,0,0), C1,8); \
    GAPB(o[3]=__builtin_amdgcn_mfma_f32_32x32x16_bf16(PAF(2),VFR(6),o[3],0,0,0), C1,10); \
    GAPB(o[2]=__builtin_amdgcn_mfma_f32_32x32x16_bf16(PAF(3),VFR(3),o[2],0,0,0), C1,12); \
    GAPB(o[3]=__builtin_amdgcn_mfma_f32_32x32x16_bf16(PAF(3),VFR(7),o[3],0,0,0), C1,14); \
    }while(0)
  int t=1;
  if(wid>=4)__builtin_amdgcn_s_setprio(1);
  #undef CMASK
  #define CMASK(P0,P1,t) do{}while(0)
  for(;t+5<NT;t+=2){
    STEP(pB0,pB1,pA0,pA1,t,true,true,true);     WAIT_BAR(3); ROT();
    STEP(pA0,pA1,pB0,pB1,t+1,true,true,true);   WAIT_BAR(3); ROT();
  }
  #undef CMASK
  #define CMASK(P0,P1,t) do{int jb_=(t)-(NT-4); if(jb_>=0)cmask(P0,P1,jb_,qrel,hi);}while(0)
  #define ENDW(tt) do{ if((tt)+3<NT){WAIT_BAR(3);} else if((tt)+2<NT){WAIT_BAR(2);} else {WAIT_BAR(0);} }while(0)
  for(;t+1<NT;t+=2){
    STEP(pB0,pB1,pA0,pA1,t,(t+3<NT),(t+1<NT),(t+1<NT));       ENDW(t);   ROT();
    STEP(pA0,pA1,pB0,pB1,t+1,(t+4<NT),(t+2<NT),(t+2<NT));     ENDW(t+1); ROT();
  }
  STEP(pB0,pB1,pA0,pA1,NT-1,false,false,false);
  __builtin_amdgcn_s_setprio(0);
  { float sacc=pB0[0]+pB0[1]; _Pragma("unroll") for(int r=2;r<16;++r)sacc+=pB0[r]; _Pragma("unroll") for(int r=0;r<16;++r)sacc+=pB1[r]; l_reg+=sacc;
    pw0=(u32x4){PKW(pB0,0),PKW(pB0,2),PKW(pB0,4),PKW(pB0,6)};pw1=(u32x4){PKW(pB0,8),PKW(pB0,10),PKW(pB0,12),PKW(pB0,14)};pw2=(u32x4){PKW(pB1,0),PKW(pB1,2),PKW(pB1,4),PKW(pB1,6)};pw3=(u32x4){PKW(pB1,8),PKW(pB1,10),PKW(pB1,12),PKW(pB1,14)};
    SBAR(); pv4(o,vb0+2*sl_cur,PAF(0),PAF(1),PAF(2),PAF(3)); }
  asm volatile("s_waitcnt lgkmcnt(0)\n\ts_barrier":::"memory");
  if(has_next){ const long nrow=(long)nb*SEQ; const bf16*nk=K+nrow*DM+nqcol+(long)lane*DM+wid*8; const bf16*nv=V+nrow*DM+nvcol+(long)(16*(wid&3)+(lane>>2))*DM+(wid>>2)*32+(lane&3)*8;
    glds16(nk,(unsigned)__builtin_amdgcn_readfirstlane(kdst)); glds16(nv,(unsigned)__builtin_amdgcn_readfirstlane(vdst)); glds16(nv+64,(unsigned)__builtin_amdgcn_readfirstlane(vdst+8192)); glds16(nk+(long)KVBLK*DM,(unsigned)__builtin_amdgcn_readfirstlane(kdst+KSLOT)); }
  #undef PKW
  #undef PAF
  #undef VFR
  #undef PIN
  #undef GAPA
  #undef GAPB
  #undef EX
  #undef VRD
  #undef VRD2
  #undef KRD
  #undef STEP
  #undef ENDW
  {auto rr=__builtin_amdgcn_permlane32_swap(__float_as_uint(l_reg),__float_as_uint(l_reg),false,false);l_reg=__uint_as_float(rr[0])+__uint_as_float(rr[1]);}
  { int tz=threadIdx.x; asm volatile("":"+v"(tz)); const int lane2=tz&63,r2=lane2&31,hi2=lane2>>5,wid2=tz>>6;
    float*wsf2=(float*)(shm+LDS_WS)+wid2*64;
    if(hi2==0)wsf2[32+r2]=l_reg;asm volatile("s_waitcnt lgkmcnt(0)":::"memory");
    float rli[16];
    #pragma unroll
    for(int r=0;r<16;++r)rli[r]=__builtin_amdgcn_rcpf(wsf2[32+crow(r,hi2)]);
    bf16*stg=(bf16*)(shm+LDS_OST)+wid2*4096;
    if(comp==0){
      #pragma unroll
      for(int r=0;r<16;++r){const int orow=crow(r,hi2);
        #pragma unroll
        for(int d0=0;d0<4;++d0)stg[orow*128+d0*32+r2]=__float2bfloat16(o[d0][r]*rli[r]);}
    } else {
      float sg[4];
      #pragma unroll
      for(int d0=0;d0<4;++d0)sg[d0]=subln[d0*32+r2]*(1.0f-0.35550906759310784f);
      #pragma unroll
      for(int r=0;r<16;++r){const int orow=crow(r,hi2); float ss=0.f;
        #pragma unroll
        for(int d0=0;d0<4;++d0){const float o1=__bfloat162float(stg[orow*128+d0*32+r2]); const float dv=o1-lam*(o[d0][r]*rli[r]); o[d0][r]=dv; ss+=dv*dv;}
        ss+=__shfl_xor(ss,1);ss+=__shfl_xor(ss,2);ss+=__shfl_xor(ss,4);ss+=__shfl_xor(ss,8);ss+=__shfl_xor(ss,16);
        const float rn=__builtin_amdgcn_rsqf(ss*(1.f/128.f)+1e-6f);
        #pragma unroll
        for(int d0=0;d0<4;++d0)stg[orow*128+d0*32+r2]=__float2bfloat16(o[d0][r]*rn*sg[d0]);}
      asm volatile("s_waitcnt lgkmcnt(0)":::"memory");
      unsigned char*Ow=(unsigned char*)OUT+(rowbase+q0+wid2*QBLK)*OPITCH+ocol;
      #pragma unroll
      for(int i=0;i<8;++i){const int row=i*4+(lane2>>4),ch=lane2&15; const u32x4 v=*(const u32x4*)(stg+row*128+ch*8);
        u32x2 w8; w8.x=gm::pk_fp8x4(bflo(v.x)*16.f,bfhi(v.x)*16.f,bflo(v.y)*16.f,bfhi(v.y)*16.f); w8.y=gm::pk_fp8x4(bflo(v.z)*16.f,bfhi(v.z)*16.f,bflo(v.w)*16.f,bfhi(v.w)*16.f);
        *(u32x2*)(Ow+(long)row*OPITCH+ch*8)=w8;} }
  }
  asm volatile("s_waitcnt lgkmcnt(0)\n\ts_barrier":::"memory");
  #undef DMA_K
  #undef DMA_V
  #undef CMASK
  #undef ROT
}
__device__ __forceinline__ void diff_attn_phase(char*lds,const bf16*Q,const bf16*K,const bf16*V,bf16*OUT,float lam,const float*subln,int G,int bid,int vcu){
  const bool bal=(G==256);
  auto unit=[&](int i,int&hd,int&qb,int&c)->bool{ const int item=i>>1; c=i&1;
    if(bal){ if(i>=12)return false;
      if(item<4){ hd=vcu>>3; const int s=vcu&7; qb=(item==0)?s:(item==1)?15-s:(item==2)?16+s:31-s; }
      else{ hd=32+(vcu>>4); const int s=vcu&15; qb=(item==4)?s:31-s; } }
    else{ const int id=bid+item*G; if(id>=48*NQB)return false; hd=id/NQB; qb=NQB-1-(id%NQB); }
    return true; };
  int hd,qb,c; bool ok=unit(0,hd,qb,c);
  for(int i=0;ok;++i){
    int nhd=0,nqb=0,nc=0; const bool hn=unit(i+1,nhd,nqb,nc);
    const int b=hd/NHEAD,h=hd%NHEAD,nbb=nhd/NHEAD,nh=nhd%NHEAD;
    attn_unit(b,h*128+64*c,h*128,qb,c,lam,subln,h*128,Q,K,V,OUT,lds,i==0,hn,nbb,nh*128+64*nc,nh*128);
    hd=nhd;qb=nqb;c=nc;ok=hn;
  }
}
#undef SBAR
#undef WAIT_BAR
}
__device__ __forceinline__ void subln_phase(const Ctx& C) {
    const bf16_t* O1 = WSP(bf16_t, WS_BIG + BG_O1); const bf16_t* O2 = WSP(bf16_t, WS_BIG + BG_O2); bf16_t* cat = WSP(bf16_t, WS_S1);
    const int lane = C.lane;
    const float p01 = wave_sum(C.in(17)[lane] * C.in(17)[64 + lane]), p23 = wave_sum(C.in(17)[128 + lane] * C.in(17)[192 + lane]);
    const float lam = expf(p01) - expf(p23) + LAMBDA_INIT;
    const int sub = C.tid & 15;
    const f32x4 g0 = *(const f32x4*)(C.in(18) + 8 * sub), g1 = *(const f32x4*)(C.in(18) + 8 * sub + 4);
    const int NGRP = T * DH;
    for (int grp = (C.vcu * 512 + C.tid) >> 4; grp < NGRP; grp += (C.G * 512) >> 4) {
        const size_t off = (size_t)grp * DDV + 8 * sub;
        const u32x4 a = *(const u32x4*)(O1 + off), b = *(const u32x4*)(O2 + off);
        float v[8] = {bflo(a.x) - lam * bflo(b.x), bfhi(a.x) - lam * bfhi(b.x), bflo(a.y) - lam * bflo(b.y), bfhi(a.y) - lam * bfhi(b.y),
                      bflo(a.z) - lam * bflo(b.z), bfhi(a.z) - lam * bfhi(b.z), bflo(a.w) - lam * bflo(b.w), bfhi(a.w) - lam * bfhi(b.w)};
        float ss = 0.f;
#pragma unroll
        for (int i = 0; i < 8; ++i) ss += v[i] * v[i];
        ss += __shfl_xor(ss, 1); ss += __shfl_xor(ss, 2); ss += __shfl_xor(ss, 4); ss += __shfl_xor(ss, 8);
        const float rn = (1.0f / sqrtf(ss * (1.f / DDV) + EPS)) * (1.0f - LAMBDA_INIT);
        u32x4 w; w.x = cvtpk(v[0] * rn * g0[0], v[1] * rn * g0[1]); w.y = cvtpk(v[2] * rn * g0[2], v[3] * rn * g0[3]); w.z = cvtpk(v[4] * rn * g1[0], v[5] * rn * g1[1]); w.w = cvtpk(v[6] * rn * g1[2], v[7] * rn * g1[3]);
        const int tok = grp / DH, h = grp % DH;
        *(u32x4*)(cat + (size_t)tok * D + h * DDV + 8 * sub) = w;
    }
}
#ifndef MK_PROBE
#define MK_PROBE 0
#endif
#define REPN(k) ((MK_PROBE == (k)) ? 3 : 1)
#ifndef MK_N_LAUNCHES
#define MK_N_LAUNCHES 1
#endif
constexpr int NPHASE = 19;
struct Args { const void* in[28]; float* out; unsigned char* ws; int ph_lo, ph_hi; };
__global__ void __launch_bounds__(512, 2) yoco_fwd(Args args) {
    extern __shared__ __attribute__((aligned(16))) unsigned char lds_raw[];
    Ctx C;
    C.lds = (LAS unsigned char*)lds_raw;
    C.tid = threadIdx.x; C.lane = C.tid & 63; C.wave = __builtin_amdgcn_readfirstlane(C.tid >> 6);
    C.G = gridDim.x; C.bid = blockIdx.x; C.vcu = (C.G % 8 == 0) ? (C.bid % 8) * (C.G / 8) + C.bid / 8 : C.bid;
    C.ka = (karg_t)__builtin_amdgcn_kernarg_segment_ptr();
    C.out = args.out; C.ws = args.ws;
    volatile LAS unsigned* MISC = (volatile LAS unsigned*)(C.lds + MISC_OFF);
    for (int u = C.tid; u < 256; u += 512) MISC[u] = 0u;
    __syncthreads();
    unsigned* ctl = (unsigned*)(C.ws + WS_CTL);
    XcdBarrier bar; bar.bar = ctl + CW_BAR; bar.x = 0; bar.st = nullptr;
    const int lo = args.ph_lo, hi = args.ph_hi;
    if (hi - lo > 1) bar = xcd_barrier_post(ctl + CW_BAR, MISC + 8);
#ifndef MK_PHASE_MASK
#define MK_PHASE_MASK 0xFFFFFFFFu
#endif
#ifndef MK_DYN
#define MK_DYN 0
#endif
#define TKT(k) ((MK_DYN && (C.G % 8 == 0)) ? ctl + 32768 + (k) * 512 : (unsigned*)nullptr)
#define TSLOT ((LAS int*)(C.lds + MISC_OFF + 640))
#define IN(k) (((MK_PHASE_MASK >> (k)) & 1u) && lo <= (k) && (k) < hi)
#define SEAM(k) do { if (IN(k) && IN((k) + 1)) xcd_barrier(bar); } while (0)
    unsigned char* big = C.ws + WS_BIG;
    float* rstd = WSP(float, WS_RSTD);

    if (IN(0)) { p0_prologue(C);
#if MK_PROBE == 1
        xcd_barrier(bar); p0_prologue(C);
#endif
#if MK_PROBE == 24
        for (int q = 0; q < 16; ++q) xcd_barrier(bar);
#endif

    } SEAM(0);
    if (IN(1)) { ProbInA P; P.pm0 = 0;
        P.ord.init(T / 256, 12, C.G, C.bid, TKT(1), TSLOT);
 P.xb = (const char*)(C.ws + WS_S0); P.w = (const char*)(C.ws + WS_WINA); P.big = big; P.rstd = rstd; gm::gemm_phase(C.lds, P);
        { ProbInA8 Q; Q.ord.init(T / 256, 8, C.G, C.bid, TKT(1), TSLOT); Q.a = (const char*)(C.ws + WS_X8); Q.w = (const char*)(C.ws + WS_WINA + (size_t)3072 * D * 2); Q.big = big; Q.rstd = rstd; gm::gemm_phase8(C.lds, Q); }
    }
    if (MK_N_LAUNCHES != 1) { SEAM(1); }
    if (IN(2)) for (int rep = 0; rep < REPN(20); ++rep) {
        const int nmk = C.G > 64 ? 32 : 0;
        if (C.bid < 32 || nmk == 0) { ProbMemKV8 P; P.G = nmk ? 32 : C.G; P.c = C.bid; P.memb = (const char*)(C.ws + WS_MEMB8); P.w = (const char*)(C.ws + WS_WMEM); P.outp = WSP(float, WS_MEMKV); P.rstd = WSP(float, WS_MISC + MS_RSTDMEM); gm::gemm_phase8(C.lds, P); }
        if (C.bid >= nmk) gates_phase(C, (C.bid - nmk) * 8 + C.wave, (C.G - nmk) * 8);
    } SEAM(2);
    if (IN(3)) { mlstm_a(C); } SEAM(3);
    if (IN(4)) { mlstm_b(C); } SEAM(4);
    if (IN(5)) {
#ifndef SKIP_MLC
 mlstm_c(C);
#endif
#ifndef SKIP_MA
 memattn_phase(C, 0, WSP(bf16_t, WS_BIG + BG_MQ), WSP(bf16_t, WS_S1));
#endif
 }
 SEAM(5);
    if (IN(6)) { ProbOut<false> P; P.ord.init(T / 256, D / 256, C.G, C.bid, TKT(6), TSLOT); P.a = (const char*)(C.ws + WS_S1); P.w = (const char*)(C.ws + WS_WOUTA); P.resid = WSP(bf16_t, WS_S0);
        P.outp = WSP(bf16_t, WS_S2); gm::gemm_phase(C.lds, P); } SEAM(6);
    if (IN(7)) { router_phase(C, 0, WSP(bf16_t, WS_S2), rstd + T, 0);
#if MK_PROBE == 26
        xcd_barrier(bar); router_phase(C, 0, WSP(bf16_t, WS_S2), rstd + T, 2); xcd_barrier(bar); router_phase(C, 0, WSP(bf16_t, WS_S2), rstd + T, 3);
#endif
    } SEAM(7);
    if (IN(8)) { moe_tables(C, 0); ProbGU8 P; P.G = C.G; P.c = C.bid; P.tb = moe_tb(C.lds); P.xb = (const char*)(C.ws + WS_X8); P.w = (const char*)(C.ws + WS_WGU); P.ltok = WSP(int, WS_LIST); P.lrs = WSP(float, WS_LIST + 8 * MiB); P.act = C.ws + WS_BIG + BG_ACT;
#if MK_PROBE == 42
        int nr_ = 2; asm volatile("" : "+s"(nr_)); for (int rep_ = 0; rep_ < nr_; ++rep_)
#endif
        gm::gemm_phase8(C.lds, P); } SEAM(8);
    if (IN(9)) { moe_tables(C, 0); ProbDown8 P; P.G = C.G; P.c = C.bid; P.tb = moe_tb(C.lds); P.act = (const char*)(C.ws + WS_BIG + BG_ACT); P.w = (const char*)(C.ws + WS_WD); P.lw = WSP(float, WS_LIST + 4 * MiB); P.yb = WSP(bf16_t, WS_BIG + BG_YB);
#if MK_PROBE == 43
        int nr_ = 2; asm volatile("" : "+s"(nr_)); for (int rep_ = 0; rep_ < nr_; ++rep_)
#endif
        gm::gemm_phase8(C.lds, P); } SEAM(9);
    if (IN(10)) { moe_tables(C, 0); for (int rep = 0; rep < REPN(21); ++rep) combine_phase<false>(C, WSP(bf16_t, WS_S2), WSP(bf16_t, WS_BIG + BG_YB), WSP(bf16_t, WS_S0), rstd + 2 * T, nullptr); } SEAM(10);
    if (IN(11)) { ProbL1F8 P; P.ord.init(T / 256, NL1 / 256, C.G, C.bid, TKT(11), TSLOT); P.a = (const char*)(C.ws + WS_X8); P.w = (const char*)(C.ws + WS_WL1); P.big = big; P.rstd = rstd + 2 * T;
        P.pos = (const int*)C.in(2); P.kgain = C.in(14); P.qgain = C.in(16);
        gm::gemm_phase8(C.lds, P); } SEAM(11);
    if (IN(12)) {
        float lam; { const float* lv = C.in(17); const float p01 = wave_sum(lv[C.lane] * lv[64 + C.lane]), p23 = wave_sum(lv[128 + C.lane] * lv[192 + C.lane]); lam = expf(p01) - expf(p23) + LAMBDA_INIT; }
#if MK_PROBE == 41
        int nr_ = 2; asm volatile("" : "+s"(nr_)); for (int rep_ = 0; rep_ < nr_; ++rep_)
#endif
        attn2::diff_attn_phase((char*)lds_raw, (const attn2::bf16*)(big + BG_QR), (const attn2::bf16*)(big + BG_KR), (const attn2::bf16*)(big + BG_VN), (attn2::bf16*)(C.ws + WS_S1), lam, C.in(18), C.G, C.bid, C.vcu);
        __syncthreads();
        memattn_phase(C, 1, WSP(bf16_t, WS_BIG + BG_MQ2), WSP(bf16_t, WS_S1));
    } if (IN(12) && IN(14)) xcd_barrier(bar);
    if (IN(14)) { ProbOut8 P; P.ord.init(T / 256, D / 256, C.G, C.bid, TKT(14), TSLOT); P.a = (const char*)(C.ws + WS_S1); P.w = (const char*)(C.ws + WS_WOUTB); P.resid = WSP(bf16_t, WS_S0); P.outp = WSP(bf16_t, WS_S2); gm::gemm_phase8(C.lds, P); } SEAM(14);
    if (IN(15)) { router_phase(C, 1, WSP(bf16_t, WS_S2), rstd + 3 * T, 1); } SEAM(15);
    if (IN(16)) { moe_tables(C, 1); ProbGU8 P; P.G = C.G; P.c = C.bid; P.tb = moe_tb(C.lds); P.xb = (const char*)(C.ws + WS_X8); P.w = (const char*)(C.ws + WS_WGU + (size_t)128 * MiB); P.ltok = WSP(int, WS_LIST); P.lrs = WSP(float, WS_LIST + 8 * MiB); P.act = C.ws + WS_BIG + BG_ACT; gm::gemm_phase8(C.lds, P); } SEAM(16);
    if (IN(17)) { moe_tables(C, 1); ProbDown8 P; P.G = C.G; P.c = C.bid; P.tb = moe_tb(C.lds); P.act = (const char*)(C.ws + WS_BIG + BG_ACT); P.w = (const char*)(C.ws + WS_WD + (size_t)64 * MiB); P.lw = WSP(float, WS_LIST + 4 * MiB); P.yb = WSP(bf16_t, WS_BIG + BG_YB); gm::gemm_phase8(C.lds, P); } SEAM(17);
    if (IN(18)) { moe_tables(C, 1); for (int rep = 0; rep < REPN(23); ++rep) combine_phase<true>(C, WSP(bf16_t, WS_S2), WSP(bf16_t, WS_BIG + BG_YB), nullptr, nullptr, C.out); }
#undef IN
#undef SEAM
}

extern "C" void kernel_launch(void* const* d_in, const int* in_sizes, int n_in, void* d_out, int out_size, void* d_ws, size_t ws_size, hipStream_t stream) {
    static int grid = 0;
    if (grid == 0) {
        if (n_in != 28 || out_size != T * D || ws_size < WS_END9) { fprintf(stderr, "kernel_launch: unexpected shapes: n_in %d out %d ws %zu (need %zu)\n", n_in, out_size, ws_size, (size_t)WS_END9); grid = -1; return; }
        int dev = 0, cus = 0, per_cu = 0;
        if (hipGetDevice(&dev) != hipSuccess || hipDeviceGetAttribute(&cus, hipDeviceAttributeMultiprocessorCount, dev) != hipSuccess) { grid = -1; return; }
        if (hipFuncSetAttribute((const void*)yoco_fwd, hipFuncAttributeMaxDynamicSharedMemorySize, LDS_BYTES) != hipSuccess) { fprintf(stderr, "kernel_launch: hipFuncSetAttribute failed\n"); grid = -1; return; }
        if (hipOccupancyMaxActiveBlocksPerMultiprocessor(&per_cu, (const void*)yoco_fwd, 512, LDS_BYTES) != hipSuccess || per_cu < 1) { fprintf(stderr, "kernel_launch: occupancy query says %d\n", per_cu); (void)hipGetLastError(); if (per_cu < 1) { grid = -1; return; } }
        grid = cus;
    }
    if (grid < 0) return;
    hipMemsetAsync((char*)d_ws + WS_CTL, 0, CTL_BYTES, stream);
    Args a{};
    for (int i = 0; i < 28; ++i) a.in[i] = d_in[i];
    a.out = (float*)d_out; a.ws = (unsigned char*)d_ws;
#if MK_N_LAUNCHES == 1
    a.ph_lo = 0; a.ph_hi = NPHASE;
    hipLaunchKernelGGL(yoco_fwd, dim3(grid), dim3(512), LDS_BYTES, stream, a);
#else
    for (int p = 0; p < NPHASE; ++p) { a.ph_lo = p; a.ph_hi = p + 1; hipLaunchKernelGGL(yoco_fwd, dim3(grid), dim3(512), LDS_BYTES, stream, a); }
#endif
}
```

```cpp
#include <hip/hip_runtime.h>
#include <cstdio>
#include <cstdint>

#define LAS __attribute__((address_space(3)))
#define GAS __attribute__((address_space(1)))
typedef unsigned short bf16_t;
typedef short bf16x8 __attribute__((ext_vector_type(8)));
typedef short s16x4 __attribute__((ext_vector_type(4)));
typedef float f32x4 __attribute__((ext_vector_type(4)));
typedef float f32x2 __attribute__((ext_vector_type(2)));
typedef float f32x16 __attribute__((ext_vector_type(16)));
typedef unsigned u32x4 __attribute__((ext_vector_type(4)));
typedef unsigned u32x2 __attribute__((ext_vector_type(2)));
typedef __bf16 bf16x2_t __attribute__((ext_vector_type(2)));

constexpr int T = 32768, D = 2048, NB = 4, SEQ = 8192;
constexpr int MEMS = 256, MEMH = 4, MEMW = 512, MEMHD = 128;
constexpr int LH = 6, LDV = 256, LDQK = 128, LCH = 128, LNC = 64;
constexpr int DH = 12, DHD = 64, DDV = 128;
constexpr int NE = 32, NG = 4, EPG = 8, DFF = 1024;
constexpr float EPS = 1e-6f;
constexpr int A_IN = 5132;
constexpr int NA = 5120;
constexpr int NL1 = 5120;
constexpr int MAXSLOT = 73728;
constexpr float LAMBDA_INIT = 0.35550906759310784f;
constexpr float LOG2E = 1.4426950408889634f;

constexpr size_t MiB = 1u << 20;
constexpr size_t WS_CTL = 0, CTL_BYTES = 1 * MiB;
constexpr size_t WS_RSTD = 1 * MiB;
constexpr size_t WS_GATES = 2 * MiB;
constexpr size_t WS_ROPE = 4 * MiB;
constexpr size_t WS_MEMKV = 12 * MiB;
constexpr size_t WS_MISC = 20 * MiB;
constexpr size_t WS_LIST = 23 * MiB;
constexpr size_t WS_MEMB = 36 * MiB;
constexpr size_t WS_WINA = 40 * MiB;
constexpr size_t WS_WOUTA = 60 * MiB;
constexpr size_t WS_WL1 = 68 * MiB;
constexpr size_t WS_WOUTB = 88 * MiB;
constexpr size_t WS_WMEM = 96 * MiB;
constexpr size_t WS_WGU = 104 * MiB;
constexpr size_t WS_WD = 616 * MiB;
constexpr size_t WS_S0 = 872 * MiB;
constexpr size_t WS_S1 = 1002 * MiB;
constexpr size_t WS_S2 = 1132 * MiB;
constexpr size_t WS_BIG = 1262 * MiB;
constexpr size_t WS_END = 1774 * MiB;
constexpr size_t BG_QN = 0, BG_KN = 48 * MiB, BG_VT = 96 * MiB, BG_ON = 192 * MiB, BG_MQ = 288 * MiB, BG_DCT = 320 * MiB, BG_CT = 416 * MiB;
constexpr size_t BG_ACT = 0, BG_YB = 144 * MiB;
constexpr size_t BG_KR = 0, BG_VN = 96 * MiB, BG_QR = 192 * MiB, BG_MQ2 = 288 * MiB, BG_O1 = 320 * MiB, BG_O2 = 416 * MiB;
constexpr size_t MS_RSTDMEM = 0;
constexpr size_t MS_BL = 8192, MS_ML = 8192 + 6144, MS_MST = 8192 + 2 * 6144;
constexpr size_t MS_DN = 32768;
constexpr size_t MS_NST = 32768 + 786432;
constexpr size_t MS_WR = 32768 + 2 * 786432;
constexpr size_t MS_WG = MS_WR + 786432;
static_assert(MS_WG + 131072 <= 3 * MiB, "misc");
constexpr int CW_BAR = 4096;
constexpr int CW_CNT = 16384;

constexpr int LDS_BYTES = 147456;
constexpr int MISC_OFF = 147456 - 1024;

__device__ __forceinline__ unsigned cvtpk(float lo, float hi) { f32x2 v = {lo, hi}; bf16x2_t b = __builtin_convertvector(v, bf16x2_t); return __builtin_bit_cast(unsigned, b); }
__device__ __forceinline__ float bf2f(unsigned short b) { return __uint_as_float(((unsigned)b) << 16); }
__device__ __forceinline__ float bflo(unsigned w) { return __uint_as_float(w << 16); }
__device__ __forceinline__ float bfhi(unsigned w) { return __uint_as_float(w & 0xffff0000u); }
__device__ __forceinline__ unsigned short f2bf(float f) { return (unsigned short)(cvtpk(f, 0.f) & 0xffffu); }
__device__ __forceinline__ float wave_sum(float v) {
#pragma unroll
    for (int o = 1; o < 64; o <<= 1) v += __shfl_xor(v, o);
    return v;
}
#define LDS_WAIT() asm volatile("s_waitcnt lgkmcnt(0)" ::: "memory")
#define VM_WAIT() asm volatile("s_waitcnt vmcnt(0)" ::: "memory")

#define XB_TMO      128
#define XB_XCNT(j)  (256  + 64 * (j))
#define XB_XSUB(j)  (1280 + 64 * (j))
#define XB_XGEN(j)  (2304 + 64 * (j))
#define XB_TOP      3328
#define XB_TOPGEN   3392
#define XCD_BAR_WORDS 3456
#define XB_SPIN_CAP (1u << 18)
__device__ __forceinline__ unsigned xb_ld(unsigned* p)              { return __hip_atomic_load(p, __ATOMIC_RELAXED, __HIP_MEMORY_SCOPE_AGENT); }
__device__ __forceinline__ unsigned xb_add(unsigned* p, unsigned v) { return __hip_atomic_fetch_add(p, v, __ATOMIC_RELAXED, __HIP_MEMORY_SCOPE_AGENT); }
__device__ __forceinline__ unsigned xb_xcc_id() { return (unsigned)__builtin_amdgcn_s_getreg((3 << 11) | 20) & 0xFu; }
#define XB_SPIN(cond, bar) do { unsigned _sp = 0; while (cond) { __builtin_amdgcn_s_sleep(1); \
    if ((++_sp & 255u) == 0u) { if (xb_ld(&(bar)[XB_TMO])) break; if (_sp > XB_SPIN_CAP) { atomicAdd(&(bar)[XB_TMO], 1u); break; } } } } while (0)
struct XcdBarrier { unsigned* bar; unsigned x; volatile LAS unsigned* st; };
__device__ __forceinline__ XcdBarrier xcd_barrier_post(unsigned* bar, volatile LAS unsigned* st) {
    XcdBarrier b; b.bar = bar; b.x = xb_xcc_id(); b.st = st;
    if (threadIdx.x == 0) (void)xb_add(&bar[XB_XCNT(b.x)], 1u);
    return b;
}
__device__ __forceinline__ void xcd_barrier_complete(unsigned* bar, unsigned x, unsigned& nloc, unsigned& nx) {
    const unsigned G = gridDim.x * gridDim.y * gridDim.z;
    unsigned sum, cnt, mine, sp = 0u;
    for (;;) {
        sum = 0u; cnt = 0u; mine = 0u;
#pragma unroll
        for (unsigned j = 0; j < 16; ++j) { const unsigned c = xb_ld(&bar[XB_XCNT(j)]); sum += c; cnt += (c > 0u) ? 1u : 0u; mine = (j == x) ? c : mine; }
        if (sum == G) break;
        __builtin_amdgcn_s_sleep(1);
        if ((++sp & 255u) == 0u) { if (xb_ld(&bar[XB_TMO])) break; if (sp > XB_SPIN_CAP) { atomicAdd(&bar[XB_TMO], 1u); break; } }
    }
    nloc = mine > 0u ? mine : 1u; nx = cnt > 0u ? cnt : 1u;
}
__device__ __forceinline__ void xcd_barrier(const XcdBarrier& b) {
    asm volatile("s_waitcnt vmcnt(0)" ::: "memory");
    __syncthreads();
    if (threadIdx.x == 0) {
        unsigned* bar = b.bar;
        __builtin_amdgcn_s_waitcnt(0);
        unsigned nloc = b.st[0], nx = b.st[1];
        if (nloc == 0u) { xcd_barrier_complete(bar, b.x, nloc, nx); b.st[0] = nloc; b.st[1] = nx; }
        const unsigned old = xb_add(&bar[XB_XSUB(b.x)], 1u);
        const unsigned gen = old / nloc;
        if (old + 1u == (gen + 1u) * nloc) {
            __builtin_amdgcn_fence(__ATOMIC_RELEASE, "agent");
            asm volatile("s_waitcnt vmcnt(0)" ::: "memory");
            const unsigned og = xb_add(&bar[XB_TOP], 1u);
            const unsigned tg = og / nx;
            if (og + 1u == (tg + 1u) * nx) xb_add(&bar[XB_TOPGEN], 1u);
            else XB_SPIN(xb_ld(&bar[XB_TOPGEN]) == tg, bar);
            __builtin_amdgcn_fence(__ATOMIC_ACQUIRE, "agent");
            xb_add(&bar[XB_XGEN(b.x)], 1u);
            asm volatile("s_waitcnt vmcnt(0)" ::: "memory");
        } else {
            XB_SPIN(xb_ld(&bar[XB_XGEN(b.x)]) == gen, bar);
            __builtin_amdgcn_fence(__ATOMIC_ACQUIRE, "agent");
            asm volatile("s_waitcnt vmcnt(0)" ::: "memory");
        }
    }
    __syncthreads();
}
namespace gm {
constexpr int BM = 256, BK = 64, HALF = 128, HTB = HALF * BK * 2, STAGE_BYTES = 8 * HTB, NXCD = 8, WGM = 8;
__host__ __device__ __forceinline__ int lds_byte(int r, int c) { const int st = (r >> 4) * 2 + (c >> 5), rr = r & 15, cc = c & 31, ob = rr * 64 + cc * 2; return st * 1024 + (ob ^ (((ob >> 9) & 1) << 5)); }
__host__ __device__ __forceinline__ void stage_rc(int b, int& R, int& C) { const int st = b / 1024, sb = b % 1024, swz = sb ^ (((sb >> 9) & 1) << 5); R = (st >> 1) * 16 + swz / 64; C = (st & 1) * 32 + (swz % 64) / 2; }
__host__ __device__ __forceinline__ int perm32(int rho) { const int n = rho >> 4, i = rho & 15; return 8 * (i >> 2) + 4 * n + (i & 3); }

struct Unit { const char* a; const char* b; int pm, pn, e, x; };

struct Order {
    int nM, nN, nwg, G, c; unsigned* tk; LAS int* slot;
    __device__ __forceinline__ void init(int nM_, int nN_, int G_, int c_, unsigned* tk_ = nullptr, LAS int* slot_ = nullptr) { nM = nM_; nN = nN_; nwg = nM * nN; G = G_; c = c_; tk = tk_; slot = slot_; }
    __device__ __forceinline__ long pick(int i) const {
        long L = (long)i * G + c;
        if (tk) {
            if (i >= 2) L = slot[i & 1];
            if (i >= 1 && threadIdx.x == 0) { int v = nwg;
#pragma unroll 1
                for (int j = 0; j < 8 && v >= nwg; ++j) { const int lb = (c + j) & 7; const unsigned t = __hip_atomic_fetch_add(tk + lb * 64, 1u, __ATOMIC_RELAXED, __HIP_MEMORY_SCOPE_AGENT); v = 2 * G + 8 * (int)t + lb; }
                slot[(i + 1) & 1] = v; }
        }
        return L;
    }
    __device__ __forceinline__ bool get(int i, int& pm, int& pn) const {
        const long L = pick(i); if (L >= nwg) return false;
        int wgid = (int)L; { const int q = nwg / NXCD, r = nwg % NXCD, xcd = wgid % NXCD, off = wgid / NXCD; wgid = (xcd < r ? xcd * (q + 1) : r * (q + 1) + (xcd - r) * q) + off; }
        const int nig = WGM * nN, gid = wgid / nig, fm = gid * WGM, gsz = (nM - fm) < WGM ? (nM - fm) : WGM;
        pm = fm + ((wgid % nig) % gsz); pn = (wgid % nig) / gsz; return true;
    }
};

template <class P>
__device__ __forceinline__ void gemm_phase(LAS unsigned char* lds, const P& p) {
    const int tid = threadIdx.x, wid = __builtin_amdgcn_readfirstlane(tid >> 6), lane = tid & 63, wr = wid >> 2, wc = wid & 3, fr = lane & 15, fq = lane >> 4;
    constexpr int K = P::K, nt = K / BK;
    unsigned voffA[2], voffB[2];
#pragma unroll
    for (int i = 0; i < 2; ++i) { int R, C; stage_rc(tid * 16 + i * 8192, R, C); const int Rb = (R & ~31) + perm32(R & 31);
        voffA[i] = (unsigned)(R * K + C) * 2u; voffB[i] = (unsigned)(Rb * K + C) * 2u; }
    constexpr size_t kstep = (size_t)(BK * 2);
    constexpr size_t hstep = (size_t)HALF * K * 2;
    const unsigned ldsw = (unsigned)wid * 1024u;
    const int aoff = lds_byte(wr * 64 + fr, fq * 8), boff = lds_byte(wc * 32 + fr, fq * 8);
#define GM_SA(b, h) (((b) * 2 + (h)) * HTB)
#define GM_SB(b, h) ((4 + (b) * 2 + (h)) * HTB)
#define GM_STAGE_B(bufoff, kbase, h) do { const char* _g = (kbase) + (size_t)(h) * hstep; _Pragma("unroll") for (int _i = 0; _i < 2; ++_i) \
        __builtin_amdgcn_global_load_lds((const unsigned*)(_g + voffB[_i]), (LAS unsigned*)(lds + (bufoff) + ldsw + _i * 8192), 16, 0, 0); } while (0)
#define GM_STAGE_A(bufoff, kbase, h, VV) do { const char* _g = (kbase) + (P::GATHER ? (size_t)0 : (size_t)(h) * hstep); _Pragma("unroll") for (int _i = 0; _i < 2; ++_i) { \
        const unsigned _o = P::GATHER ? VV[h][_i] : voffA[_i]; \
        __builtin_amdgcn_global_load_lds((const unsigned*)(_g + _o), (LAS unsigned*)(lds + (bufoff) + ldsw + _i * 8192), 16, 0, 0); } } while (0)
#define GM_LDA(dst, b, h) do { _Pragma("unroll") for (int m = 0; m < 4; ++m) _Pragma("unroll") for (int k = 0; k < 2; ++k) dst[m][k] = *(const LAS bf16x8*)(lds + GM_SA(b, h) + aoff + m * 2048 + k * 1024); } while (0)
#define GM_LDB(dst, b, h) do { _Pragma("unroll") for (int n = 0; n < 2; ++n) _Pragma("unroll") for (int k = 0; k < 2; ++k) dst[n][k] = *(const LAS bf16x8*)(lds + GM_SB(b, h) + boff + n * 2048 + k * 1024); } while (0)
#define GM_MMA(ai, bj, At, Bt) do { __builtin_amdgcn_s_setprio(1); _Pragma("unroll") for (int k = 0; k < 2; ++k) _Pragma("unroll") for (int m = 0; m < 4; ++m) _Pragma("unroll") for (int n = 0; n < 2; ++n) \
        acc[ai][bj][m][n] = __builtin_amdgcn_mfma_f32_16x16x32_bf16(Bt[n][k], At[m][k], acc[ai][bj][m][n], 0, 0, 0); __builtin_amdgcn_s_setprio(0); } while (0)
#define GM_WAIT_V(n) asm volatile("s_waitcnt vmcnt(" #n ")" ::: "memory")
#define GM_WAIT_L(n) asm volatile("s_waitcnt lgkmcnt(" #n ")" ::: "memory")
#define GM_BAR __builtin_amdgcn_s_barrier()
#define GM_SCHED __builtin_amdgcn_sched_barrier(0)
#define GM_GATHER_LOAD(VV, U) do { _Pragma("unroll") for (int _h = 0; _h < 2; ++_h) _Pragma("unroll") for (int _i = 0; _i < 2; ++_i) { int R, C; stage_rc(tid * 16 + _i * 8192, R, C); \
        VV[_h][_i] = p.row_off(U, _h * HALF + R) + (unsigned)C * 2u; } GM_WAIT_V(0); } while (0)
    Unit cur, nxt; int ui = 0;
    if (!p.next(0, cur)) return;
    f32x4 acc[2][2][4][2];
#pragma unroll
    for (int a = 0; a < 2; ++a)
#pragma unroll
        for (int b = 0; b < 2; ++b)
#pragma unroll
            for (int m = 0; m < 4; ++m)
#pragma unroll
                for (int n = 0; n < 2; ++n) acc[a][b][m][n] = (f32x4){0.f, 0.f, 0.f, 0.f};
    bf16x8 At[4][2], B0[2][2], B1[2][2];
    const char* cA = cur.a; const char* cB = cur.b;
    unsigned vC[2][2] = {{0u, 0u}, {0u, 0u}};
    if constexpr (P::GATHER) { GM_GATHER_LOAD(vC, cur); }
    GM_STAGE_B(GM_SB(0, 0), cB, 0); GM_STAGE_B(GM_SB(0, 1), cB, 1); GM_STAGE_A(GM_SA(0, 0), cA, 0, vC); GM_STAGE_A(GM_SA(0, 1), cA, 1, vC);
    if (wr == 1) GM_BAR;
    GM_WAIT_V(2); GM_BAR;
    GM_STAGE_B(GM_SB(1, 0), cB + kstep, 0); GM_STAGE_A(GM_SA(1, 0), cA + kstep, 0, vC); GM_STAGE_B(GM_SB(1, 1), cB + kstep, 1);
    GM_WAIT_V(6); GM_BAR;
    for (;;) {
        const bool has_next = p.next(ui + 1, nxt);
        const char* nA = has_next ? nxt.a : cA; const char* nB = has_next ? nxt.b : cB;
#pragma unroll 1
        for (int t = 0; t < nt; t += 2) {
            const bool last = (t == nt - 2);
            const char* a1 = cA + (size_t)(t + 1) * kstep;
            const char* a2 = last ? nA : cA + (size_t)(t + 2) * kstep; const char* b2 = last ? nB : cB + (size_t)(t + 2) * kstep;
            const char* a3 = a2 + kstep; const char* b3 = b2 + kstep;
            GM_LDB(B0, 0, 0); GM_LDB(B1, 0, 1); GM_SCHED; GM_LDA(At, 0, 0); GM_STAGE_A(GM_SA(1, 1), a1, 1, vC);
            if constexpr (P::GATHER) { if (last && has_next) { GM_GATHER_LOAD(vC, nxt); } }
            GM_WAIT_V(8); GM_WAIT_L(0); GM_BAR; GM_MMA(0, 0, At, B0); GM_MMA(0, 1, At, B1); GM_BAR; GM_SCHED;
            GM_LDA(At, 0, 1); GM_STAGE_B(GM_SB(0, 0), b2, 0); GM_STAGE_B(GM_SB(0, 1), b2, 1); GM_STAGE_A(GM_SA(0, 0), a2, 0, vC);
            GM_WAIT_V(8); GM_WAIT_L(0); GM_BAR; GM_MMA(1, 0, At, B0); GM_MMA(1, 1, At, B1); GM_BAR; GM_SCHED;
            GM_LDB(B0, 1, 0); GM_LDB(B1, 1, 1); GM_SCHED; GM_LDA(At, 1, 0); GM_STAGE_A(GM_SA(0, 1), a2, 1, vC);
            GM_WAIT_V(8); GM_WAIT_L(0); GM_BAR; GM_MMA(0, 0, At, B0); GM_MMA(0, 1, At, B1); GM_BAR; GM_SCHED;
            GM_LDA(At, 1, 1); GM_STAGE_B(GM_SB(1, 0), b3, 0); GM_STAGE_B(GM_SB(1, 1), b3, 1); GM_STAGE_A(GM_SA(1, 0), a3, 0, vC);
            GM_WAIT_V(8); GM_WAIT_L(0); GM_BAR; GM_MMA(1, 0, At, B0); GM_MMA(1, 1, At, B1); GM_BAR; GM_SCHED;
        }
        if (wr == 0) GM_BAR;
        { int tz = threadIdx.x; asm volatile("" : "+v"(tz)); const int w2 = tz >> 6, l2 = tz & 63;
          p.epi(acc, cur, w2 >> 2, w2 & 3, l2 & 15, l2 >> 4); }
        if (!has_next) break;
#pragma unroll
        for (int a = 0; a < 2; ++a)
#pragma unroll
            for (int b = 0; b < 2; ++b)
#pragma unroll
                for (int m = 0; m < 4; ++m)
#pragma unroll
                    for (int n = 0; n < 2; ++n) acc[a][b][m][n] = (f32x4){0.f, 0.f, 0.f, 0.f};
        cur = nxt; cA = nA; cB = nB; ++ui;
        if (wr == 1) GM_BAR;
    }
    GM_WAIT_V(0);
    GM_BAR;
#undef GM_SA
#undef GM_SB
#undef GM_STAGE_A
#undef GM_STAGE_B
#undef GM_LDA
#undef GM_LDB
#undef GM_MMA
#undef GM_WAIT_V
#undef GM_WAIT_L
#undef GM_BAR
#undef GM_SCHED
#undef GM_GATHER_LOAD
}

__device__ __forceinline__ void store_tile_bf16(const f32x4 (&acc)[2][2][4][2], bf16_t* obase, size_t ldc, const float* rowscale, const float* colscale, bool act, int wr, int wc, int fr, int fq) {
    f32x4 cs[2][2];
#pragma unroll
    for (int bj = 0; bj < 2; ++bj)
#pragma unroll
        for (int n = 0; n < 2; ++n) cs[bj][n] = colscale ? *(const f32x4*)(colscale + bj * HALF + wc * 32 + 8 * fq + 4 * n) : (f32x4){1.f, 1.f, 1.f, 1.f};
    float rs8[8];
#pragma unroll
    for (int i = 0; i < 8; ++i) rs8[i] = rowscale ? rowscale[(i >> 2) * HALF + wr * 64 + (i & 3) * 16 + fr] : 1.f;
#pragma unroll
    for (int ai = 0; ai < 2; ++ai)
#pragma unroll
        for (int m = 0; m < 4; ++m) {
            const int r = ai * HALF + wr * 64 + m * 16 + fr; const float rs = rs8[ai * 4 + m];
            bf16_t* rowp = obase + (size_t)r * ldc + wc * 32 + 8 * fq;
#pragma unroll
            for (int bj = 0; bj < 2; ++bj) {
                f32x4 v0 = acc[ai][bj][m][0] * cs[bj][0] * rs, v1 = acc[ai][bj][m][1] * cs[bj][1] * rs;
                if (act) {
#pragma unroll
                    for (int j = 0; j < 4; ++j) { v0[j] = __builtin_amdgcn_rcpf(1.f + __builtin_amdgcn_exp2f(-LOG2E * v0[j])); v1[j] = __builtin_amdgcn_rcpf(1.f + __builtin_amdgcn_exp2f(-LOG2E * v1[j])); } }
                u32x4 w; w.x = cvtpk(v0[0], v0[1]); w.y = cvtpk(v0[2], v0[3]); w.z = cvtpk(v1[0], v1[1]); w.w = cvtpk(v1[2], v1[3]);
                *(u32x4*)(rowp + bj * HALF) = w; }
            asm volatile("" ::: "memory");
        }
}
}
namespace gm {
typedef int v8i_t __attribute__((ext_vector_type(8)));
__host__ __device__ __forceinline__ int perm32b(int rho) { return 16 * ((rho >> 2) & 1) + 4 * (rho >> 3) + (rho & 3); }
__host__ __device__ __forceinline__ int lds_byte8(int r, int c) { const int st = (r >> 4) * 2 + (c >> 5), rr = r & 15, cc = c & 31, ob = rr * 64 + cc * 2; return st * 1024 + (ob ^ (((ob >> 8) & 3) << 4)); }
__host__ __device__ __forceinline__ void stage_rc8(int b, int& R, int& C) { const int st = b / 1024, sb = b % 1024, swz = sb ^ (((sb >> 8) & 3) << 4); R = (st >> 1) * 16 + swz / 64; C = (st & 1) * 32 + (swz % 64) / 2; }
template <class P>
__device__ __forceinline__ void gemm_phase8(LAS unsigned char* lds, const P& p) {
    const int tid = threadIdx.x, wid = __builtin_amdgcn_readfirstlane(tid >> 6), lane = tid & 63, wr = wid >> 2, wc = wid & 3;
    constexpr int K = P::K, nt = K / BK;
    unsigned voffA[2], voffB[2];
#pragma unroll
    for (int i = 0; i < 2; ++i) { int R, C; stage_rc8(tid * 16 + i * 8192, R, C); const int Rb = (R & ~31) + perm32b(R & 31);
        voffA[i] = (unsigned)(R * K + C) * 2u; voffB[i] = (unsigned)(Rb * K + C) * 2u; }
    constexpr size_t kstep = (size_t)(BK * 2);
    constexpr size_t hstep = (size_t)HALF * K * 2;
    const unsigned ldsw = (unsigned)wid * 1024u;
    const int aoff = lds_byte8(wr * 64 + (lane & 31), 16 * (lane >> 5)), boff = lds_byte8(wc * 32 + (lane & 31), 16 * (lane >> 5));
#define GM_SA(b, h) (((b) * 2 + (h)) * HTB)
#define GM_SB(b, h) ((4 + (b) * 2 + (h)) * HTB)
#define GM_STAGE_B(bufoff, kbase, h) do { const char* _g = (kbase) + (size_t)(h) * hstep; _Pragma("unroll") for (int _i = 0; _i < 2; ++_i) \
        __builtin_amdgcn_global_load_lds((const unsigned*)(_g + voffB[_i]), (LAS unsigned*)(lds + (bufoff) + ldsw + _i * 8192), 16, 0, 0); } while (0)
#define GM_STAGE_A(bufoff, kbase, h, VV) do { const char* _g = (kbase) + (P::GATHER ? (size_t)0 : (size_t)(h) * hstep); _Pragma("unroll") for (int _i = 0; _i < 2; ++_i) { \
        const unsigned _o = P::GATHER ? VV[h][_i] : voffA[_i]; \
        __builtin_amdgcn_global_load_lds((const unsigned*)(_g + _o), (LAS unsigned*)(lds + (bufoff) + ldsw + _i * 8192), 16, 0, 0); } } while (0)
#define GM_LDA(dst, b, h) do { _Pragma("unroll") for (int m = 0; m < 4; ++m) _Pragma("unroll") for (int k = 0; k < 2; ++k) dst[m][k] = *(const LAS bf16x8*)(lds + GM_SA(b, h) + (aoff ^ (k * 16)) + (m >> 1) * 4096 + (m & 1) * 1024); } while (0)
#define GM_LDB(dst, b, h) do { _Pragma("unroll") for (int n = 0; n < 2; ++n) _Pragma("unroll") for (int k = 0; k < 2; ++k) dst[n][k] = *(const LAS bf16x8*)(lds + GM_SB(b, h) + (boff ^ (k * 16)) + n * 1024); } while (0)
#define GM_V8(lo, hi) __builtin_bit_cast(v8i_t, __builtin_shufflevector(lo, hi, 0, 1, 2, 3, 4, 5, 6, 7, 8, 9, 10, 11, 12, 13, 14, 15))
#define GM_MMA(ai, bj, At, Bt) do { __builtin_amdgcn_s_setprio(1); _Pragma("unroll") for (int s = 0; s < 2; ++s) _Pragma("unroll") for (int mb = 0; mb < 2; ++mb) \
        acc[ai][bj][mb] = __builtin_amdgcn_mfma_scale_f32_32x32x64_f8f6f4(GM_V8(Bt[s][0], Bt[s][1]), GM_V8(At[mb * 2 + s][0], At[mb * 2 + s][1]), acc[ai][bj][mb], 0, 0, 0, 0x7F7F7F7F, 0, 0x7F7F7F7F); \
        __builtin_amdgcn_s_setprio(0); } while (0)
#define GM_WAIT_V(n) asm volatile("s_waitcnt vmcnt(" #n ")" ::: "memory")
#define GM_WAIT_L(n) asm volatile("s_waitcnt lgkmcnt(" #n ")" ::: "memory")
#define GM_BAR __builtin_amdgcn_s_barrier()
#define GM_SCHED __builtin_amdgcn_sched_barrier(0)
#define GM_GATHER_LOAD(VV, U) do { _Pragma("unroll") for (int _h = 0; _h < 2; ++_h) _Pragma("unroll") for (int _i = 0; _i < 2; ++_i) { int R, C; stage_rc8(tid * 16 + _i * 8192, R, C); \
        VV[_h][_i] = p.row_off(U, _h * HALF + R) + (unsigned)C * 2u; } GM_WAIT_V(0); } while (0)
    Unit cur, nxt; int ui = 0;
    if (!p.next(0, cur)) return;
    f32x16 acc[2][2][2];
#pragma unroll
    for (int a = 0; a < 2; ++a)
#pragma unroll
        for (int b = 0; b < 2; ++b)
#pragma unroll
            for (int m = 0; m < 2; ++m) acc[a][b][m] = f32x16{};
    bf16x8 At[4][2], B0[2][2], B1[2][2];
    const char* cA = cur.a; const char* cB = cur.b;
    unsigned vC[2][2] = {{0u, 0u}, {0u, 0u}};
    if constexpr (P::GATHER) { GM_GATHER_LOAD(vC, cur); }
    GM_STAGE_B(GM_SB(0, 0), cB, 0); GM_STAGE_B(GM_SB(0, 1), cB, 1); GM_STAGE_A(GM_SA(0, 0), cA, 0, vC); GM_STAGE_A(GM_SA(0, 1), cA, 1, vC);
    if (wr == 1) GM_BAR;
    GM_WAIT_V(2); GM_BAR;
    GM_STAGE_B(GM_SB(1, 0), cB + kstep, 0); GM_STAGE_A(GM_SA(1, 0), cA + kstep, 0, vC); GM_STAGE_B(GM_SB(1, 1), cB + kstep, 1);
    GM_WAIT_V(6); GM_BAR;
    for (;;) {
        const bool has_next = p.next(ui + 1, nxt);
        const char* nA = has_next ? nxt.a : cA; const char* nB = has_next ? nxt.b : cB;
#pragma unroll 1
        for (int t = 0; t < nt; t += 2) {
            const bool last = (t == nt - 2);
            const char* a1 = cA + (size_t)(t + 1) * kstep;
            const char* a2 = last ? nA : cA + (size_t)(t + 2) * kstep; const char* b2 = last ? nB : cB + (size_t)(t + 2) * kstep;
            const char* a3 = a2 + kstep; const char* b3 = b2 + kstep;
            __builtin_amdgcn_s_setprio(2); GM_LDB(B0, 0, 0); GM_LDB(B1, 0, 1); GM_SCHED; GM_LDA(At, 0, 0); GM_STAGE_A(GM_SA(1, 1), a1, 1, vC);
            if constexpr (P::GATHER) { if (last && has_next) { GM_GATHER_LOAD(vC, nxt); } }
            __builtin_amdgcn_s_setprio(0); GM_WAIT_V(8); GM_WAIT_L(0); GM_BAR; GM_MMA(0, 0, At, B0); GM_MMA(0, 1, At, B1); GM_BAR; GM_SCHED;
            __builtin_amdgcn_s_setprio(2); GM_LDA(At, 0, 1); GM_STAGE_B(GM_SB(0, 0), b2, 0); GM_STAGE_B(GM_SB(0, 1), b2, 1); GM_STAGE_A(GM_SA(0, 0), a2, 0, vC);
            __builtin_amdgcn_s_setprio(0); GM_WAIT_V(8); GM_WAIT_L(0); GM_BAR; GM_MMA(1, 0, At, B0); GM_MMA(1, 1, At, B1); GM_BAR; GM_SCHED;
            __builtin_amdgcn_s_setprio(2); GM_LDB(B0, 1, 0); GM_LDB(B1, 1, 1); GM_SCHED; GM_LDA(At, 1, 0); GM_STAGE_A(GM_SA(0, 1), a2, 1, vC);
            __builtin_amdgcn_s_setprio(0); GM_WAIT_V(8); GM_WAIT_L(0); GM_BAR; GM_MMA(0, 0, At, B0); GM_MMA(0, 1, At, B1); GM_BAR; GM_SCHED;
            __builtin_amdgcn_s_setprio(2); GM_LDA(At, 1, 1); GM_STAGE_B(GM_SB(1, 0), b3, 0); GM_STAGE_B(GM_SB(1, 1), b3, 1); GM_STAGE_A(GM_SA(1, 0), a3, 0, vC);
            __builtin_amdgcn_s_setprio(0); GM_WAIT_V(8); GM_WAIT_L(0); GM_BAR; GM_MMA(1, 0, At, B0); GM_MMA(1, 1, At, B1); GM_BAR; GM_SCHED;
        }
        if (wr == 0) GM_BAR;
        { int tz = threadIdx.x; asm volatile("" : "+v"(tz)); const int w2 = tz >> 6, l2 = tz & 63;
          p.epi8(acc, cur, w2 >> 2, w2 & 3, l2 & 31, l2 >> 5); }
        if (!has_next) break;
#pragma unroll
        for (int a = 0; a < 2; ++a)
#pragma unroll
            for (int b = 0; b < 2; ++b)
#pragma unroll
                for (int m = 0; m < 2; ++m) acc[a][b][m] = f32x16{};
        cur = nxt; cA = nA; cB = nB; ++ui;
        if (wr == 1) GM_BAR;
    }
    GM_WAIT_V(0);
    GM_BAR;
#undef GM_SA
#undef GM_SB
#undef GM_STAGE_A
#undef GM_STAGE_B
#undef GM_LDA
#undef GM_LDB
#undef GM_V8
#undef GM_MMA
#undef GM_WAIT_V
#undef GM_WAIT_L
#undef GM_BAR
#undef GM_SCHED
#undef GM_GATHER_LOAD
}
__device__ __forceinline__ unsigned pk_fp8x4(float a, float b, float c, float d) {
    a = fminf(fmaxf(a, -448.f), 448.f); b = fminf(fmaxf(b, -448.f), 448.f); c = fminf(fmaxf(c, -448.f), 448.f); d = fminf(fmaxf(d, -448.f), 448.f);
    int w = 0; w = __builtin_amdgcn_cvt_pk_fp8_f32(a, b, w, false); w = __builtin_amdgcn_cvt_pk_fp8_f32(c, d, w, true); return (unsigned)w;
}
}
typedef __attribute__((address_space(4))) const unsigned long long* karg_t;
typedef __attribute__((address_space(4))) const unsigned long long* karg_t;
struct Ctx {
    karg_t ka;
    float* out; unsigned char* ws;
    LAS unsigned char* lds;
    int tid, lane, wave, G, vcu, bid;
    __device__ __forceinline__ const float* in(int k) const { karg_t p = ka; asm volatile("" : "+s"(p)); return (const float*)(const GAS float*)p[k]; }
};
#define WSP(T_, off) ((T_*)(C.ws + (off)))

struct ProbInA {
    static constexpr bool GATHER = false; static constexpr int K = 2048;
    gm::Order ord; const char* xb; const char* w; unsigned char* big; const float* rstd; int pm0;
    __device__ __forceinline__ bool next(int i, gm::Unit& u) const {
        int pm, pn; if (!ord.get(i, pm, pn)) return false; pm += pm0; u.pm = pm; u.pn = pn; u.e = 0; u.x = 0;
        const bool sw = (pn >= 6 && pn < 12);
        const char* xa = xb + (size_t)pm * 256 * K * 2; const char* wa = w + (size_t)pn * 256 * K * 2;
        u.a = sw ? wa : xa; u.b = sw ? xa : wa; return true;
    }
    __device__ __forceinline__ unsigned row_off(const gm::Unit&, int) const { return 0u; }
    __device__ __forceinline__ void epi(const f32x4 (&acc)[2][2][4][2], const gm::Unit& u, int wr, int wc, int fr, int fq) const {
        const int pm = u.pm, pn = u.pn;
        bf16_t* ob; size_t ldc; const float* rsp = rstd + pm * 256; const float* csp = nullptr; bool act = false;
        if (pn >= 6 && pn < 12) {
            const int b = pm >> 5, hd = pn - 6;
            ob = (bf16_t*)(big + BG_VT) + ((size_t)((b * LH + hd) * LDV)) * SEQ + (size_t)(pm & 31) * 256; ldc = SEQ; csp = rsp; rsp = nullptr;
        } else if (pn < 3) { ob = (bf16_t*)(big + BG_QN) + (size_t)pm * 256 * 768 + pn * 256; ldc = 768; }
        else if (pn < 6) { ob = (bf16_t*)(big + BG_KN) + (size_t)pm * 256 * 768 + (pn - 3) * 256; ldc = 768; }
        else if (pn < 18) { ob = (bf16_t*)(big + BG_ON) + (size_t)pm * 256 * 1536 + (pn - 12) * 256; ldc = 1536; act = true; }
        else { ob = (bf16_t*)(big + BG_MQ) + (size_t)pm * 256 * 512 + (pn - 18) * 256; ldc = 512; }
        gm::store_tile_bf16(acc, ob, ldc, rsp, csp, act, wr, wc, fr, fq);
    }
};
struct ProbMemKV {
    static constexpr bool GATHER = false; static constexpr int K = 2048;
    int G, c; const char* memb; const char* w; float* outp; const float* rstd;
    __device__ __forceinline__ bool next(int i, gm::Unit& u) const {
        const int L = i * G + c; if (L >= 32) return false;
        const int l = L >> 4, pm = (L >> 2) & 3, pn = L & 3; u.pm = pm; u.pn = pn; u.e = l; u.x = 0;
        u.a = memb + (size_t)pm * 256 * K * 2; u.b = w + ((size_t)l * 1024 + pn * 256) * K * 2; return true;
    }
    __device__ __forceinline__ unsigned row_off(const gm::Unit&, int) const { return 0u; }
    __device__ __forceinline__ void epi(const f32x4 (&acc)[2][2][4][2], const gm::Unit& u, int wr, int wc, int fr, int fq) const {
        float* ob = outp + ((size_t)u.e * 1024 + u.pm * 256) * 1024 + u.pn * 256;
        float rs8[8];
#pragma unroll
        for (int i = 0; i < 8; ++i) rs8[i] = rstd[u.pm * 256 + (i >> 2) * 128 + wr * 64 + (i & 3) * 16 + fr];
#pragma unroll
        for (int ai = 0; ai < 2; ++ai)
#pragma unroll
            for (int m = 0; m < 4; ++m) { const int r = ai * 128 + wr * 64 + m * 16 + fr; const float rs = rs8[ai * 4 + m]; float* rowp = ob + (size_t)r * 1024 + wc * 32 + 8 * fq;
#pragma unroll
                for (int bj = 0; bj < 2; ++bj) { *(f32x4*)(rowp + bj * 128) = acc[ai][bj][m][0] * rs; *(f32x4*)(rowp + bj * 128 + 4) = acc[ai][bj][m][1] * rs; } }
    }
};
template <bool RESID_F32> struct ProbOut {
    static constexpr bool GATHER = false; static constexpr int K = 2048;
    gm::Order ord; const char* a; const char* w; const void* resid; bf16_t* outp;
    __device__ __forceinline__ bool next(int i, gm::Unit& u) const {
        int pm, pn; if (!ord.get(i, pm, pn)) return false; u.pm = pm; u.pn = pn; u.e = 0; u.x = 0;
        u.a = a + (size_t)pm * 256 * K * 2; u.b = w + (size_t)pn * 256 * K * 2; return true;
    }
    __device__ __forceinline__ unsigned row_off(const gm::Unit&, int) const { return 0u; }
    __device__ __forceinline__ void epi(const f32x4 (&acc)[2][2][4][2], const gm::Unit& u, int wr, int wc, int fr, int fq) const {
#pragma unroll
        for (int ai = 0; ai < 2; ++ai) {
            const size_t off0 = ((size_t)u.pm * 256 + ai * 128 + wr * 64 + fr) * D + u.pn * 256 + wc * 32 + 8 * fq;
            f32x4 rf[4][2][2]; u32x4 rb[4][2];
#pragma unroll
            for (int m = 0; m < 4; ++m)
#pragma unroll
                for (int bj = 0; bj < 2; ++bj) {
                    if (RESID_F32) { const float* rp = (const float*)resid + off0 + (size_t)m * 16 * D + bj * 128; rf[m][bj][0] = *(const f32x4*)rp; rf[m][bj][1] = *(const f32x4*)(rp + 4); }
                    else rb[m][bj] = *(const u32x4*)((const bf16_t*)resid + off0 + (size_t)m * 16 * D + bj * 128); }
#pragma unroll
            for (int m = 0; m < 4; ++m)
#pragma unroll
                for (int bj = 0; bj < 2; ++bj) {
                    f32x4 v0 = acc[ai][bj][m][0], v1 = acc[ai][bj][m][1];
                    if (RESID_F32) { v0 += rf[m][bj][0]; v1 += rf[m][bj][1]; }
                    else { const u32x4 rw = rb[m][bj]; v0 += (f32x4){bflo(rw.x), bfhi(rw.x), bflo(rw.y), bfhi(rw.y)}; v1 += (f32x4){bflo(rw.z), bfhi(rw.z), bflo(rw.w), bfhi(rw.w)}; }
                    u32x4 w4; w4.x = cvtpk(v0[0], v0[1]); w4.y = cvtpk(v0[2], v0[3]); w4.z = cvtpk(v1[0], v1[1]); w4.w = cvtpk(v1[2], v1[3]);
                    *(u32x4*)(outp + off0 + (size_t)m * 16 * D + bj * 128) = w4; }
            asm volatile("" ::: "memory");
        }
    }
};
__device__ __forceinline__ LAS int* moe_tb(LAS unsigned char* lds) { return (LAS int*)(lds + MISC_OFF + 128); }
__device__ __forceinline__ void moe_tables(const Ctx& C, int layer) {
    LAS int* tb = moe_tb(C.lds);
    if (C.tid < 64) { const unsigned* cw = (const unsigned*)(C.ws + WS_CTL) + CW_CNT + layer * 32 * 64; const int e = C.tid & 31;
        const int c = (int)__hip_atomic_load(cw + e * 64, __ATOMIC_RELAXED, __HIP_MEMORY_SCOPE_AGENT);
        int incl = (c + 255) >> 8;
#pragma unroll
        for (int o = 1; o < 32; o <<= 1) { const int t = __shfl_up(incl, o); if (e >= o) incl += t; }
        if (C.tid < 32) { tb[40 + e] = c; tb[e] = incl - ((c + 255) >> 8); if (e == 31) tb[32] = incl; } }
    __syncthreads();
}
__device__ __forceinline__ bool moe_unit(LAS int* tb, int i, int G, int c, gm::Unit& u) {
    int g, pn;
    if ((G & 63) == 0) { const int x = c & 7, j = c >> 3; g = i * (G >> 3) + x * (G >> 6) + (j >> 3); pn = j & 7; }
    else { const int L = i * G + c; g = L >> 3; pn = L & 7; }
    if (g >= tb[32]) return false;
    int e = 0;
#pragma unroll 1
    for (int k = 16; k >= 1; k >>= 1) if (tb[e + k] <= g) e += k;
    u.e = e; u.x = g - tb[e]; u.pm = g; u.pn = pn; return true;
}
struct ProbGU {
    static constexpr bool GATHER = true; static constexpr int K = 2048;
    int G, c; LAS int* tb; const char* xb; const char* w; const int* ltok; const float* lrs; bf16_t* act;
    __device__ __forceinline__ bool next(int i, gm::Unit& u) const {
        if (!moe_unit(tb, i, G, c, u)) return false;
        u.a = xb; u.b = w + ((size_t)u.e * 2048 + u.pn * 256) * K * 2; return true;
    }
    __device__ __forceinline__ unsigned row_off(const gm::Unit& u, int r) const {
        const int slot = u.x * 256 + r; const int idx = slot < tb[40 + u.e] ? ltok[(size_t)u.e * T + slot] : T; return (unsigned)idx * (unsigned)(K * 2);
    }
    __device__ __forceinline__ void epi(const f32x4 (&acc)[2][2][4][2], const gm::Unit& u, int wr, int wc, int fr, int fq) const {
        const int cnt = tb[40 + u.e];
        float rs8[8];
#pragma unroll
        for (int i = 0; i < 8; ++i) { const int slot = u.x * 256 + (i >> 2) * 128 + wr * 64 + (i & 3) * 16 + fr; rs8[i] = slot < cnt ? lrs[(size_t)u.e * T + slot] : 0.f; }
#pragma unroll
        for (int ai = 0; ai < 2; ++ai)
#pragma unroll
            for (int m = 0; m < 4; ++m) { const int r = ai * 128 + wr * 64 + m * 16 + fr; const float rs = rs8[ai * 4 + m];
                float o[8];
#pragma unroll
                for (int n = 0; n < 2; ++n)
#pragma unroll
                    for (int j = 0; j < 4; ++j) { const float g = acc[ai][0][m][n][j] * rs, uu = acc[ai][1][m][n][j] * rs; o[n * 4 + j] = g * __builtin_amdgcn_rcpf(1.f + __builtin_amdgcn_exp2f(-LOG2E * g)) * uu; }
                u32x4 w4; w4.x = cvtpk(o[0], o[1]); w4.y = cvtpk(o[2], o[3]); w4.z = cvtpk(o[4], o[5]); w4.w = cvtpk(o[6], o[7]);
                *(u32x4*)(act + ((size_t)u.pm * 256 + r) * DFF + u.pn * 128 + wc * 32 + 8 * fq) = w4; asm volatile("" ::: "memory"); }
    }
};
struct ProbDown {
    static constexpr bool GATHER = false; static constexpr int K = 1024;
    int G, c; LAS int* tb; const char* act; const char* w; const float* lw; bf16_t* yb;
    __device__ __forceinline__ bool next(int i, gm::Unit& u) const {
        if (!moe_unit(tb, i, G, c, u)) return false;
        u.a = act + (size_t)u.pm * 256 * K * 2; u.b = w + ((size_t)u.e * 2048 + u.pn * 256) * K * 2; return true;
    }
    __device__ __forceinline__ unsigned row_off(const gm::Unit&, int) const { return 0u; }
    __device__ __forceinline__ void epi(const f32x4 (&acc)[2][2][4][2], const gm::Unit& u, int wr, int wc, int fr, int fq) const {
        const int cnt = tb[40 + u.e];
#pragma unroll
        for (int ai = 0; ai < 2; ++ai)
#pragma unroll
            for (int m = 0; m < 4; ++m) { const int r = ai * 128 + wr * 64 + m * 16 + fr; const int slot = u.x * 256 + r; const float ws = slot < cnt ? lw[(size_t)u.e * T + slot] : 0.f;
                bf16_t* rowp = yb + ((size_t)u.pm * 256 + r) * D + u.pn * 256 + wc * 32 + 8 * fq;
#pragma unroll
                for (int bj = 0; bj < 2; ++bj) { const f32x4 v0 = acc[ai][bj][m][0] * ws, v1 = acc[ai][bj][m][1] * ws;
                    u32x4 w4; w4.x = cvtpk(v0[0], v0[1]); w4.y = cvtpk(v0[2], v0[3]); w4.z = cvtpk(v1[0], v1[1]); w4.w = cvtpk(v1[2], v1[3]);
                    *(u32x4*)(rowp + bj * 128) = w4; } }
    }
};
struct ProbL1 {
    static constexpr bool GATHER = false; static constexpr int K = 2048;
    gm::Order ord; const char* xb; const char* w; unsigned char* big; const float* rstd; const int* pos; const float* kgain; const float* qgain;
    __device__ __forceinline__ bool next(int i, gm::Unit& u) const {
        int pm, pn; if (!ord.get(i, pm, pn)) return false; pn = pn < 6 ? pn : pn + 6;
        u.pm = pm; u.pn = pn; u.e = 0; u.x = 0;
        u.a = xb + (size_t)pm * 256 * K * 2; u.b = w + (size_t)pn * 256 * K * 2; return true;
    }
    __device__ __forceinline__ unsigned row_off(const gm::Unit&, int) const { return 0u; }
    __device__ __forceinline__ void epi(const f32x4 (&acc)[2][2][4][2], const gm::Unit& u, int wr, int wc, int fr, int fq) const {
        const int pm = u.pm, pn = u.pn;
        if (pn >= 18) { gm::store_tile_bf16(acc, (bf16_t*)(big + BG_MQ2) + (size_t)pm * 256 * 512 + (pn - 18) * 256, 512, rstd + pm * 256, nullptr, false, wr, wc, fr, fq); return; }
        const bool isq = pn >= 12; const int pl = isq ? pn - 12 : pn;
        bf16_t* ob = (bf16_t*)(big + (isq ? BG_QR : BG_KR)); const float* gain = isq ? qgain : kgain; const float osc = isq ? 0.125f * LOG2E : 1.f;
        float rs8[8]; int ps8[8];
#pragma unroll
        for (int i = 0; i < 8; ++i) { const size_t tok = (size_t)pm * 256 + (i >> 2) * 128 + wr * 64 + (i & 3) * 16 + fr; rs8[i] = rstd[tok]; ps8[i] = pos[tok]; }
        f32x4 g1[2], g2[2], invf[2];
#pragma unroll
        for (int n = 0; n < 2; ++n) { g1[n] = *(const f32x4*)(gain + 8 * fq + 4 * n); g2[n] = *(const f32x4*)(gain + 32 + 8 * fq + 4 * n);
#pragma unroll
            for (int j = 0; j < 4; ++j) invf[n][j] = exp2f(-(float)(8 * fq + 4 * n + j) * (13.287712379549449f / 32.f)) * 0.15915494309189535f; }
#pragma unroll
        for (int ai = 0; ai < 2; ++ai)
#pragma unroll
            for (int m = 0; m < 4; ++m) { const size_t tok = (size_t)pm * 256 + ai * 128 + wr * 64 + m * 16 + fr; const float rs = rs8[ai * 4 + m]; const float pf = (float)ps8[ai * 4 + m];
                float ss = 0.f;
#pragma unroll
                for (int n = 0; n < 2; ++n) { const f32x4 a1 = acc[ai][0][m][n], a2 = acc[ai][1][m][n];
                    ss += (a1[0] * a1[0] + a1[1] * a1[1]) + (a1[2] * a1[2] + a1[3] * a1[3]) + (a2[0] * a2[0] + a2[1] * a2[1]) + (a2[2] * a2[2] + a2[3] * a2[3]); }
                ss *= rs * rs; ss += __shfl_xor(ss, 16); ss += __shfl_xor(ss, 32);
                const float rn = rs * osc * __builtin_amdgcn_rsqf(ss * (1.f / 64.f) + EPS);
                u32x4 w1, w2; unsigned* pw1 = (unsigned*)&w1; unsigned* pw2 = (unsigned*)&w2;
#pragma unroll
                for (int n = 0; n < 2; ++n) { f32x4 cc, sn;
#pragma unroll
                    for (int j = 0; j < 4; ++j) { const float fr_ = __builtin_amdgcn_fractf(pf * invf[n][j]); cc[j] = __builtin_amdgcn_cosf(fr_); sn[j] = __builtin_amdgcn_sinf(fr_); }
                    const f32x4 y1 = acc[ai][0][m][n] * rn * g1[n], y2 = acc[ai][1][m][n] * rn * g2[n];
                    const f32x4 o1 = y1 * cc - y2 * sn, o2 = y1 * sn + y2 * cc;
                    pw1[2 * n] = cvtpk(o1[0], o1[1]); pw1[2 * n + 1] = cvtpk(o1[2], o1[3]); pw2[2 * n] = cvtpk(o2[0], o2[1]); pw2[2 * n + 1] = cvtpk(o2[2], o2[3]); }
                bf16_t* rowp = ob + tok * 1536 + pl * 256 + wc * 64 + 8 * fq;
                *(u32x4*)rowp = w1; *(u32x4*)(rowp + 32) = w2; }
    }
};
constexpr float SX8 = 4.f, SW8 = 256.f, SA8 = 8.f, SD8 = 128.f, SY8 = 64.f;
constexpr float SC8 = 16.f, SWO8 = 256.f;
constexpr size_t WS_X8 = WS_END;
constexpr size_t WS_END8 = WS_END + 66 * MiB;
struct ProbGU8 {
    static constexpr bool GATHER = true; static constexpr int K = 1024;
    int G, c; LAS int* tb; const char* xb; const char* w; const int* ltok; const float* lrs; unsigned char* act;
    __device__ __forceinline__ bool next(int i, gm::Unit& u) const {
        if (!moe_unit(tb, i, G, c, u)) return false;
        u.a = xb; u.b = w + ((size_t)u.e * 2048 + u.pn * 256) * 2048; return true;
    }
    __device__ __forceinline__ unsigned row_off(const gm::Unit& u, int r) const {
        const int slot = u.x * 256 + r, cnt = tb[40 + u.e]; const int v = ltok[(size_t)u.e * T + (slot < cnt ? slot : cnt - 1)];
        return (unsigned)(slot < cnt ? v : T) * 2048u;
    }
    __device__ __forceinline__ void epi8(const f32x16 (&acc)[2][2][2], const gm::Unit& u, int wr, int wc, int c32, int h) const {
        const int cnt = tb[40 + u.e];
        float rs4[4];
#pragma unroll
        for (int i = 0; i < 4; ++i) { const int slot = u.x * 256 + (i >> 1) * 128 + wr * 64 + (i & 1) * 32 + c32; const float v = lrs[(size_t)u.e * T + (slot < cnt ? slot : cnt - 1)]; rs4[i] = slot < cnt ? v * (1.0f / (SX8 * SW8)) : 0.f; }
#pragma unroll
        for (int ai = 0; ai < 2; ++ai)
#pragma unroll
            for (int mb = 0; mb < 2; ++mb) { const int r = ai * 128 + wr * 64 + mb * 32 + c32; const float rs = rs4[ai * 2 + mb];
                float o[16];
#pragma unroll
                for (int i = 0; i < 16; ++i) { const float g = acc[ai][0][mb][i] * rs, uu = acc[ai][1][mb][i] * rs; o[i] = g * __builtin_amdgcn_rcpf(1.f + __builtin_amdgcn_exp2f(-LOG2E * g)) * uu * SA8; }
                u32x4 w4; w4.x = gm::pk_fp8x4(o[0], o[1], o[2], o[3]); w4.y = gm::pk_fp8x4(o[4], o[5], o[6], o[7]); w4.z = gm::pk_fp8x4(o[8], o[9], o[10], o[11]); w4.w = gm::pk_fp8x4(o[12], o[13], o[14], o[15]);
                *(u32x4*)(act + ((size_t)u.pm * 256 + r) * DFF + u.pn * 128 + wc * 32 + 16 * h) = w4; }
    }
};
struct ProbDown8 {
    static constexpr bool GATHER = false; static constexpr int K = 512;
    int G, c; LAS int* tb; const char* act; const char* w; const float* lw; bf16_t* yb;
    __device__ __forceinline__ bool next(int i, gm::Unit& u) const {
        if (!moe_unit(tb, i, G, c, u)) return false;
        u.a = act + (size_t)u.pm * 256 * 1024; u.b = w + ((size_t)u.e * 2048 + u.pn * 256) * 1024; return true;
    }
    __device__ __forceinline__ unsigned row_off(const gm::Unit&, int) const { return 0u; }
    __device__ __forceinline__ void epi8(const f32x16 (&acc)[2][2][2], const gm::Unit& u, int wr, int wc, int c32, int h) const {
        const int cnt = tb[40 + u.e];
        float ws4[4];
#pragma unroll
        for (int i = 0; i < 4; ++i) { const int slot = u.x * 256 + (i >> 1) * 128 + wr * 64 + (i & 1) * 32 + c32; const float v = lw[(size_t)u.e * T + (slot < cnt ? slot : cnt - 1)]; ws4[i] = slot < cnt ? v * (SY8 / (SA8 * SD8)) : 0.f; }
#pragma unroll
        for (int ai = 0; ai < 2; ++ai)
#pragma unroll
            for (int mb = 0; mb < 2; ++mb) { const int r = ai * 128 + wr * 64 + mb * 32 + c32; const float ws = ws4[ai * 2 + mb];
                unsigned char* rowp = (unsigned char*)yb + ((size_t)u.pm * 256 + r) * D + u.pn * 256 + wc * 32 + 16 * h;
#pragma unroll
                for (int bj = 0; bj < 2; ++bj) { u32x4 w0;
                    w0.x = gm::pk_fp8x4(acc[ai][bj][mb][0] * ws, acc[ai][bj][mb][1] * ws, acc[ai][bj][mb][2] * ws, acc[ai][bj][mb][3] * ws);
                    w0.y = gm::pk_fp8x4(acc[ai][bj][mb][4] * ws, acc[ai][bj][mb][5] * ws, acc[ai][bj][mb][6] * ws, acc[ai][bj][mb][7] * ws);
                    w0.z = gm::pk_fp8x4(acc[ai][bj][mb][8] * ws, acc[ai][bj][mb][9] * ws, acc[ai][bj][mb][10] * ws, acc[ai][bj][mb][11] * ws);
                    w0.w = gm::pk_fp8x4(acc[ai][bj][mb][12] * ws, acc[ai][bj][mb][13] * ws, acc[ai][bj][mb][14] * ws, acc[ai][bj][mb][15] * ws);
                    *(u32x4*)(rowp + bj * 128) = w0; }
                asm volatile("" ::: "memory"); }
    }
};

struct ProbOut8 {
    static constexpr bool GATHER = false; static constexpr int K = 1024;
    gm::Order ord; const char* a; const char* w; const bf16_t* resid; bf16_t* outp;
    __device__ __forceinline__ bool next(int i, gm::Unit& u) const {
        int pm, pn; if (!ord.get(i, pm, pn)) return false; u.pm = pm; u.pn = pn; u.e = 0; u.x = 0;
        u.a = a + (size_t)pm * 256 * 2048; u.b = w + (size_t)pn * 256 * 2048; return true;
    }
    __device__ __forceinline__ unsigned row_off(const gm::Unit&, int) const { return 0u; }
    __device__ __forceinline__ void epi8(const f32x16 (&acc)[2][2][2], const gm::Unit& u, int wr, int wc, int c32, int h) const {
        constexpr float sc = 1.0f / (SC8 * SWO8);
#pragma unroll
        for (int ai = 0; ai < 2; ++ai) {
            const size_t off0 = ((size_t)u.pm * 256 + ai * 128 + wr * 64 + c32) * D + u.pn * 256 + wc * 32 + 16 * h;
            u32x4 rb[2][2][2];
#pragma unroll
            for (int mb = 0; mb < 2; ++mb)
#pragma unroll
                for (int bj = 0; bj < 2; ++bj) { const bf16_t* rp = resid + off0 + (size_t)mb * 32 * D + bj * 128; rb[mb][bj][0] = *(const u32x4*)rp; rb[mb][bj][1] = *(const u32x4*)(rp + 8); }
#pragma unroll
            for (int mb = 0; mb < 2; ++mb)
#pragma unroll
                for (int bj = 0; bj < 2; ++bj) { bf16_t* op = outp + off0 + (size_t)mb * 32 * D + bj * 128;
#pragma unroll
                    for (int q = 0; q < 2; ++q) { const u32x4 rw = rb[mb][bj][q]; const f32x16& a = acc[ai][bj][mb];
                        u32x4 w4; w4.x = cvtpk(a[8 * q + 0] * sc + bflo(rw.x), a[8 * q + 1] * sc + bfhi(rw.x)); w4.y = cvtpk(a[8 * q + 2] * sc + bflo(rw.y), a[8 * q + 3] * sc + bfhi(rw.y));
                        w4.z = cvtpk(a[8 * q + 4] * sc + bflo(rw.z), a[8 * q + 5] * sc + bfhi(rw.z)); w4.w = cvtpk(a[8 * q + 6] * sc + bflo(rw.w), a[8 * q + 7] * sc + bfhi(rw.w));
                        *(u32x4*)(op + 8 * q) = w4; } }
            asm volatile("" ::: "memory");
        }
    }
};

struct ProbL1V8 {
    static constexpr bool GATHER = false; static constexpr int K = 1024;
    gm::Order ord; const char* a; const char* w; bf16_t* vn; bf16_t* mq; const float* rstd;
    __device__ __forceinline__ bool next(int i, gm::Unit& u) const {
        int pm, pn; if (!ord.get(i, pm, pn)) return false; u.pm = pm; u.pn = pn; u.e = 0; u.x = 0;
        u.a = a + (size_t)pm * 256 * 2048; u.b = w + (size_t)pn * 256 * 2048; return true;
    }
    __device__ __forceinline__ unsigned row_off(const gm::Unit&, int) const { return 0u; }
    __device__ __forceinline__ void epi8(const f32x16 (&acc)[2][2][2], const gm::Unit& u, int wr, int wc, int c32, int h) const {
        float rs4[4];
#pragma unroll
        for (int i = 0; i < 4; ++i) rs4[i] = rstd[(size_t)u.pm * 256 + (i >> 1) * 128 + wr * 64 + (i & 1) * 32 + c32] * (1.0f / (SX8 * SW8));
#pragma unroll
        for (int ai = 0; ai < 2; ++ai)
#pragma unroll
            for (int mb = 0; mb < 2; ++mb) { const float rs = rs4[ai * 2 + mb];
                const size_t row = (size_t)u.pm * 256 + ai * 128 + wr * 64 + mb * 32 + c32;
                bf16_t* rowp = (u.pn < 6 ? vn + row * 1536 + u.pn * 256 : mq + row * 512 + (u.pn - 6) * 256) + wc * 32 + 16 * h;
#pragma unroll
                for (int bj = 0; bj < 2; ++bj) { const f32x16& a = acc[ai][bj][mb];
#pragma unroll
                    for (int q = 0; q < 2; ++q) { u32x4 w4; w4.x = cvtpk(a[8 * q + 0] * rs, a[8 * q + 1] * rs); w4.y = cvtpk(a[8 * q + 2] * rs, a[8 * q + 3] * rs); w4.z = cvtpk(a[8 * q + 4] * rs, a[8 * q + 5] * rs); w4.w = cvtpk(a[8 * q + 6] * rs, a[8 * q + 7] * rs);
                        *(u32x4*)(rowp + bj * 128 + 8 * q) = w4; } }
                asm volatile("" ::: "memory"); }
    }
};

struct ProbL1F8 {
    static constexpr bool GATHER = false; static constexpr int K = 1024;
    gm::Order ord; const char* a; const char* w; unsigned char* big; const float* rstd; const int* pos; const float* kgain; const float* qgain;
    __device__ __forceinline__ bool next(int i, gm::Unit& u) const {
        int pm, pn; if (!ord.get(i, pm, pn)) return false; u.pm = pm; u.pn = pn; u.e = 0; u.x = 0;
        u.a = a + (size_t)pm * 256 * 2048; u.b = w + (size_t)pn * 256 * 2048; return true;
    }
    __device__ __forceinline__ unsigned row_off(const gm::Unit&, int) const { return 0u; }
    __device__ __forceinline__ void epi8(const f32x16 (&acc)[2][2][2], const gm::Unit& u, int wr, int wc, int c32, int h) const {
        const int pm = u.pm, pn = u.pn;
        float rs4[4];
#pragma unroll
        for (int i = 0; i < 4; ++i) rs4[i] = rstd[(size_t)pm * 256 + (i >> 1) * 128 + wr * 64 + (i & 1) * 32 + c32] * (1.0f / (SX8 * SW8));
        const bool isv = pn >= 6 && pn < 12, ismq = pn >= 18;
        if (isv || ismq) {
#pragma unroll
            for (int ai = 0; ai < 2; ++ai)
#pragma unroll
                for (int mb = 0; mb < 2; ++mb) { const float rs = rs4[ai * 2 + mb];
                    const size_t row = (size_t)pm * 256 + ai * 128 + wr * 64 + mb * 32 + c32;
                    bf16_t* rowp = (isv ? (bf16_t*)(big + BG_VN) + row * 1536 + (pn - 6) * 256 : (bf16_t*)(big + BG_MQ2) + row * 512 + (pn - 18) * 256) + wc * 32 + 16 * h;
#pragma unroll
                    for (int bj = 0; bj < 2; ++bj) { const f32x16& a = acc[ai][bj][mb];
#pragma unroll
                        for (int q = 0; q < 2; ++q) { u32x4 w4; w4.x = cvtpk(a[8 * q + 0] * rs, a[8 * q + 1] * rs); w4.y = cvtpk(a[8 * q + 2] * rs, a[8 * q + 3] * rs); w4.z = cvtpk(a[8 * q + 4] * rs, a[8 * q + 5] * rs); w4.w = cvtpk(a[8 * q + 6] * rs, a[8 * q + 7] * rs);
                            *(u32x4*)(rowp + bj * 128 + 8 * q) = w4; } }
                    asm volatile("" ::: "memory"); }
            return;
        }
        const bool isq = pn >= 12; const int pl = isq ? pn - 12 : pn;
        bf16_t* ob = (bf16_t*)(big + (isq ? BG_QR : BG_KR)); const float* gain = isq ? qgain : kgain; const float osc = isq ? 0.125f * LOG2E : 1.f;
        int ps4[4];
#pragma unroll
        for (int i = 0; i < 4; ++i) ps4[i] = pos[(size_t)pm * 256 + (i >> 1) * 128 + wr * 64 + (i & 1) * 32 + c32];
        f32x4 g1[4], g2[4];
#pragma unroll
        for (int q = 0; q < 4; ++q) { g1[q] = *(const f32x4*)(gain + 16 * h + 4 * q); g2[q] = *(const f32x4*)(gain + 32 + 16 * h + 4 * q); }
        const float fbase = (float)(16 * h) * (13.287712379549449f / 32.f);
#pragma unroll
        for (int ai = 0; ai < 2; ++ai)
#pragma unroll
            for (int mb = 0; mb < 2; ++mb) { const float rs = rs4[ai * 2 + mb]; const float pf = (float)ps4[ai * 2 + mb] * 0.15915494309189535f;
                const size_t tok = (size_t)pm * 256 + ai * 128 + wr * 64 + mb * 32 + c32;
                const f32x16& a1 = acc[ai][0][mb]; const f32x16& a2 = acc[ai][1][mb];
                float ss = 0.f;
#pragma unroll
                for (int i = 0; i < 16; ++i) ss += a1[i] * a1[i] + a2[i] * a2[i];
                ss *= rs * rs; ss += __shfl_xor(ss, 32);
                const float rn = rs * osc * __builtin_amdgcn_rsqf(ss * (1.f / 64.f) + EPS);
                bf16_t* rowp = ob + tok * 1536 + pl * 256 + wc * 64 + 16 * h;
#pragma unroll
                for (int q = 0; q < 2; ++q) { float o1[8], o2[8];
#pragma unroll
                    for (int j = 0; j < 8; ++j) { const int i = 8 * q + j;
                        const float fr_ = __builtin_amdgcn_fractf(pf * __builtin_amdgcn_exp2f(-(fbase + (float)i * (13.287712379549449f / 32.f)))); const float cc = __builtin_amdgcn_cosf(fr_), sn = __builtin_amdgcn_sinf(fr_);
                        const float y1 = a1[i] * rn * g1[i >> 2][i & 3], y2 = a2[i] * rn * g2[i >> 2][i & 3]; o1[j] = y1 * cc - y2 * sn; o2[j] = y1 * sn + y2 * cc; }
                    u32x4 w1, w2;
                    w1.x = cvtpk(o1[0], o1[1]); w1.y = cvtpk(o1[2], o1[3]); w1.z = cvtpk(o1[4], o1[5]); w1.w = cvtpk(o1[6], o1[7]);
                    w2.x = cvtpk(o2[0], o2[1]); w2.y = cvtpk(o2[2], o2[3]); w2.z = cvtpk(o2[4], o2[5]); w2.w = cvtpk(o2[6], o2[7]);
                    *(u32x4*)(rowp + 8 * q) = w1; *(u32x4*)(rowp + 32 + 8 * q) = w2; }
                asm volatile("" ::: "memory"); }
    }
};

struct ProbInA8 {
    static constexpr bool GATHER = false; static constexpr int K = 1024;
    gm::Order ord; const char* a; const char* w; unsigned char* big; const float* rstd;
    __device__ __forceinline__ bool next(int i, gm::Unit& u) const {
        int pm, pn; if (!ord.get(i, pm, pn)) return false; u.pm = pm; u.pn = pn; u.e = 0; u.x = 0;
        u.a = a + (size_t)pm * 256 * 2048; u.b = w + (size_t)pn * 256 * 2048; return true;
    }
    __device__ __forceinline__ unsigned row_off(const gm::Unit&, int) const { return 0u; }
    __device__ __forceinline__ void epi8(const f32x16 (&acc)[2][2][2], const gm::Unit& u, int wr, int wc, int c32, int h) const {
        const int pm = u.pm, pn = u.pn; const bool isg = pn < 6;
        float rs4[4];
#pragma unroll
        for (int i = 0; i < 4; ++i) rs4[i] = rstd[(size_t)pm * 256 + (i >> 1) * 128 + wr * 64 + (i & 1) * 32 + c32] * (1.0f / (SX8 * SW8));
#pragma unroll
        for (int ai = 0; ai < 2; ++ai)
#pragma unroll
            for (int mb = 0; mb < 2; ++mb) { const float rs = rs4[ai * 2 + mb];
                const size_t row = (size_t)pm * 256 + ai * 128 + wr * 64 + mb * 32 + c32;
                bf16_t* rowp = (isg ? (bf16_t*)(big + BG_ON) + row * 1536 + pn * 256 : (bf16_t*)(big + BG_MQ) + row * 512 + (pn - 6) * 256) + wc * 32 + 16 * h;
#pragma unroll
                for (int bj = 0; bj < 2; ++bj) { const f32x16& a = acc[ai][bj][mb];
#pragma unroll
                    for (int q = 0; q < 2; ++q) { float v[8];
#pragma unroll
                        for (int j = 0; j < 8; ++j) { const float t = a[8 * q + j] * rs; v[j] = isg ? __builtin_amdgcn_rcpf(1.f + __builtin_amdgcn_exp2f(-LOG2E * t)) : t; }
                        u32x4 w4; w4.x = cvtpk(v[0], v[1]); w4.y = cvtpk(v[2], v[3]); w4.z = cvtpk(v[4], v[5]); w4.w = cvtpk(v[6], v[7]);
                        *(u32x4*)(rowp + bj * 128 + 8 * q) = w4; } }
                asm volatile("" ::: "memory"); }
    }
};
__device__ __forceinline__ void xpose_item(const float* W, size_t ld, int k0, int n0, bf16_t* dst, int dstep, int Kd, const float* scale, float mul, LAS float* scr, int lane) {
    const int kr = lane >> 4, q = lane & 15;
    f32x4 v[16];
#pragma unroll
    for (int i = 0; i < 16; ++i) v[i] = __builtin_nontemporal_load((const f32x4*)(W + (size_t)(k0 + 4 * i + kr) * ld + n0 + 4 * q));
#pragma unroll
    for (int i = 0; i < 16; ++i) { const int k = 4 * i + kr; const float s = scale ? scale[k0 + k] * mul : mul; *(LAS f32x4*)(scr + k * 64 + 4 * (q ^ ((k >> 3) & 7))) = v[i] * s; }
    LDS_WAIT(); asm volatile("" ::: "memory");
    const int c = lane & 7;
#pragma unroll
    for (int j = 0; j < 8; ++j) { const int n = (lane >> 3) + 8 * j; const LAS float* sp = scr + (8 * c) * 64 + 4 * ((n >> 2) ^ c) + (n & 3);
        u32x4 o; o.x = cvtpk(sp[0], sp[64]); o.y = cvtpk(sp[128], sp[192]); o.z = cvtpk(sp[256], sp[320]); o.w = cvtpk(sp[384], sp[448]);
        *(u32x4*)(dst + (size_t)((n & 31) + (n >> 5) * dstep) * Kd + k0 + 8 * c) = o; }
    LDS_WAIT(); asm volatile("" ::: "memory");
}
__device__ __forceinline__ void xpose_item8(const float* W, size_t ld, int k0, int n0, unsigned char* dst, int Kd, const float* scale, float mul, LAS float* scr, int lane) {
    const int kr = lane >> 4, q = lane & 15;
    f32x4 v[16];
#pragma unroll
    for (int i = 0; i < 16; ++i) v[i] = __builtin_nontemporal_load((const f32x4*)(W + (size_t)(k0 + 4 * i + kr) * ld + n0 + 4 * q));
#pragma unroll
    for (int i = 0; i < 16; ++i) { const int k = 4 * i + kr; const float s = scale ? scale[k0 + k] * mul : mul; *(LAS f32x4*)(scr + k * 64 + 4 * (q ^ ((k >> 3) & 7))) = v[i] * s; }
    LDS_WAIT(); asm volatile("" ::: "memory");
    const int c = lane & 7;
#pragma unroll
    for (int j = 0; j < 8; ++j) { const int n = (lane >> 3) + 8 * j; const LAS float* sp = scr + (8 * c) * 64 + 4 * ((n >> 2) ^ c) + (n & 3);
        u32x2 o; o.x = gm::pk_fp8x4(sp[0], sp[64], sp[128], sp[192]); o.y = gm::pk_fp8x4(sp[256], sp[320], sp[384], sp[448]);
        *(u32x2*)(dst + (size_t)n * Kd + k0 + 8 * c) = o; }
    LDS_WAIT(); asm volatile("" ::: "memory");
}
__device__ __forceinline__ void cast_row(const float* xrow, bf16_t* orow, float* rstd_out, int lane) {
    const f32x4* xr = (const f32x4*)xrow + lane; f32x4 v[8]; float s = 0.f;
#pragma unroll
    for (int j = 0; j < 8; ++j) { v[j] = xr[64 * j]; s += (v[j].x * v[j].x + v[j].y * v[j].y) + (v[j].z * v[j].z + v[j].w * v[j].w); }
    s = wave_sum(s);
    u32x2* o8 = (u32x2*)orow + lane;
#pragma unroll
    for (int j = 0; j < 8; ++j) { u32x2 w; w.x = cvtpk(v[j].x, v[j].y); w.y = cvtpk(v[j].z, v[j].w); o8[64 * j] = w; }
    if (lane == 0) *rstd_out = 1.0f / sqrtf(s * (1.f / D) + EPS);
}
__device__ __forceinline__ void cast_row2(const float* xr0, const float* xr1, bf16_t* o0, bf16_t* o1, float* r0, float* r1, int lane, unsigned char* e0, unsigned char* e1) {
    const f32x4* p0 = (const f32x4*)xr0 + lane; const f32x4* p1 = (const f32x4*)xr1 + lane; f32x4 v[8], w[8]; float s0 = 0.f, s1 = 0.f;
#pragma unroll
    for (int j = 0; j < 8; ++j) { v[j] = p0[64 * j]; w[j] = p1[64 * j]; }
#pragma unroll
    for (int j = 0; j < 8; ++j) { s0 += (v[j].x * v[j].x + v[j].y * v[j].y) + (v[j].z * v[j].z + v[j].w * v[j].w); s1 += (w[j].x * w[j].x + w[j].y * w[j].y) + (w[j].z * w[j].z + w[j].w * w[j].w); }
    s0 = wave_sum(s0); s1 = wave_sum(s1);
    u32x2* q0 = (u32x2*)o0 + lane; u32x2* q1 = (u32x2*)o1 + lane;
#pragma unroll
    for (int j = 0; j < 8; ++j) { u32x2 a; a.x = cvtpk(v[j].x, v[j].y); a.y = cvtpk(v[j].z, v[j].w); q0[64 * j] = a; u32x2 b; b.x = cvtpk(w[j].x, w[j].y); b.y = cvtpk(w[j].z, w[j].w); q1[64 * j] = b; }
#pragma unroll
    for (int j = 0; j < 8; ++j) { ((unsigned*)e0 + lane)[64 * j] = gm::pk_fp8x4(v[j].x * 4.f, v[j].y * 4.f, v[j].z * 4.f, v[j].w * 4.f); ((unsigned*)e1 + lane)[64 * j] = gm::pk_fp8x4(w[j].x * 4.f, w[j].y * 4.f, w[j].z * 4.f, w[j].w * 4.f); }
    if (lane == 0) { *r0 = 1.0f / sqrtf(s0 * (1.f / D) + EPS); *r1 = 1.0f / sqrtf(s1 * (1.f / D) + EPS); }
}
__device__ __forceinline__ void p0_prologue(const Ctx& C) {
    LAS float* scr = (LAS float*)(C.lds + C.wave * 16384);
    const int gw = C.vcu * 8 + C.wave, NGW = C.G * 8, lane = C.lane;
    { bf16_t* xb = WSP(bf16_t, WS_S0); float* rstd0 = WSP(float, WS_RSTD);
      for (int m = gw; m < T / 2; m += NGW) cast_row2(C.in(0) + (size_t)m * D, C.in(0) + (size_t)(m + T / 2) * D, xb + (size_t)m * D, xb + (size_t)(m + T / 2) * D, rstd0 + m, rstd0 + m + T / 2, lane, C.ws + WS_END + (size_t)m * D, C.ws + WS_END + (size_t)(m + T / 2) * D);
      bf16_t* memb = WSP(bf16_t, WS_MEMB); float* rsm = WSP(float, WS_MISC + MS_RSTDMEM);
      for (int m = gw; m < NB * MEMS; m += NGW) cast_row(C.in(1) + (size_t)m * D, memb + (size_t)m * D, rsm + m, lane); }
    { const int gt = C.vcu * 512 + C.tid, NGT = C.G * 512;
      bf16_t* wr = WSP(bf16_t, WS_MISC + MS_WR);
      for (int i = gt; i < 2 * 48 * 2048; i += NGT) { const int l = i / (48 * 2048), n = (i / 2048) % 48, k = i % 2048; float v = 0.f;
          if (n < 4) v = C.in(21)[((size_t)l * D + k) * NG + n]; else if (n < 36) v = C.in(23)[((size_t)l * D + k) * NE + (n - 4)];
          v *= C.in(20)[l * D + k]; const unsigned short hi = f2bf(v); const unsigned short lo = f2bf(v - bf2f(hi));
          wr[(size_t)(l * 2 + 0) * 48 * 2048 + n * 2048 + k] = hi; wr[(size_t)(l * 2 + 1) * 48 * 2048 + n * 2048 + k] = lo; }
      bf16_t* wg = WSP(bf16_t, WS_MISC + MS_WG);
      for (int i = gt; i < 16 * 2048; i += NGT) { const int n = i / 2048, k = i % 2048; float v = 0.f; if (n < 12) v = C.in(8)[(size_t)k * A_IN + 4608 + n] * C.in(3)[k];
          const unsigned short hi = f2bf(v); const unsigned short lo = f2bf(v - bf2f(hi)); wg[n * 2048 + k] = hi; wg[16 * 2048 + n * 2048 + k] = lo; }
      unsigned* zr = (unsigned*)(WSP(bf16_t, WS_S2) + (size_t)T * D);
      for (int i = gt; i < 1024; i += NGT) zr[i] = 0u;
      unsigned* zr8 = (unsigned*)(C.ws + WS_X8 + (size_t)T * 2048);
      for (int i = gt; i < 512; i += NGT) zr8[i] = 0u; }
    constexpr int I_A = 32 * 80, I_O = 32 * 32, I_L = 32 * 80, I_M = 32 * 16, I_G = 32 * 16, I_D = 16 * 32;
    constexpr int N_SMALL = I_A + I_O + I_L + I_O + 2 * I_M;
    constexpr int NITEMS = N_SMALL + 64 * (2 * I_G + I_D);
    struct XP { const float* W; size_t ld; int k0, n0; unsigned char* dst; int dstep, Kd; const float* scale; float mul; int f8; };
    auto params = [&](int it) -> XP {
        XP x; int r = it; x.dstep = 32; x.f8 = 0; x.mul = 1.f; x.scale = nullptr;
        if (r < I_A) { const int kb = r / 80, nb = r % 80; const int dr = nb * 64; x.W = C.in(8); x.ld = A_IN; x.k0 = kb * 64; x.n0 = dr < 4608 ? dr : dr + 12; x.dst = C.ws + WS_WINA + (size_t)dr * D * 2; x.Kd = D; x.scale = C.in(3); x.mul = dr < 768 ? 0.08838834764831845f : 1.f;
            if (dr >= 3072) { x.f8 = 1; x.mul = 256.f; x.dst = C.ws + WS_WINA + (size_t)3072 * D * 2 + (size_t)(dr - 3072) * D; }
            return x; } r -= I_A;
        if (r < I_O) { const int kb = r / 32, nb = r % 32; x.W = C.in(11); x.ld = D; x.k0 = kb * 64; x.n0 = nb * 64; x.dst = C.ws + WS_WOUTA + (size_t)nb * 64 * D * 2; x.Kd = D; return x; } r -= I_O;
        if (r < I_L) { const int kb = r / 80, nb = r % 80; const int dr0 = nb * 64;
            const bool isk = dr0 < 1536, isv = dr0 >= 1536 && dr0 < 3072, isq = dr0 >= 3072 && dr0 < 4608;
            x.W = (isk || isv) ? C.in(13) : C.in(15); x.ld = (isk || isv) ? 3072 : 2048; x.n0 = (isk || isv) ? dr0 : dr0 - 3072; x.k0 = kb * 64;
            int dr = dr0;
            if (isk || isq) { const int base = isk ? 0 : 3072, loc = dr0 - base, tile = loc >> 8, wc = (loc >> 6) & 3; dr = base + tile * 256 + wc * 32; x.dstep = 128; }
            x.dst = C.ws + WS_WL1 + (size_t)dr * D; x.Kd = D; x.scale = (isk || isv) ? C.in(12) : C.in(3) + D; x.f8 = 1; x.mul = SW8;
            return x; } r -= I_L;
        if (r < I_O) { const int kb = r / 32, nb = r % 32; x.W = C.in(19); x.ld = D; x.k0 = kb * 64; x.n0 = nb * 64; x.dst = C.ws + WS_WOUTB + (size_t)nb * 64 * D; x.Kd = D; x.f8 = 1; x.mul = SWO8; return x; } r -= I_O;
        if (r < 2 * I_M) { const int l = r / I_M, q = r % I_M, kb = q / 16, nb = q % 16; x.W = C.in(5) + (size_t)l * D * 1024; x.ld = 1024; x.k0 = kb * 64; x.n0 = nb * 64; x.dst = C.ws + WS_WMEM + ((size_t)l * 1024 + nb * 64) * D * 2; x.Kd = D; x.scale = C.in(4) + l * D; return x; } r -= 2 * I_M;
        { const int le = r / (2 * I_G + I_D), q = r % (2 * I_G + I_D), l = le >> 5; x.f8 = 1;
          if (q < 2 * I_G) { const int up = q >= I_G, qq = q - up * I_G, kb = qq / 16, nb = qq % 16; const int h0 = nb * 64; const int dr = 256 * (h0 >> 7) + (h0 & 127) + up * 128;
              x.W = (up ? C.in(26) : C.in(25)) + (size_t)le * D * DFF; x.ld = DFF; x.k0 = kb * 64; x.n0 = h0; x.dst = C.ws + WS_WGU + ((size_t)le * 2048 + dr) * D; x.Kd = D; x.scale = C.in(20) + l * D; x.mul = SW8; }
          else { const int qq = q - 2 * I_G, kb = qq / 32, nb = qq % 32; x.W = C.in(27) + (size_t)le * DFF * D; x.ld = D; x.k0 = kb * 64; x.n0 = nb * 64; x.dst = C.ws + WS_WD + ((size_t)le * 2048 + nb * 64) * DFF; x.Kd = DFF; x.mul = SD8; } }
        return x;
    };
    const int kr = lane >> 4, q16 = lane & 15, c8 = lane & 7;
#define XP_LOAD(X, V) do { _Pragma("unroll") for (int i = 0; i < 16; ++i) V[i] = __builtin_nontemporal_load((const f32x4*)(X.W + (size_t)(X.k0 + 4 * i + kr) * X.ld + X.n0 + 4 * q16)); } while (0)
    auto xp_store = [&](const XP& x, const f32x4 (&v)[16]) {
#pragma unroll
        for (int i = 0; i < 16; ++i) { const int k = 4 * i + kr; const float sc = x.scale ? x.scale[x.k0 + k] * x.mul : x.mul; *(LAS f32x4*)(scr + k * 64 + 4 * (q16 ^ ((k >> 3) & 7))) = v[i] * sc; }
        LDS_WAIT(); asm volatile("" ::: "memory");
        if (x.f8) {
#pragma unroll
            for (int j = 0; j < 8; ++j) { const int n = (lane >> 3) + 8 * j; const LAS float* sp = scr + (8 * c8) * 64 + 4 * ((n >> 2) ^ c8) + (n & 3);
                u32x2 o; o.x = gm::pk_fp8x4(sp[0], sp[64], sp[128], sp[192]); o.y = gm::pk_fp8x4(sp[256], sp[320], sp[384], sp[448]);
                *(u32x2*)(x.dst + (size_t)((n & 31) + (n >> 5) * x.dstep) * x.Kd + x.k0 + 8 * c8) = o; }
        } else {
#pragma unroll
            for (int j = 0; j < 8; ++j) { const int n = (lane >> 3) + 8 * j; const LAS float* sp = scr + (8 * c8) * 64 + 4 * ((n >> 2) ^ c8) + (n & 3);
                u32x4 o; o.x = cvtpk(sp[0], sp[64]); o.y = cvtpk(sp[128], sp[192]); o.z = cvtpk(sp[256], sp[320]); o.w = cvtpk(sp[384], sp[448]);
                *(u32x4*)(x.dst + ((size_t)((n & 31) + (n >> 5) * x.dstep) * x.Kd + x.k0 + 8 * c8) * 2) = o; }
        }
        LDS_WAIT(); asm volatile("" ::: "memory");
    };
    if (gw < NITEMS) {
        auto remap = [&](int it) { return it < NITEMS - N_SMALL ? it + N_SMALL : it - (NITEMS - N_SMALL); };
        XP cur = params(remap(gw)); f32x4 v[16]; XP_LOAD(cur, v);
#pragma unroll 1
        for (int it = gw; it < NITEMS; it += NGW) {
            const int nit = it + NGW; const bool hn = nit < NITEMS;
            XP nx = cur; f32x4 w[16];
            if (hn) { nx = params(remap(nit)); XP_LOAD(nx, w); }
            xp_store(cur, v);
            if (hn) { cur = nx;
#pragma unroll
                for (int i = 0; i < 16; ++i) v[i] = w[i]; }
        }
    }
#undef XP_LOAD
}
template <int NBK>
__device__ __forceinline__ void skinny16(const bf16_t* xrows, const bf16_t* whi, const bf16_t* wlo, f32x4 (&acc)[NBK], float& ss, int lane, unsigned char* x8rows = nullptr) {
    const int t = lane & 15, g = lane >> 4;
    const bf16_t* xp = xrows + (size_t)t * D + 16 * g;
    const bf16_t* hp = whi + (size_t)t * D + 16 * g; const bf16_t* lp = wlo + (size_t)t * D + 16 * g;
#pragma unroll
    for (int nb = 0; nb < NBK; ++nb) acc[nb] = (f32x4){0.f, 0.f, 0.f, 0.f};
    float s = 0.f;
#define SK_LOAD(X, S_) do { xa##X = *(const u32x4*)(xp + 64 * (S_)); xc##X = *(const u32x4*)(xp + 64 * (S_) + 8); \
        _Pragma("unroll") for (int nb = 0; nb < NBK; ++nb) { h0##X[nb] = *(const bf16x8*)(hp + (size_t)nb * 16 * D + 64 * (S_)); h1##X[nb] = *(const bf16x8*)(hp + (size_t)nb * 16 * D + 64 * (S_) + 8); \
            l0##X[nb] = *(const bf16x8*)(lp + (size_t)nb * 16 * D + 64 * (S_)); l1##X[nb] = *(const bf16x8*)(lp + (size_t)nb * 16 * D + 64 * (S_) + 8); } } while (0)
#define SK_COMP(X, S_) do { const u32x4 xa = xa##X, xc = xc##X; \
        s += (bflo(xa.x) * bflo(xa.x) + bfhi(xa.x) * bfhi(xa.x)) + (bflo(xa.y) * bflo(xa.y) + bfhi(xa.y) * bfhi(xa.y)) + (bflo(xa.z) * bflo(xa.z) + bfhi(xa.z) * bfhi(xa.z)) + (bflo(xa.w) * bflo(xa.w) + bfhi(xa.w) * bfhi(xa.w)); \
        s += (bflo(xc.x) * bflo(xc.x) + bfhi(xc.x) * bfhi(xc.x)) + (bflo(xc.y) * bflo(xc.y) + bfhi(xc.y) * bfhi(xc.y)) + (bflo(xc.z) * bflo(xc.z) + bfhi(xc.z) * bfhi(xc.z)) + (bflo(xc.w) * bflo(xc.w) + bfhi(xc.w) * bfhi(xc.w)); \
        const bf16x8 fa = __builtin_bit_cast(bf16x8, xa), fc = __builtin_bit_cast(bf16x8, xc); \
        if (x8rows) { u32x4 q8; q8.x = gm::pk_fp8x4(bflo(xa.x) * SX8, bfhi(xa.x) * SX8, bflo(xa.y) * SX8, bfhi(xa.y) * SX8); q8.y = gm::pk_fp8x4(bflo(xa.z) * SX8, bfhi(xa.z) * SX8, bflo(xa.w) * SX8, bfhi(xa.w) * SX8); \
            q8.z = gm::pk_fp8x4(bflo(xc.x) * SX8, bfhi(xc.x) * SX8, bflo(xc.y) * SX8, bfhi(xc.y) * SX8); q8.w = gm::pk_fp8x4(bflo(xc.z) * SX8, bfhi(xc.z) * SX8, bflo(xc.w) * SX8, bfhi(xc.w) * SX8); \
            *(u32x4*)(x8rows + (size_t)t * D + 16 * g + 64 * (S_)) = q8; } \
        _Pragma("unroll") for (int nb = 0; nb < NBK; ++nb) { \
            acc[nb] = __builtin_amdgcn_mfma_f32_16x16x32_bf16(h0##X[nb], fa, acc[nb], 0, 0, 0); acc[nb] = __builtin_amdgcn_mfma_f32_16x16x32_bf16(h1##X[nb], fc, acc[nb], 0, 0, 0); \
            acc[nb] = __builtin_amdgcn_mfma_f32_16x16x32_bf16(l0##X[nb], fa, acc[nb], 0, 0, 0); acc[nb] = __builtin_amdgcn_mfma_f32_16x16x32_bf16(l1##X[nb], fc, acc[nb], 0, 0, 0); } } while (0)
    u32x4 xaA, xcA, xaB, xcB; bf16x8 h0A[NBK], h1A[NBK], l0A[NBK], l1A[NBK], h0B[NBK], h1B[NBK], l0B[NBK], l1B[NBK];
    SK_LOAD(A, 0);
#pragma unroll 1
    for (int S = 0; S < 32; S += 2) {
        SK_LOAD(B, S + 1);
        SK_COMP(A, S);
        if (S + 2 < 32) SK_LOAD(A, S + 2);
        SK_COMP(B, S + 1);
    }
#undef SK_LOAD
#undef SK_COMP
    s += __shfl_xor(s, 16); s += __shfl_xor(s, 32); ss = s;
}
__device__ __forceinline__ void gates_phase(const Ctx& C, int w0, int nw) {
    const bf16_t* xb = WSP(bf16_t, WS_S0); const bf16_t* wg = WSP(bf16_t, WS_MISC + MS_WG); const float* rstd0 = WSP(float, WS_RSTD); float* gates = WSP(float, WS_GATES);
    const int lane = C.lane, t = lane & 15, g = lane >> 4;
    for (int tile = w0; tile < T / 16; tile += nw) {
        f32x4 acc[1]; float ss; skinny16<1>(xb + (size_t)tile * 16 * D, wg, wg + 16 * 2048, acc, ss, lane);
        const int tok = tile * 16 + t; const float rs = rstd0[tok];
        if (g < 3) { f32x4 o;
#pragma unroll
            for (int r = 0; r < 4; ++r) o[r] = acc[0][r] * rs + C.in(9)[4 * g + r];
            *(f32x4*)(gates + (size_t)tok * 16 + 4 * g) = o; }
    }
}
__device__ __forceinline__ void router_logits(const Ctx& C, const bf16_t* xrows, const bf16_t* whi, const bf16_t* wlo, LAS unsigned char* Wb, f32x4 (&acc)[3], float& ss, unsigned char* x8rows) {
    const int lane = C.lane, tid = C.tid, t = lane & 15, g = lane >> 4;
    const bf16_t* xp = xrows + (size_t)t * D + 16 * g;
#pragma unroll
    for (int nb = 0; nb < 3; ++nb) acc[nb] = (f32x4){0.f, 0.f, 0.f, 0.f};
    float s = 0.f;
    u32x4 wreg[6];
#define RL_WLOAD(c_) do { _Pragma("unroll") for (int j = 0; j < 6; ++j) { const int p = tid + 512 * j, hl = p / 1536, rem = p % 1536, n = rem >> 5, q = rem & 31; \
        wreg[j] = *(const u32x4*)((hl ? wlo : whi) + (size_t)n * D + 256 * (c_) + 8 * q); } } while (0)
    RL_WLOAD(0);
#pragma unroll 1
    for (int c = 0; c < 8; ++c) {
        u32x4 xa[4], xc[4];
#pragma unroll
        for (int S = 0; S < 4; ++S) { xa[S] = *(const u32x4*)(xp + 256 * c + 64 * S); xc[S] = *(const u32x4*)(xp + 256 * c + 64 * S + 8); }
        __syncthreads();
#pragma unroll
        for (int j = 0; j < 6; ++j) { const int p = tid + 512 * j, hl = p / 1536, rem = p % 1536, n = rem >> 5, q = rem & 31; *(LAS u32x4*)(Wb + hl * (48 * 528) + n * 528 + q * 16) = wreg[j]; }
        if (c + 1 < 8) RL_WLOAD(c + 1);
        __syncthreads();
#pragma unroll
        for (int S = 0; S < 4; ++S) {
            const u32x4 a = xa[S], b = xc[S];
            s += (bflo(a.x) * bflo(a.x) + bfhi(a.x) * bfhi(a.x)) + (bflo(a.y) * bflo(a.y) + bfhi(a.y) * bfhi(a.y)) + (bflo(a.z) * bflo(a.z) + bfhi(a.z) * bfhi(a.z)) + (bflo(a.w) * bflo(a.w) + bfhi(a.w) * bfhi(a.w));
            s += (bflo(b.x) * bflo(b.x) + bfhi(b.x) * bfhi(b.x)) + (bflo(b.y) * bflo(b.y) + bfhi(b.y) * bfhi(b.y)) + (bflo(b.z) * bflo(b.z) + bfhi(b.z) * bfhi(b.z)) + (bflo(b.w) * bflo(b.w) + bfhi(b.w) * bfhi(b.w));
            const bf16x8 fa = __builtin_bit_cast(bf16x8, a), fc = __builtin_bit_cast(bf16x8, b);
            { u32x4 q8; q8.x = gm::pk_fp8x4(bflo(a.x) * SX8, bfhi(a.x) * SX8, bflo(a.y) * SX8, bfhi(a.y) * SX8); q8.y = gm::pk_fp8x4(bflo(a.z) * SX8, bfhi(a.z) * SX8, bflo(a.w) * SX8, bfhi(a.w) * SX8);
              q8.z = gm::pk_fp8x4(bflo(b.x) * SX8, bfhi(b.x) * SX8, bflo(b.y) * SX8, bfhi(b.y) * SX8); q8.w = gm::pk_fp8x4(bflo(b.z) * SX8, bfhi(b.z) * SX8, bflo(b.w) * SX8, bfhi(b.w) * SX8);
              *(u32x4*)(x8rows + (size_t)t * D + 16 * g + 256 * c + 64 * S) = q8; }
#pragma unroll
            for (int nb = 0; nb < 3; ++nb) { const LAS unsigned char* wp = Wb + (16 * nb + t) * 528 + (64 * S + 16 * g) * 2;
                const bf16x8 h0 = *(const LAS bf16x8*)wp, h1 = *(const LAS bf16x8*)(wp + 16), l0 = *(const LAS bf16x8*)(wp + 48 * 528), l1 = *(const LAS bf16x8*)(wp + 48 * 528 + 16);
                acc[nb] = __builtin_amdgcn_mfma_f32_16x16x32_bf16(h0, fa, acc[nb], 0, 0, 0); acc[nb] = __builtin_amdgcn_mfma_f32_16x16x32_bf16(h1, fc, acc[nb], 0, 0, 0);
                acc[nb] = __builtin_amdgcn_mfma_f32_16x16x32_bf16(l0, fa, acc[nb], 0, 0, 0); acc[nb] = __builtin_amdgcn_mfma_f32_16x16x32_bf16(l1, fc, acc[nb], 0, 0, 0); }
        }
    }
#undef RL_WLOAD
    s += __shfl_xor(s, 16); s += __shfl_xor(s, 32); ss = s;
}
__device__ __forceinline__ void router_phase(const Ctx& C, int layer, const bf16_t* xb, float* rstd_out, int cslot) {
    const bf16_t* whi = WSP(bf16_t, WS_MISC + MS_WR) + (size_t)layer * 2 * 48 * 2048; const bf16_t* wlo = whi + 48 * 2048;
    const float* bg = C.in(22) + layer * NG; const float* be = C.in(24) + layer * NE;
    int* ltok = WSP(int, WS_LIST); float* lw = WSP(float, WS_LIST + 4 * MiB); float* lrs = WSP(float, WS_LIST + 8 * MiB); int* tokslot = WSP(int, WS_LIST + 12 * MiB);
    unsigned* cw = (unsigned*)(C.ws + WS_CTL) + CW_CNT + cslot * 32 * 64;
    LAS float* scr = (LAS float*)(C.lds + C.wave * 3200); LAS int* lcnt = (LAS int*)(C.lds + 25600); LAS int* lbase = lcnt + 32;
    const int lane = C.lane, t = lane & 15, g = lane >> 4;
    for (int tile = C.bid; tile < T / 128; tile += C.G) {
        if (C.tid < 32) lcnt[C.tid] = 0;
        __syncthreads();
        const int tok0 = tile * 128 + C.wave * 16;
        f32x4 acc[3]; float ss; router_logits(C, xb + (size_t)tok0 * D, whi, wlo, C.lds + 26112, acc, ss, C.ws + WS_X8 + (size_t)tok0 * D);
#pragma unroll
        for (int nb = 0; nb < 3; ++nb)
#pragma unroll
            for (int r = 0; r < 4; ++r) scr[t * 49 + 16 * nb + 4 * g + r] = acc[nb][r];
        LDS_WAIT(); asm volatile("" ::: "memory");
        int e1 = 0, e2 = 0, lp1 = 0, lp2 = 0; float w1 = 0.f, w2 = 0.f, rs = 0.f;
        if (lane < 16) {
            rs = 1.0f / sqrtf(ss * (1.f / D) + EPS);
            const LAS float* row = scr + lane * 49;
            float lg0 = row[0] * rs + bg[0], lg1 = row[1] * rs + bg[1], lg2 = row[2] * rs + bg[2], lg3 = row[3] * rs + bg[3];
            int gi = 0; float gm = lg0; if (lg1 > gm) { gm = lg1; gi = 1; } if (lg2 > gm) { gm = lg2; gi = 2; } if (lg3 > gm) { gm = lg3; gi = 3; }
            const float gsum = expf(lg0 - gm) + expf(lg1 - gm) + expf(lg2 - gm) + expf(lg3 - gm); const float gw = 1.0f / gsum;
            float le[8];
#pragma unroll
            for (int i = 0; i < 8; ++i) le[i] = row[4 + 8 * gi + i] * rs + be[8 * gi + i];
            int i1 = 0; float m1 = le[0];
#pragma unroll
            for (int i = 1; i < 8; ++i) if (le[i] > m1) { m1 = le[i]; i1 = i; }
            int i2 = -1; float m2 = -INFINITY;
#pragma unroll
            for (int i = 0; i < 8; ++i) if (i != i1 && le[i] > m2) { m2 = le[i]; i2 = i; }
            const float d = expf(m2 - m1); const float ew1 = 1.0f / (1.0f + d), ew2 = d / (1.0f + d);
            e1 = 8 * gi + i1; e2 = 8 * gi + i2; w1 = gw * ew1; w2 = gw * ew2;
            lp1 = atomicAdd((int*)(lcnt + e1), 1); lp2 = atomicAdd((int*)(lcnt + e2), 1);
            rstd_out[tok0 + lane] = rs;
        }
        __syncthreads();
        if (C.tid < 32) { const int c = lcnt[C.tid]; int b = 0; if (c > 0) b = (int)__hip_atomic_fetch_add(cw + C.tid * 64, (unsigned)c, __ATOMIC_RELAXED, __HIP_MEMORY_SCOPE_AGENT); lbase[C.tid] = b; }
        __syncthreads();
        if (lane < 16) { const int tok = tok0 + lane; const int p1 = lbase[e1] + lp1, p2 = lbase[e2] + lp2;
            ltok[(size_t)e1 * T + p1] = tok; lw[(size_t)e1 * T + p1] = w1; lrs[(size_t)e1 * T + p1] = rs;
            ltok[(size_t)e2 * T + p2] = tok; lw[(size_t)e2 * T + p2] = w2; lrs[(size_t)e2 * T + p2] = rs;
            tokslot[2 * tok] = (e1 << 16) | p1; tokslot[2 * tok + 1] = (e2 << 16) | p2; }
    }
}
template <bool F32OUT>
__device__ __forceinline__ void combine_phase(const Ctx& C, const bf16_t* xold, const bf16_t* yb, bf16_t* xnew, float* rstd_out, float* outf) {
    LAS int* tb = moe_tb(C.lds); const int* tokslot = WSP(int, WS_LIST + 12 * MiB);
    const int gw = C.vcu * 8 + C.wave, NGW = C.G * 8, lane = C.lane;
    int tok = gw; if (tok >= T) return;
    int s0 = tokslot[2 * tok], s1 = tokslot[2 * tok + 1];
#pragma unroll 1
    for (; tok < T; tok += NGW) {
        const size_t r0 = (size_t)tb[s0 >> 16] * 256 + (s0 & 0xffff), r1 = (size_t)tb[s1 >> 16] * 256 + (s1 & 0xffff);
        const u32x4* px = (const u32x4*)(xold + (size_t)tok * D) + lane; const u32x2* p0 = (const u32x2*)((const unsigned char*)yb + r0 * D) + lane; const u32x2* p1 = (const u32x2*)((const unsigned char*)yb + r1 * D) + lane;
        u32x4 a[4]; u32x2 b[4], c[4];
#pragma unroll
        for (int j = 0; j < 4; ++j) { a[j] = px[64 * j]; b[j] = p0[64 * j]; c[j] = p1[64 * j]; }
        const int tn = tok + NGW; if (tn < T) { s0 = tokslot[2 * tn]; s1 = tokslot[2 * tn + 1]; }
        __builtin_amdgcn_sched_barrier(0);
        float ss = 0.f;
#pragma unroll
        for (int j = 0; j < 4; ++j) { float v[8];
            const f32x2 b0 = __builtin_amdgcn_cvt_pk_f32_fp8((int)b[j].x, false), b1 = __builtin_amdgcn_cvt_pk_f32_fp8((int)b[j].x, true), b2 = __builtin_amdgcn_cvt_pk_f32_fp8((int)b[j].y, false), b3 = __builtin_amdgcn_cvt_pk_f32_fp8((int)b[j].y, true);
            const f32x2 c0 = __builtin_amdgcn_cvt_pk_f32_fp8((int)c[j].x, false), c1 = __builtin_amdgcn_cvt_pk_f32_fp8((int)c[j].x, true), c2 = __builtin_amdgcn_cvt_pk_f32_fp8((int)c[j].y, false), c3 = __builtin_amdgcn_cvt_pk_f32_fp8((int)c[j].y, true);
            constexpr float iy = 1.0f / SY8;
            v[0] = bflo(a[j].x) + (b0.x + c0.x) * iy; v[1] = bfhi(a[j].x) + (b0.y + c0.y) * iy; v[2] = bflo(a[j].y) + (b1.x + c1.x) * iy; v[3] = bfhi(a[j].y) + (b1.y + c1.y) * iy;
            v[4] = bflo(a[j].z) + (b2.x + c2.x) * iy; v[5] = bfhi(a[j].z) + (b2.y + c2.y) * iy; v[6] = bflo(a[j].w) + (b3.x + c3.x) * iy; v[7] = bfhi(a[j].w) + (b3.y + c3.y) * iy;
            if (F32OUT) { float* o = outf + (size_t)tok * D + (64 * j + lane) * 8; *(f32x4*)o = (f32x4){v[0], v[1], v[2], v[3]}; *(f32x4*)(o + 4) = (f32x4){v[4], v[5], v[6], v[7]}; }
            else { u32x4 w; w.x = cvtpk(v[0], v[1]); w.y = cvtpk(v[2], v[3]); w.z = cvtpk(v[4], v[5]); w.w = cvtpk(v[6], v[7]);
                ss += (bflo(w.x) * bflo(w.x) + bfhi(w.x) * bfhi(w.x)) + (bflo(w.y) * bflo(w.y) + bfhi(w.y) * bfhi(w.y)) + (bflo(w.z) * bflo(w.z) + bfhi(w.z) * bfhi(w.z)) + (bflo(w.w) * bflo(w.w) + bfhi(w.w) * bfhi(w.w));
                ((u32x4*)(xnew + (size_t)tok * D) + lane)[64 * j] = w;
                u32x2 w8; w8.x = gm::pk_fp8x4(v[0] * SX8, v[1] * SX8, v[2] * SX8, v[3] * SX8); w8.y = gm::pk_fp8x4(v[4] * SX8, v[5] * SX8, v[6] * SX8, v[7] * SX8);
                ((u32x2*)(C.ws + WS_X8 + (size_t)tok * D) + lane)[64 * j] = w8; } }
        if (!F32OUT) { ss = wave_sum(ss); if (lane == 0) rstd_out[tok] = 1.0f / sqrtf(ss * (1.f / D) + EPS); }
    }
}
__device__ __forceinline__ float logsigmoidf(float f) { return fminf(f, 0.f) - log1pf(expf(-fabsf(f))); }
__device__ __forceinline__ float wave_incl_sum(float v, int lane) {
#pragma unroll
    for (int o = 1; o < 64; o <<= 1) { const float t = __shfl_up(v, o); if (lane >= o) v += t; }
    return v;
}
__device__ __forceinline__ float wave_incl_max(float v, int lane) {
#pragma unroll
    for (int o = 1; o < 64; o <<= 1) { const float t = __shfl_up(v, o); if (lane >= o) v = fmaxf(v, t); }
    return v;
}
__device__ __forceinline__ float wave_max(float v) {
#pragma unroll
    for (int o = 1; o < 64; o <<= 1) v = fmaxf(v, __shfl_xor(v, o));
    return v;
}
constexpr int LROW = 272;
__device__ __forceinline__ void mlstm_a(const Ctx& C) {
    const float* gates = WSP(float, WS_GATES); const bf16_t* Kn = WSP(bf16_t, WS_BIG + BG_KN); const bf16_t* VT = WSP(bf16_t, WS_BIG + BG_VT);
    bf16_t* dCT = WSP(bf16_t, WS_BIG + BG_DCT); float* bl = WSP(float, WS_MISC + MS_BL); float* ml = WSP(float, WS_MISC + MS_ML); float* dn = WSP(float, WS_MISC + MS_DN);
    LAS unsigned char* KwT = C.lds; LAS float* wst = (LAS float*)(C.lds + 128 * LROW);
    float* gsa = WSP(float, WS_ROPE); float* gsb = gsa + 24 * LNC * 128; float* gspm = gsb + 24 * LNC * 128;
    const int tid = C.tid, lane = C.lane, wave = C.wave, fr = lane & 15, g = lane >> 4;
    for (int u = C.bid; u < 24 * LNC; u += C.G) {
        const int bh = u >> 6, j = u & 63, b = bh / LH, h = bh % LH; const size_t tok0 = (size_t)b * SEQ + j * LCH;
        if (wave == 0) {
            const float* gp = gates + (tok0 + 2 * lane) * 16;
            const float i0 = gp[h], i1 = gp[16 + h], x0 = logsigmoidf(gp[6 + h]), x1 = logsigmoidf(gp[16 + 6 + h]);
            const float ps = x0 + x1, incl = wave_incl_sum(ps, lane), excl = incl - ps, b0 = excl + x0, b1 = excl + ps;
            const float blast = __shfl(incl, 63);
            const float st0 = blast - b0 + i0, st1 = blast - b1 + i1; const float mloc = wave_max(fmaxf(st0, st1));
            wst[2 * lane] = expf(st0 - mloc); wst[2 * lane + 1] = expf(st1 - mloc);
            if (lane == 0) { bl[u] = blast; ml[u] = mloc; }
            { const float a0 = i0 - b0, a1 = i1 - b1; const float pmx = wave_incl_max(fmaxf(a0, a1), lane); const float pprev = __shfl_up(pmx, 1); const float pm0 = lane > 0 ? fmaxf(pprev, a0) : a0;
              *(f32x2*)(gsa + (size_t)u * 128 + 2 * lane) = (f32x2){a0, a1}; *(f32x2*)(gsb + (size_t)u * 128 + 2 * lane) = (f32x2){b0, b1}; *(f32x2*)(gspm + (size_t)u * 128 + 2 * lane) = (f32x2){pm0, pmx}; }
        }
        __syncthreads();
        { const int s = tid >> 2, dq = tid & 3; const float w = wst[s]; const bf16_t* kp = Kn + (tok0 + s) * 768 + h * 128 + dq * 32;
#pragma unroll
          for (int i = 0; i < 4; ++i) { const u32x4 kv = *(const u32x4*)(kp + 8 * i); const unsigned kw[4] = {kv.x, kv.y, kv.z, kv.w};
#pragma unroll
              for (int q = 0; q < 4; ++q) { const int d = dq * 32 + 8 * i + 2 * q; const unsigned pk = cvtpk(bflo(kw[q]) * w, bfhi(kw[q]) * w);
                  *(LAS unsigned short*)(KwT + d * LROW + s * 2) = (unsigned short)(pk & 0xffffu); *(LAS unsigned short*)(KwT + (d + 1) * LROW + s * 2) = (unsigned short)(pk >> 16); } } }
        __syncthreads();
        if (tid < 128) { float s = 0.f;
#pragma unroll
            for (int i = 0; i < 16; ++i) { const u32x4 v = *(const LAS u32x4*)(KwT + tid * LROW + i * 16); s += (bflo(v.x) + bfhi(v.x)) + (bflo(v.y) + bfhi(v.y)) + (bflo(v.z) + bfhi(v.z)) + (bflo(v.w) + bfhi(v.w)); }
            dn[(size_t)u * 128 + tid] = s; }
        bf16x8 vf[2][4];
#pragma unroll
        for (int vi = 0; vi < 2; ++vi)
#pragma unroll
            for (int ks = 0; ks < 4; ++ks) vf[vi][ks] = *(const bf16x8*)(VT + ((size_t)bh * LDV + 16 * (2 * wave + vi) + fr) * SEQ + j * LCH + 32 * ks + 8 * g);
#pragma unroll
        for (int db = 0; db < 8; ++db) {
            bf16x8 kf[4];
#pragma unroll
            for (int ks = 0; ks < 4; ++ks) kf[ks] = *(const LAS bf16x8*)(KwT + (16 * db + fr) * LROW + (32 * ks + 8 * g) * 2);
#pragma unroll
            for (int vi = 0; vi < 2; ++vi) { f32x4 a = {0.f, 0.f, 0.f, 0.f};
#pragma unroll
                for (int ks = 0; ks < 4; ++ks) a = __builtin_amdgcn_mfma_f32_16x16x32_bf16(kf[ks], vf[vi][ks], a, 0, 0, 0);
                u32x2 w; w.x = cvtpk(a[0], a[1]); w.y = cvtpk(a[2], a[3]);
                *(u32x2*)(dCT + (((size_t)u * LDV) + 16 * (2 * wave + vi) + fr) * 128 + 16 * db + 4 * g) = w; }
        }
        __syncthreads();
    }
}
__device__ __forceinline__ void mlstm_b(const Ctx& C) {
    const bf16_t* dCT = WSP(bf16_t, WS_BIG + BG_DCT); bf16_t* CT = WSP(bf16_t, WS_BIG + BG_CT);
    const float* bl = WSP(float, WS_MISC + MS_BL); const float* ml = WSP(float, WS_MISC + MS_ML); float* mst = WSP(float, WS_MISC + MS_MST);
    const float* dn = WSP(float, WS_MISC + MS_DN); float* nst = WSP(float, WS_MISC + MS_NST);
    LAS float* sdec = (LAS float*)C.lds; LAS float* swg = sdec + 64; LAS float* sbl = sdec + 128; LAS float* sml = sdec + 192;
    const int tid = C.tid;
    for (int blk = C.vcu; blk < 24 * 8; blk += C.G) {
        const int bh = blk >> 3;
        if (tid < 64) { sbl[tid] = bl[bh * LNC + tid]; sml[tid] = ml[bh * LNC + tid]; }
        __syncthreads();
        if (tid == 0) { float m = 0.f;
            for (int j = 0; j < LNC; ++j) { if ((blk & 7) == 0) mst[bh * LNC + j] = m; const float mn = fmaxf(sbl[j] + m, sml[j]); sdec[j] = expf(sbl[j] + m - mn); swg[j] = expf(sml[j] - mn); m = mn; } }
        __syncthreads();
        const size_t base = (size_t)bh * LNC * 4096 + (blk & 7) * 512 + tid;
        float c[8] = {0.f, 0.f, 0.f, 0.f, 0.f, 0.f, 0.f, 0.f};
        u32x4 dr[8];
#pragma unroll
        for (int i = 0; i < 8; ++i) dr[i] = *((const u32x4*)dCT + base + (size_t)i * 4096);
#pragma unroll 1
        for (int j0 = 0; j0 < LNC; j0 += 8) {
#pragma unroll
            for (int i = 0; i < 8; ++i) { const int j = j0 + i; const u32x4 dv = dr[i];
                if (j + 8 < LNC) dr[i] = *((const u32x4*)dCT + base + (size_t)(j + 8) * 4096);
                u32x4 o; o.x = cvtpk(c[0], c[1]); o.y = cvtpk(c[2], c[3]); o.z = cvtpk(c[4], c[5]); o.w = cvtpk(c[6], c[7]);
                *((u32x4*)CT + base + (size_t)j * 4096) = o;
                const float dec = sdec[j], wg = swg[j];
                c[0] = dec * c[0] + wg * bflo(dv.x); c[1] = dec * c[1] + wg * bfhi(dv.x); c[2] = dec * c[2] + wg * bflo(dv.y); c[3] = dec * c[3] + wg * bfhi(dv.y);
                c[4] = dec * c[4] + wg * bflo(dv.z); c[5] = dec * c[5] + wg * bfhi(dv.z); c[6] = dec * c[6] + wg * bflo(dv.w); c[7] = dec * c[7] + wg * bfhi(dv.w); }
        }
        if (tid < 16) { const int d = (blk & 7) * 16 + tid; float n = 0.f; const float* dp = dn + (size_t)bh * LNC * 128 + d; float* np = nst + (size_t)bh * LNC * 128 + d;
            float dq[16];
#pragma unroll
            for (int i = 0; i < 16; ++i) dq[i] = dp[(size_t)i * 128];
#pragma unroll 1
            for (int j0 = 0; j0 < LNC; j0 += 16) {
#pragma unroll
                for (int i = 0; i < 16; ++i) { const int j = j0 + i; const float dv = dq[i]; if (j + 16 < LNC) dq[i] = dp[(size_t)(j + 16) * 128]; np[(size_t)j * 128] = n; n = sdec[j] * n + swg[j] * dv; } } }
        __syncthreads();
    }
}
__device__ __forceinline__ void mlstm_c(const Ctx& C) {
    const bf16_t* Qn = WSP(bf16_t, WS_BIG + BG_QN); const bf16_t* Kn = WSP(bf16_t, WS_BIG + BG_KN); const bf16_t* VT = WSP(bf16_t, WS_BIG + BG_VT);
    const bf16_t* On = WSP(bf16_t, WS_BIG + BG_ON); const bf16_t* CT = WSP(bf16_t, WS_BIG + BG_CT); const float* mst = WSP(float, WS_MISC + MS_MST); const float* nst = WSP(float, WS_MISC + MS_NST);
    bf16_t* cat = WSP(bf16_t, WS_S1); const float* gsa = WSP(float, WS_ROPE); const float* gsb = gsa + 24 * LNC * 128; const float* gspm = gsb + 24 * LNC * 128;
    LAS unsigned char* VTs = C.lds; LAS unsigned char* CTs = C.lds + 256 * LROW; LAS float* sa = (LAS float*)(C.lds + 512 * LROW); LAS float* sb = sa + 128; LAS float* spm = sb + 128; LAS float* sn = spm + 128;
    const int tid = C.tid, lane = C.lane, wave = C.wave, fr = lane & 15, g = lane >> 4;
    for (int u = C.bid; u < 24 * LNC; u += C.G) {
        const int bh = u >> 6, j = u & 63, b = bh / LH, h = bh % LH; const size_t tok0 = (size_t)b * SEQ + j * LCH;
        { const int q = tid >> 7, e = tid & 127; const float* src = q == 0 ? gsa : q == 1 ? gsb : q == 2 ? gspm : nst; LAS float* dst = q == 0 ? sa : q == 1 ? sb : q == 2 ? spm : sn;
          const int v = tid >> 1, hf = tid & 1; const bf16_t* vp = VT + ((size_t)bh * LDV + v) * SEQ + j * LCH + hf * 64; const bf16_t* cq = CT + ((size_t)u * LDV + v) * 128 + hf * 64;
          const float sv = src[(size_t)u * 128 + e]; u32x4 cc[8], vv[8];
#pragma unroll
          for (int i = 0; i < 8; ++i) { vv[i] = *(const u32x4*)(vp + 8 * i); cc[i] = *(const u32x4*)(cq + 8 * i); }
          __builtin_amdgcn_sched_barrier(0);
          dst[e] = sv;
#pragma unroll
          for (int i = 0; i < 8; ++i) { *(LAS u32x4*)(VTs + v * LROW + (hf * 64 + 8 * i) * 2) = vv[i]; *(LAS u32x4*)(CTs + v * LROW + (hf * 64 + 8 * i) * 2) = cc[i]; } }
        __syncthreads();
        {
            const int t = 16 * wave + fr; const size_t tok = tok0 + t;
            const float mprev = mst[u]; const float Mt = fmaxf(mprev, spm[t]); const float bt = sb[t]; const float winter = expf(mprev - Mt); const float mt = bt + Mt;
            bf16x8 bq[4]; float qn = 0.f;
#pragma unroll
            for (int ks = 0; ks < 4; ++ks) { const u32x4 qv = *(const u32x4*)(Qn + tok * 768 + h * 128 + 32 * ks + 8 * g); bq[ks] = __builtin_bit_cast(bf16x8, qv);
                const LAS float* np = sn + 32 * ks + 8 * g;
                qn += bflo(qv.x) * np[0] + bfhi(qv.x) * np[1] + bflo(qv.y) * np[2] + bfhi(qv.y) * np[3] + bflo(qv.z) * np[4] + bfhi(qv.z) * np[5] + bflo(qv.w) * np[6] + bfhi(qv.w) * np[7]; }
            qn += __shfl_xor(qn, 16); qn += __shfl_xor(qn, 32);
            f32x4 acc[16];
#pragma unroll
            for (int vb = 0; vb < 16; ++vb) { f32x4 a = {0.f, 0.f, 0.f, 0.f};
#pragma unroll
                for (int ks = 0; ks < 4; ++ks) { const bf16x8 cf = *(const LAS bf16x8*)(CTs + (16 * vb + fr) * LROW + (32 * ks + 8 * g) * 2); a = __builtin_amdgcn_mfma_f32_16x16x32_bf16(cf, bq[ks], a, 0, 0, 0); }
                acc[vb] = a * winter; if ((vb & 3) == 3) asm volatile("" ::: "memory"); }
            f32x4 sw[8]; float den = 0.f;
#pragma unroll
            for (int kh = 0; kh < 2; ++kh) {
                bf16x8 kfr[4][4];
#pragma unroll
                for (int k4 = 0; k4 < 4; ++k4) if (kh * 4 + k4 <= wave) {
#pragma unroll
                    for (int ks = 0; ks < 4; ++ks) kfr[k4][ks] = *(const bf16x8*)(Kn + (tok0 + 16 * (kh * 4 + k4) + fr) * 768 + h * 128 + 32 * ks + 8 * g); }
                __builtin_amdgcn_sched_barrier(0);
#pragma unroll
                for (int k4 = 0; k4 < 4; ++k4) { const int kb = kh * 4 + k4;
                    f32x4 s = {0.f, 0.f, 0.f, 0.f};
                    if (kb <= wave) {
#pragma unroll
                        for (int ks = 0; ks < 4; ++ks) s = __builtin_amdgcn_mfma_f32_16x16x32_bf16(kfr[k4][ks], bq[ks], s, 0, 0, 0);
                        const f32x4 av = *(const LAS f32x4*)(sa + 16 * kb + 4 * g);
#pragma unroll
                        for (int r = 0; r < 4; ++r) { const int sidx = 16 * kb + 4 * g + r; const float wgt = sidx <= t ? expf(av[r] - Mt) : 0.f; s[r] *= wgt; den += s[r]; }
                    }
                    sw[kb] = s; }
                __builtin_amdgcn_sched_barrier(0);
            }
            den += __shfl_xor(den, 16); den += __shfl_xor(den, 32);
            den += winter * qn;
#pragma unroll
            for (int kp = 0; kp < 4; ++kp) {
                if (2 * kp <= wave) {
                    u32x4 pw; pw.x = cvtpk(sw[2 * kp][0], sw[2 * kp][1]); pw.y = cvtpk(sw[2 * kp][2], sw[2 * kp][3]); pw.z = cvtpk(sw[2 * kp + 1][0], sw[2 * kp + 1][1]); pw.w = cvtpk(sw[2 * kp + 1][2], sw[2 * kp + 1][3]);
                    const bf16x8 pb = __builtin_bit_cast(bf16x8, pw);
#pragma unroll
                    for (int vb = 0; vb < 16; ++vb) { const LAS unsigned char* vp = VTs + (16 * vb + fr) * LROW + (32 * kp + 4 * g) * 2;
                        u32x4 vw; const u32x2 lo = *(const LAS u32x2*)vp, hi = *(const LAS u32x2*)(vp + 32); vw.x = lo.x; vw.y = lo.y; vw.z = hi.x; vw.w = hi.y;
                        acc[vb] = __builtin_amdgcn_mfma_f32_16x16x32_bf16(__builtin_bit_cast(bf16x8, vw), pb, acc[vb], 0, 0, 0); }
                }
            }
            const float dinv = 1.0f / fmaxf(fabsf(den), expf(-mt));
            float ss = 0.f;
#pragma unroll
            for (int vb = 0; vb < 16; ++vb) { acc[vb] = acc[vb] * dinv; ss += (acc[vb][0] * acc[vb][0] + acc[vb][1] * acc[vb][1]) + (acc[vb][2] * acc[vb][2] + acc[vb][3] * acc[vb][3]); }
            ss += __shfl_xor(ss, 16); ss += __shfl_xor(ss, 32);
            const float rn = 1.0f / sqrtf(ss * (1.f / LDV) + EPS);
#pragma unroll
            for (int hv = 0; hv < 2; ++hv) {
                f32x4 gnv[8]; u32x2 owv[8];
#pragma unroll
                for (int i = 0; i < 8; ++i) { const int v = 16 * (hv * 8 + i) + 4 * g; gnv[i] = *(const f32x4*)(C.in(10) + h * LDV + v); owv[i] = *(const u32x2*)(On + tok * 1536 + h * LDV + v); }
                __builtin_amdgcn_sched_barrier(0);
#pragma unroll
                for (int i = 0; i < 8; ++i) { const int vb = hv * 8 + i; const int v = 16 * vb + 4 * g; const f32x4 gn = gnv[i]; const u32x2 ow = owv[i];
                    const f32x4 o = {acc[vb][0] * rn * gn[0] * bflo(ow.x), acc[vb][1] * rn * gn[1] * bfhi(ow.x), acc[vb][2] * rn * gn[2] * bflo(ow.y), acc[vb][3] * rn * gn[3] * bfhi(ow.y)};
                    u32x2 w; w.x = cvtpk(o[0], o[1]); w.y = cvtpk(o[2], o[3]);
                    *(u32x2*)(cat + tok * D + h * LDV + v) = w; }
            }
        }
        __syncthreads();
    }
}
constexpr int VROW = 528;
__device__ __forceinline__ void memattn_phase(const Ctx& C, int layer, const bf16_t* MQ, bf16_t* cat) {
    const float* mkv = WSP(float, WS_MEMKV) + (size_t)layer * 1024 * 1024; const float* qgain = C.in(6) + layer * MEMHD; const float* kgain = C.in(7) + layer * MEMHD;
    LAS unsigned char* Kms = C.lds; LAS unsigned char* VTm = C.lds + 256 * LROW;
    const int tid = C.tid, lane = C.lane, wave = C.wave, fr = lane & 15, g = lane >> 4;
    for (int u = C.bid; u < 256; u += C.G) {
        const int b = u >> 6, hh = (u >> 4) & 3, qc = u & 15;
        { const int slot = tid >> 1, hf = tid & 1; const float* kp = mkv + ((size_t)b * MEMS + slot) * 1024 + hh * MEMHD + hf * 64; const float* vp = kp + MEMW;
          f32x4 kv[16], vv[16]; float ss = 0.f;
#pragma unroll
          for (int i = 0; i < 16; ++i) { kv[i] = *(const f32x4*)(kp + 4 * i); vv[i] = *(const f32x4*)(vp + 4 * i); }
          __builtin_amdgcn_sched_barrier(0);
#pragma unroll
          for (int i = 0; i < 16; ++i) ss += (kv[i][0] * kv[i][0] + kv[i][1] * kv[i][1]) + (kv[i][2] * kv[i][2] + kv[i][3] * kv[i][3]);
          ss += __shfl_xor(ss, 1); const float rn = 1.0f / sqrtf(ss * (1.f / MEMHD) + EPS);
#pragma unroll
          for (int i = 0; i < 8; ++i) { const f32x4 g0 = *(const f32x4*)(kgain + hf * 64 + 8 * i), g1 = *(const f32x4*)(kgain + hf * 64 + 8 * i + 4);
              const f32x4 a = kv[2 * i] * rn * g0, c = kv[2 * i + 1] * rn * g1;
              u32x4 w; w.x = cvtpk(a[0], a[1]); w.y = cvtpk(a[2], a[3]); w.z = cvtpk(c[0], c[1]); w.w = cvtpk(c[2], c[3]);
              *(LAS u32x4*)(Kms + slot * LROW + (hf * 64 + 8 * i) * 2) = w; }
#pragma unroll
          for (int i = 0; i < 16; ++i) {
#pragma unroll
              for (int q = 0; q < 4; ++q) *(LAS unsigned short*)(VTm + (hf * 64 + 4 * i + q) * VROW + slot * 2) = f2bf(vv[i][q]); } }
        __syncthreads();
#pragma unroll 1
        for (int it = 0; it < 4; ++it) {
            const size_t tok = (size_t)b * SEQ + qc * 512 + wave * 64 + it * 16 + fr;
            u32x4 qv[4]; float ss = 0.f;
#pragma unroll
            for (int ks = 0; ks < 4; ++ks) { qv[ks] = *(const u32x4*)(MQ + tok * MEMW + hh * MEMHD + 32 * ks + 8 * g);
                ss += (bflo(qv[ks].x) * bflo(qv[ks].x) + bfhi(qv[ks].x) * bfhi(qv[ks].x)) + (bflo(qv[ks].y) * bflo(qv[ks].y) + bfhi(qv[ks].y) * bfhi(qv[ks].y))
                    + (bflo(qv[ks].z) * bflo(qv[ks].z) + bfhi(qv[ks].z) * bfhi(qv[ks].z)) + (bflo(qv[ks].w) * bflo(qv[ks].w) + bfhi(qv[ks].w) * bfhi(qv[ks].w)); }
            ss += __shfl_xor(ss, 16); ss += __shfl_xor(ss, 32);
            const float qs = (1.0f / sqrtf(ss * (1.f / MEMHD) + EPS)) * (0.08838834764831845f * LOG2E);
            bf16x8 bq[4];
#pragma unroll
            for (int ks = 0; ks < 4; ++ks) { const f32x4 g0 = *(const f32x4*)(qgain + 32 * ks + 8 * g), g1 = *(const f32x4*)(qgain + 32 * ks + 8 * g + 4); u32x4 w;
                w.x = cvtpk(bflo(qv[ks].x) * qs * g0[0], bfhi(qv[ks].x) * qs * g0[1]); w.y = cvtpk(bflo(qv[ks].y) * qs * g0[2], bfhi(qv[ks].y) * qs * g0[3]);
                w.z = cvtpk(bflo(qv[ks].z) * qs * g1[0], bfhi(qv[ks].z) * qs * g1[1]); w.w = cvtpk(bflo(qv[ks].w) * qs * g1[2], bfhi(qv[ks].w) * qs * g1[3]);
                bq[ks] = __builtin_bit_cast(bf16x8, w); }
            f32x4 sacc[16]; float mx = -INFINITY;
#pragma unroll
            for (int kb = 0; kb < 16; ++kb) { f32x4 s = {0.f, 0.f, 0.f, 0.f};
#pragma unroll
                for (int ks = 0; ks < 4; ++ks) { const bf16x8 kf = *(const LAS bf16x8*)(Kms + (16 * kb + fr) * LROW + (32 * ks + 8 * g) * 2); s = __builtin_amdgcn_mfma_f32_16x16x32_bf16(kf, bq[ks], s, 0, 0, 0); }
                sacc[kb] = s; mx = fmaxf(fmaxf(mx, fmaxf(s[0], s[1])), fmaxf(s[2], s[3])); asm volatile("" ::: "memory"); }
            mx = fmaxf(mx, __shfl_xor(mx, 16)); mx = fmaxf(mx, __shfl_xor(mx, 32));
            float sum = 0.f;
#pragma unroll
            for (int kb = 0; kb < 16; ++kb) {
#pragma unroll
                for (int r = 0; r < 4; ++r) { sacc[kb][r] = __builtin_amdgcn_exp2f(sacc[kb][r] - mx); sum += sacc[kb][r]; } }
            sum += __shfl_xor(sum, 16); sum += __shfl_xor(sum, 32);
            f32x4 oacc[8];
#pragma unroll
            for (int db = 0; db < 8; ++db) oacc[db] = (f32x4){0.f, 0.f, 0.f, 0.f};
#pragma unroll
            for (int kp = 0; kp < 8; ++kp) {
                u32x4 pw; pw.x = cvtpk(sacc[2 * kp][0], sacc[2 * kp][1]); pw.y = cvtpk(sacc[2 * kp][2], sacc[2 * kp][3]); pw.z = cvtpk(sacc[2 * kp + 1][0], sacc[2 * kp + 1][1]); pw.w = cvtpk(sacc[2 * kp + 1][2], sacc[2 * kp + 1][3]);
                const bf16x8 pb = __builtin_bit_cast(bf16x8, pw);
#pragma unroll
                for (int db = 0; db < 8; ++db) { const LAS unsigned char* vp = VTm + (16 * db + fr) * VROW + (32 * kp + 4 * g) * 2;
                    u32x4 vw; const u32x2 lo = *(const LAS u32x2*)vp, hi = *(const LAS u32x2*)(vp + 32); vw.x = lo.x; vw.y = lo.y; vw.z = hi.x; vw.w = hi.y;
                    oacc[db] = __builtin_amdgcn_mfma_f32_16x16x32_bf16(__builtin_bit_cast(bf16x8, vw), pb, oacc[db], 0, 0, 0); }
                asm volatile("" ::: "memory");
            }
            const float inv = 1.0f / sum;
#pragma unroll
            for (int db = 0; db < 8; ++db) { u32x2 w; w.x = cvtpk(oacc[db][0] * inv, oacc[db][1] * inv); w.y = cvtpk(oacc[db][2] * inv, oacc[db][3] * inv);
                if (layer == 1) *(unsigned*)((unsigned char*)cat + tok * D + 1536 + hh * MEMHD + 16 * db + 4 * g) = gm::pk_fp8x4(oacc[db][0] * inv * SC8, oacc[db][1] * inv * SC8, oacc[db][2] * inv * SC8, oacc[db][3] * inv * SC8);
                else *(u32x2*)(cat + tok * D + 1536 + hh * MEMHD + 16 * db + 4 * g) = w; }
        }
        __syncthreads();
    }
}
#include <hip/hip_bf16.h>
#include <cmath>
namespace attn_body {
using bf16=__hip_bfloat16;
using bf16x8=__attribute__((ext_vector_type(8)))short;
using s16x4=__attribute__((ext_vector_type(4)))short;
using f32x16=__attribute__((ext_vector_type(16)))float;
using u32x4=__attribute__((ext_vector_type(4)))unsigned;
constexpr int BATCH=4,NHEAD=12,SEQ=8192,D=64,DM=1536;
constexpr int NW=8,QBLK=32,QB=QBLK*NW,KVBLK=64,NQB=SEQ/QB;
constexpr int ATTN_PITCH=DM, ATTN_UNIT_ROWS=QB;
__device__ __forceinline__ int crow(int r,int hi){return (r&3)+8*(r>>2)+4*hi;}
#define SBAR() __builtin_amdgcn_sched_barrier(0)
__device__ __forceinline__ void cmask(f32x16&p0,f32x16&p1,int jb,int qrel,int hi){
  const float NEG=-INFINITY; int kb=64*jb+4*hi;
  #pragma unroll
  for(int r=0;r<16;++r){int kv=kb+(r&3)+8*(r>>2); if(kv>qrel)p0[r]=NEG; if(kv+32>qrel)p1[r]=NEG;}
}

constexpr int NSLOT=3, SLOTB=8192;
constexpr int LDS_K=0, LDS_V=NSLOT*SLOTB, LDS_WS=2*NSLOT*SLOTB, LDS_OST=LDS_WS+NW*64*4, LDS_BYTES=LDS_OST+NW*4096;
constexpr float C2=0.125f*1.4426950408889634f;
__device__ __forceinline__ void glds16(const void*gsrc,unsigned lds_dst){unsigned keep;
  asm volatile("s_mov_b32 %0, m0\n\ts_mov_b32 m0, %2\n\ts_nop 0\n\tglobal_load_lds_dwordx4 %1, off\n\ts_mov_b32 m0, %0":"=&s"(keep):"v"(gsrc),"s"(lds_dst):"memory");}
__device__ __forceinline__ float max3f(float a,float b,float c){float r;asm("v_max3_f32 %0, %1, %2, %3":"=v"(r):"v"(a),"v"(b),"v"(c));return r;}
__device__ __forceinline__ float max2f(float a,float b){float r;asm("v_max_f32_e32 %0, %1, %2":"=v"(r):"v"(a),"v"(b));return r;}
__device__ __forceinline__ float fadd_s(float a,float b){float r;asm("v_add_f32_e32 %0, %1, %2":"=v"(r):"v"(a),"v"(b));return r;}
__device__ __forceinline__ float fsub_s(float a,float b){float r;asm("v_sub_f32_e32 %0, %1, %2":"=v"(r):"v"(a),"v"(b));return r;}
typedef float f32x2_t __attribute__((ext_vector_type(2))); typedef __bf16 bf16x2_t __attribute__((ext_vector_type(2)));
__device__ __forceinline__ unsigned cvtpk_s(float lo,float hi){f32x2_t v={lo,hi};bf16x2_t b=__builtin_convertvector(v,bf16x2_t);return __builtin_bit_cast(unsigned,b);}
#define WAIT_BAR(N) asm volatile("s_waitcnt vmcnt(" #N ") lgkmcnt(0)\n\ts_barrier":::"memory")

__device__ __forceinline__ void qkt(f32x16&p0,f32x16&p1,const char*Kslot,const bf16x8*qr,const f32x16&negm,int r32,int hi){
  const char*kb=Kslot+hi*1024+r32*16;
  #pragma unroll
  for(int d0=0;d0<4;++d0){
    const bf16x8 b0=*reinterpret_cast<const bf16x8*>(kb+d0*2048);
    const bf16x8 b1=*reinterpret_cast<const bf16x8*>(kb+d0*2048+512);
    if(d0==0){p0=__builtin_amdgcn_mfma_f32_32x32x16_bf16(b0,qr[0],negm,0,0,0);p1=__builtin_amdgcn_mfma_f32_32x32x16_bf16(b1,qr[0],negm,0,0,0);}
    else{p0=__builtin_amdgcn_mfma_f32_32x32x16_bf16(b0,qr[d0],p0,0,0,0);p1=__builtin_amdgcn_mfma_f32_32x32x16_bf16(b1,qr[d0],p1,0,0,0);}}
}
typedef __attribute__((address_space(3))) const char* lds_cptr;
typedef short v4i16_t __attribute__((ext_vector_type(4)));
__device__ __forceinline__ void kload8(bf16x8*kf,lds_cptr kp){
  kf[0]=*(const __attribute__((address_space(3))) bf16x8*)(kp);      kf[1]=*(const __attribute__((address_space(3))) bf16x8*)(kp+512);
  kf[2]=*(const __attribute__((address_space(3))) bf16x8*)(kp+2048); kf[3]=*(const __attribute__((address_space(3))) bf16x8*)(kp+2560);
  kf[4]=*(const __attribute__((address_space(3))) bf16x8*)(kp+4096); kf[5]=*(const __attribute__((address_space(3))) bf16x8*)(kp+4608);
  kf[6]=*(const __attribute__((address_space(3))) bf16x8*)(kp+6144); kf[7]=*(const __attribute__((address_space(3))) bf16x8*)(kp+6656);
}
__device__ __forceinline__ void kload2(bf16x8*kf,lds_cptr kp,int j){ kf[2*j]=*(const __attribute__((address_space(3))) bf16x8*)(kp+j*2048); kf[2*j+1]=*(const __attribute__((address_space(3))) bf16x8*)(kp+j*2048+512); }
__device__ __forceinline__ s16x4 vtr(lds_cptr p){ return __builtin_bit_cast(s16x4,__builtin_amdgcn_ds_read_tr16_b64_v4i16((__attribute__((address_space(3))) v4i16_t*)p)); }
__device__ __forceinline__ float rowmax(const f32x16&p0,const f32x16&p1){
  float a=max3f(p0[0],p0[1],p1[0]),b=max3f(p0[2],p0[3],p1[1]);a=max3f(a,p1[2],p1[3]);
  #pragma unroll
  for(int r=4;r<16;r+=4){a=max3f(a,p0[r],p0[r+1]);b=max3f(b,p0[r+2],p0[r+3]);a=max3f(a,p1[r],p1[r+1]);b=max3f(b,p1[r+2],p1[r+3]);}
  const float m=max2f(a,b);
  auto rr=__builtin_amdgcn_permlane32_swap(__float_as_uint(m),__float_as_uint(m),false,false);
  return max2f(__uint_as_float(rr[0]),__uint_as_float(rr[1]));
}
__device__ __forceinline__ void pv(f32x16*o,int vb,bf16x8 pa0,bf16x8 pa1,bf16x8 pa2,bf16x8 pa3){
  #pragma unroll
  for(int d0=0;d0<2;++d0){s16x4 lo[4],hi[4];
    #pragma unroll
    for(int ks=0;ks<4;++ks){
      asm volatile("ds_read_b64_tr_b16 %0,%1 offset:%c2":"=&v"(lo[ks]):"v"(vb),"i"(d0*4096+ks*1024):"memory");
      asm volatile("ds_read_b64_tr_b16 %0,%1 offset:%c2":"=&v"(hi[ks]):"v"(vb),"i"(d0*4096+ks*1024+512):"memory");}
    asm volatile("s_waitcnt lgkmcnt(0)":::"memory");SBAR();
    #define PK(k) (bf16x8){lo[k][0],lo[k][1],lo[k][2],lo[k][3],hi[k][0],hi[k][1],hi[k][2],hi[k][3]}
    o[d0]=__builtin_amdgcn_mfma_f32_32x32x16_bf16(pa0,PK(0),o[d0],0,0,0);
    o[d0]=__builtin_amdgcn_mfma_f32_32x32x16_bf16(pa1,PK(1),o[d0],0,0,0);
    o[d0]=__builtin_amdgcn_mfma_f32_32x32x16_bf16(pa2,PK(2),o[d0],0,0,0);
    o[d0]=__builtin_amdgcn_mfma_f32_32x32x16_bf16(pa3,PK(3),o[d0],0,0,0);
    #undef PK
  }
}

#ifndef ATTN_STORE16
#define ATTN_STORE16(p,v) (*(u32x4*)(p)=(v))
#endif
template<int THRL> __device__ __forceinline__ void attn_unit(int b,int qcol,int vcol,int qb,const bf16*Q,const bf16*__restrict__ K,const bf16*__restrict__ V,bf16*O,char*shm){
  const int tid=threadIdx.x,lane=tid&63,r32=lane&31,hi=lane>>5; const int wid=__builtin_amdgcn_readfirstlane(tid>>6);
  const long rowbase=(long)b*SEQ; const int q0=qb*QB;
  const bf16*Qw=Q+(rowbase+q0+wid*QBLK)*DM+qcol;
  const bf16*Kh=K+rowbase*DM+qcol,*Vh=V+rowbase*DM+vcol;
  const unsigned lds0=(unsigned)(uintptr_t)shm;
  float*wsf=(float*)(shm+LDS_WS)+wid*64;
  const bf16*ksrc=Kh+(long)lane*DM+wid*8;
  const bf16*vsrc=Vh+(long)(16*(wid&3)+(lane>>2))*DM+(wid>>2)*32+(lane&3)*8;
  const unsigned kdst=lds0+LDS_K+wid*1024, vdst=lds0+LDS_V+wid*1024;
  #define DMA_K(t,slot) glds16(ksrc+(long)(t)*KVBLK*DM,(unsigned)__builtin_amdgcn_readfirstlane(kdst+(slot)))
  #define DMA_V(t,slot) glds16(vsrc+(long)(t)*KVBLK*DM,(unsigned)__builtin_amdgcn_readfirstlane(vdst+(slot)))
  const int vb0=(int)(lds0+LDS_V)+((lane>>4)&1)*32+(lane&3)*8+(4*hi+((lane&15)>>2))*64;
  const char*Kbase=shm+LDS_K; bf16x8 kf[8];
  const lds_cptr shm3=(lds_cptr)shm; const lds_cptr kp0=shm3+LDS_K+hi*1024+r32*16; const lds_cptr vp0=shm3+LDS_V+((lane>>4)&1)*32+(lane&3)*8+(4*hi+((lane&15)>>2))*64;
  const int NT=(q0+QB)/KVBLK;
  DMA_K(0,0);DMA_V(0,0);DMA_K(1,SLOTB);
  bf16x8 qr[4];
  #pragma unroll
  for(int d0=0;d0<4;++d0)qr[d0]=*reinterpret_cast<const bf16x8*>(&Qw[(long)r32*DM+d0*16+hi*8]);
  float mhat=0.f,l_reg=0.f;f32x16 o[2];o[0]=f32x16{};o[1]=f32x16{};f32x16 negm=f32x16{};asm volatile("":"+v"(negm));
  const int qrel=wid*QBLK+r32;
  #define CMASK(P0,P1,t) do{int jb_=(t)-(NT-4); if(jb_>=0)cmask(P0,P1,jb_,qrel,hi);}while(0)
  bool resc=false;
  #define START(P0,P1) do{ const float rm=rowmax(P0,P1); resc=false; \
    { const float dl=rm; mhat=fadd_s(mhat,dl); \
      _Pragma("unroll") for(int r=0;r<16;++r){P0[r]=fsub_s(P0[r],dl);P1[r]=fsub_s(P1[r],dl);} \
      _Pragma("unroll") for(int r=0;r<16;++r)negm[r]=-mhat; asm volatile("":"+v"(negm)); } \
    _Pragma("unroll") for(int r=0;r<16;++r)P0[r]=__builtin_amdgcn_exp2f(P0[r]); }while(0)
  #define RESC() do{ if(resc){ asm volatile("s_waitcnt lgkmcnt(0)":::"memory"); \
      _Pragma("unroll") for(int d_=0;d_<2;++d_) _Pragma("unroll") for(int r=0;r<16;++r)o[d_][r]*=wsf[crow(r,hi)]; } }while(0)
  f32x16 pA0,pA1,pB0,pB1;
  int sl_prev=0,sl_cur=0,sl_next=SLOTB;
  #define ROT() do{sl_prev=sl_cur;sl_cur=sl_next;sl_next=(sl_next==(NSLOT-1)*SLOTB)?0:sl_next+SLOTB;}while(0)
  DMA_K(2,2*SLOTB);
  WAIT_BAR(3);
  qkt(pA0,pA1,Kbase,qr,negm,r32,hi);asm volatile("s_nop 15\n\ts_nop 7":"+v"(pA0),"+v"(pA1));CMASK(pA0,pA1,0);
  START(pA0,pA1);
  _Pragma("unroll") for(int r=0;r<16;++r)pA1[r]=__builtin_amdgcn_exp2f(pA1[r]);
  WAIT_BAR(0);
  DMA_K(3,0);DMA_V(1,SLOTB);
  ROT();
  kload8(kf,kp0+sl_cur);
  WAIT_BAR(2);
  s16x4 vlo[8],vhi[8]; u32x4 pw0,pw1,pw2,pw3;
  #define PKW(P,B) cvtpk_s(P[B],P[B+1])
  #define PAF(k) __builtin_bit_cast(bf16x8,pw##k)
  #define VFR(i) (bf16x8){vlo[i][0],vlo[i][1],vlo[i][2],vlo[i][3],vhi[i][0],vhi[i][1],vhi[i][2],vhi[i][3]}
  #define PIN(x) asm volatile("":"+v"(x))
  #define MX3(a,b,c) __builtin_fmaxf(__builtin_fmaxf((a),(b)),(c))
  #define GAPA(MF,A0,A1,A2,A3,W0,W1,PW) do{ MF; sacc+=A0; sacc+=A1; sacc+=A2; sacc+=A3; PIN(sacc); W0; W1; PIN(PW); SBAR(); }while(0)
  #define EX(v) __builtin_amdgcn_exp2f(v)
  #define GAPB(MF,X,B) do{ MF; X[B]=EX(X[B]); X[B+1]=EX(X[B+1]); X[B+2]=EX(X[B+2]); X[B+3]=EX(X[B+3]); PIN(X); SBAR(); }while(0)
  #define VRD(i) do{ vlo[i]=vtr(vp_+(((i)>>2)*4096+((i)&3)*1024)); vhi[i]=vtr(vp_+(((i)>>2)*4096+((i)&3)*1024+512)); }while(0)
  #define KRD(G,j) do{ if(G){ kload2(kf,kp0+sl_next,j); SBAR(); } }while(0)
  #define STEP(C0,C1,P0,P1,t,GK,GV,GL) do{ SBAR(); \
    const lds_cptr vp_=vp0+sl_prev; \
    VRD(0); SBAR(); float sacc=(P0[0]+P0[1]); \
    GAPA(C0=__builtin_amdgcn_mfma_f32_32x32x16_bf16(kf[0],qr[0],negm,0,0,0), P0[2],P0[3],P0[4],P0[5],     pw0[0]=PKW(P0,0), pw0[1]=PKW(P0,2), pw0); \
    VRD(4); SBAR(); GAPA(C1=__builtin_amdgcn_mfma_f32_32x32x16_bf16(kf[1],qr[0],negm,0,0,0), P0[6],P0[7],P0[8],P0[9],     pw0[2]=PKW(P0,4), pw0[3]=PKW(P0,6), pw0); \
    VRD(1); SBAR(); GAPA(C0=__builtin_amdgcn_mfma_f32_32x32x16_bf16(kf[2],qr[1],C0,0,0,0),   P0[10],P0[11],P0[12],P0[13], pw1[0]=PKW(P0,8), pw1[1]=PKW(P0,10), pw1); \
    VRD(5); SBAR(); GAPA(C1=__builtin_amdgcn_mfma_f32_32x32x16_bf16(kf[3],qr[1],C1,0,0,0),   P0[14],P0[15],P1[0],P1[1],   pw1[2]=PKW(P0,12),pw1[3]=PKW(P0,14), pw1); \
    VRD(2); SBAR(); GAPA(C0=__builtin_amdgcn_mfma_f32_32x32x16_bf16(kf[4],qr[2],C0,0,0,0),   P1[2],P1[3],P1[4],P1[5],     pw2[0]=PKW(P1,0), pw2[1]=PKW(P1,2), pw2); \
    VRD(6); SBAR(); GAPA(C1=__builtin_amdgcn_mfma_f32_32x32x16_bf16(kf[5],qr[2],C1,0,0,0),   P1[6],P1[7],P1[8],P1[9],     pw2[2]=PKW(P1,4), pw2[3]=PKW(P1,6), pw2); \
    VRD(3); SBAR(); GAPA(C0=__builtin_amdgcn_mfma_f32_32x32x16_bf16(kf[6],qr[3],C0,0,0,0),   P1[10],P1[11],P1[12],P1[13], pw3[0]=PKW(P1,8), pw3[1]=PKW(P1,10), pw3); \
    VRD(7); SBAR(); GAPA(C1=__builtin_amdgcn_mfma_f32_32x32x16_bf16(kf[7],qr[3],C1,0,0,0),   P1[14],P1[15],0.f,0.f,       pw3[2]=PKW(P1,12),pw3[3]=PKW(P1,14), pw3); \
    l_reg+=sacc; \
    if(GK){DMA_K((t)+3,sl_cur);} if(GV){DMA_V((t)+1,sl_next);} \
    CMASK(C0,C1,t); \
    { float a=MX3(C0[0],C0[1],C1[0]),b=MX3(C0[2],C0[3],C1[1]); a=MX3(a,C1[2],C1[3]); \
      _Pragma("unroll") for(int r=4;r<16;r+=4){a=MX3(a,C0[r],C0[r+1]);b=MX3(b,C0[r+2],C0[r+3]);a=MX3(a,C1[r],C1[r+1]);b=MX3(b,C1[r+2],C1[r+3]);} \
      float rm=__builtin_fmaxf(a,b); { auto rr=__builtin_amdgcn_permlane32_swap(__float_as_uint(rm),__float_as_uint(rm),false,false); rm=__builtin_fmaxf(__uint_as_float(rr[0]),__uint_as_float(rr[1])); } \
      resc=false; \
      if(__builtin_expect(__any(rm>(float)THRL),0)){ const float dl=__builtin_fmaxf(rm,0.f); mhat+=dl; \
        _Pragma("unroll") for(int r=0;r<16;++r){C0[r]-=dl;C1[r]-=dl;} \
        _Pragma("unroll") for(int r=0;r<16;++r)negm[r]=-mhat; asm volatile("":"+v"(negm)); \
        const float f=__builtin_amdgcn_exp2f(-dl); l_reg*=f; if(hi==0)wsf[r32]=f; resc=true; } } \
    SBAR(); \
    GAPB(o[0]=__builtin_amdgcn_mfma_f32_32x32x16_bf16(PAF(0),VFR(0),o[0],0,0,0), C0,0); \
    GAPB(o[1]=__builtin_amdgcn_mfma_f32_32x32x16_bf16(PAF(0),VFR(4),o[1],0,0,0), C0,4); \
    KRD(GL,0); GAPB(o[0]=__builtin_amdgcn_mfma_f32_32x32x16_bf16(PAF(1),VFR(1),o[0],0,0,0), C0,8); \
    KRD(GL,1); GAPB(o[1]=__builtin_amdgcn_mfma_f32_32x32x16_bf16(PAF(1),VFR(5),o[1],0,0,0), C0,12); \
    KRD(GL,2); GAPB(o[0]=__builtin_amdgcn_mfma_f32_32x32x16_bf16(PAF(2),VFR(2),o[0],0,0,0), C1,0); \
    KRD(GL,3); GAPB(o[1]=__builtin_amdgcn_mfma_f32_32x32x16_bf16(PAF(2),VFR(6),o[1],0,0,0), C1,4); \
    GAPB(o[0]=__builtin_amdgcn_mfma_f32_32x32x16_bf16(PAF(3),VFR(3),o[0],0,0,0), C1,8); \
    GAPB(o[1]=__builtin_amdgcn_mfma_f32_32x32x16_bf16(PAF(3),VFR(7),o[1],0,0,0), C1,12); \
    }while(0)
  int t=1;
  #undef CMASK
  #define CMASK(P0,P1,t) do{}while(0)
  for(;t+5<NT;t+=2){
    STEP(pB0,pB1,pA0,pA1,t,true,true,true);     WAIT_BAR(2); RESC(); ROT();
    STEP(pA0,pA1,pB0,pB1,t+1,true,true,true);   WAIT_BAR(2); RESC(); ROT();
  }
  #undef CMASK
  #define CMASK(P0,P1,t) do{int jb_=(t)-(NT-4); if(jb_>=0)cmask(P0,P1,jb_,qrel,hi);}while(0)
  #define ENDW(tt) do{ if((tt)+3<NT){WAIT_BAR(2);} else if((tt)+2<NT){WAIT_BAR(1);} else {WAIT_BAR(0);} }while(0)
  for(;t+1<NT;t+=2){
    STEP(pB0,pB1,pA0,pA1,t,(t+3<NT),(t+1<NT),(t+1<NT));       ENDW(t);   RESC(); ROT();
    STEP(pA0,pA1,pB0,pB1,t+1,(t+4<NT),(t+2<NT),(t+2<NT));     ENDW(t+1); RESC(); ROT();
  }
  STEP(pB0,pB1,pA0,pA1,NT-1,false,false,false); RESC();
  { float sacc=pB0[0]+pB0[1]; _Pragma("unroll") for(int r=2;r<16;++r)sacc+=pB0[r]; _Pragma("unroll") for(int r=0;r<16;++r)sacc+=pB1[r]; l_reg+=sacc;
    pw0=(u32x4){PKW(pB0,0),PKW(pB0,2),PKW(pB0,4),PKW(pB0,6)};pw1=(u32x4){PKW(pB0,8),PKW(pB0,10),PKW(pB0,12),PKW(pB0,14)};pw2=(u32x4){PKW(pB1,0),PKW(pB1,2),PKW(pB1,4),PKW(pB1,6)};pw3=(u32x4){PKW(pB1,8),PKW(pB1,10),PKW(pB1,12),PKW(pB1,14)};
    SBAR(); pv(o,vb0+sl_cur,PAF(0),PAF(1),PAF(2),PAF(3)); }
  #undef PKW
  #undef PAF
  #undef VFR
  #undef PIN
  #undef MX3
  #undef GAPA
  #undef GAPB
  #undef EX
  #undef VRD
  #undef KRD
  #undef STEP
  #undef ENDW
  {auto rr=__builtin_amdgcn_permlane32_swap(__float_as_uint(l_reg),__float_as_uint(l_reg),false,false);l_reg=__uint_as_float(rr[0])+__uint_as_float(rr[1]);}
  if(hi==0)wsf[32+r32]=l_reg;asm volatile("s_waitcnt lgkmcnt(0)":::"memory");
  float rli[16];
  #pragma unroll
  for(int r=0;r<16;++r)rli[r]=__builtin_amdgcn_rcpf(wsf[32+crow(r,hi)]);
  bf16*Ow=O+(rowbase+q0+wid*QBLK)*DM+vcol;
  { bf16*stg=(bf16*)(shm+LDS_OST)+wid*2048;
    #pragma unroll
    for(int r=0;r<16;++r){const int orow=crow(r,hi);
      #pragma unroll
      for(int d0=0;d0<2;++d0)stg[orow*64+d0*32+r32]=__float2bfloat16(o[d0][r]*rli[r]);}
    asm volatile("s_waitcnt lgkmcnt(0)":::"memory");
    #pragma unroll
    for(int i=0;i<4;++i){const int row=i*8+(lane>>3),ch=lane&7; const u32x4 v=*(const u32x4*)(stg+row*64+ch*8); ATTN_STORE16(Ow+(long)row*DM+ch*8,v);} }
  asm volatile("s_waitcnt lgkmcnt(0)\n\ts_barrier":::"memory");
  #undef DMA_K
  #undef DMA_V
  #undef CMASK
  #undef START
  #undef RESC
  #undef ROT
}
constexpr int ATTN_LDS_BYTES=LDS_BYTES;
template<int THRL=8> __device__ __forceinline__ void diff_attn_phase(char*lds,const bf16*Q,const bf16*K,const bf16*V,bf16*O1,bf16*O2,int G,int bid,int vcu){
  const bool bal=(G==256);
  for(int i=0;;++i){
    int vhd,qb;
    if(bal){ if(i>=24)break; const int rr=i>>2,ii=i&3,s=vcu&7; vhd=rr*32+(vcu>>3); qb=(ii==0)?s:(ii==1)?15-s:(ii==2)?16+s:31-s; }
    else{ const int id=bid+i*G; if(id>=192*NQB)break; vhd=id/NQB; qb=NQB-1-(id%NQB); }
    const int vh=vhd&1,c=(vhd>>1)&1,bh=vhd>>2,b=bh/NHEAD,h=bh%NHEAD;
    attn_unit<THRL>(b,h*128+64*c,h*128+64*vh,qb,Q,K,V,c?O2:O1,lds);
  }
}
#undef SBAR
#undef WAIT_BAR
}
namespace attn2 {
using bf16=__hip_bfloat16;
using bf16x8=__attribute__((ext_vector_type(8)))short;
using s16x4=__attribute__((ext_vector_type(4)))short;
using f32x16=__attribute__((ext_vector_type(16)))float;
using u32x4=__attribute__((ext_vector_type(4)))unsigned;
constexpr int NHEAD=12,SEQ=8192,D=64,DM=1536,OPITCH=2048;
constexpr int NW=8,QBLK=32,QB=QBLK*NW,KVBLK=64,NQB=SEQ/QB;
__device__ __forceinline__ int crow(int r,int hi){return (r&3)+8*(r>>2)+4*hi;}
#define SBAR() __builtin_amdgcn_sched_barrier(0)
__device__ __forceinline__ void cmask(f32x16&p0,f32x16&p1,int jb,int qrel,int hi){
  const float NEG=-INFINITY; int kb=64*jb+4*hi;
  #pragma unroll
  for(int r=0;r<16;++r){int kv=kb+(r&3)+8*(r>>2); if(kv>qrel)p0[r]=NEG; if(kv+32>qrel)p1[r]=NEG;}
}
constexpr int NSLOT=3, KSLOT=8192, VSLOT=16384;
constexpr int LDS_K=0, LDS_V=NSLOT*KSLOT, LDS_WS=LDS_V+NSLOT*VSLOT, LDS_OST=LDS_WS+NW*64*4, LDS_BYTES=LDS_OST+NW*8192;
__device__ __forceinline__ void glds16(const void*gsrc,unsigned lds_dst){unsigned keep;
  asm volatile("s_mov_b32 %0, m0\n\ts_mov_b32 m0, %2\n\ts_nop 0\n\tglobal_load_lds_dwordx4 %1, off\n\ts_mov_b32 m0, %0":"=&s"(keep):"v"(gsrc),"s"(lds_dst):"memory");}
typedef float f32x2_t __attribute__((ext_vector_type(2))); typedef __bf16 bf16x2_t __attribute__((ext_vector_type(2)));
__device__ __forceinline__ unsigned cvtpk_s(float lo,float hi){f32x2_t v={lo,hi};bf16x2_t b=__builtin_convertvector(v,bf16x2_t);return __builtin_bit_cast(unsigned,b);}
#define WAIT_BAR(N) asm volatile("s_waitcnt vmcnt(" #N ") lgkmcnt(0)\n\ts_barrier":::"memory")
__device__ __forceinline__ void qkt(f32x16&p0,f32x16&p1,const char*Kslot,const bf16x8*qr,int r32,int hi){
  const char*kb=Kslot+hi*1024+r32*16; const f32x16 z=f32x16{};
  #pragma unroll
  for(int d0=0;d0<4;++d0){
    const bf16x8 b0=*reinterpret_cast<const bf16x8*>(kb+d0*2048);
    const bf16x8 b1=*reinterpret_cast<const bf16x8*>(kb+d0*2048+512);
    if(d0==0){p0=__builtin_amdgcn_mfma_f32_32x32x16_bf16(b0,qr[0],z,0,0,0);p1=__builtin_amdgcn_mfma_f32_32x32x16_bf16(b1,qr[0],z,0,0,0);}
    else{p0=__builtin_amdgcn_mfma_f32_32x32x16_bf16(b0,qr[d0],p0,0,0,0);p1=__builtin_amdgcn_mfma_f32_32x32x16_bf16(b1,qr[d0],p1,0,0,0);}}
}
typedef __attribute__((address_space(3))) const char* lds_cptr;
typedef short v4i16_t __attribute__((ext_vector_type(4)));
__device__ __forceinline__ void kload8(bf16x8*kf,lds_cptr kp){
  kf[0]=*(const __attribute__((address_space(3))) bf16x8*)(kp);      kf[1]=*(const __attribute__((address_space(3))) bf16x8*)(kp+512);
  kf[2]=*(const __attribute__((address_space(3))) bf16x8*)(kp+2048); kf[3]=*(const __attribute__((address_space(3))) bf16x8*)(kp+2560);
  kf[4]=*(const __attribute__((address_space(3))) bf16x8*)(kp+4096); kf[5]=*(const __attribute__((address_space(3))) bf16x8*)(kp+4608);
  kf[6]=*(const __attribute__((address_space(3))) bf16x8*)(kp+6144); kf[7]=*(const __attribute__((address_space(3))) bf16x8*)(kp+6656);
}
__device__ __forceinline__ void kload2(bf16x8*kf,lds_cptr kp,int j){ kf[2*j]=*(const __attribute__((address_space(3))) bf16x8*)(kp+j*2048); kf[2*j+1]=*(const __attribute__((address_space(3))) bf16x8*)(kp+j*2048+512); }
__device__ __forceinline__ s16x4 vtr(lds_cptr p){ return __builtin_bit_cast(s16x4,__builtin_amdgcn_ds_read_tr16_b64_v4i16((__attribute__((address_space(3))) v4i16_t*)p)); }
__device__ __forceinline__ void pv4(f32x16*o,int vb,bf16x8 pa0,bf16x8 pa1,bf16x8 pa2,bf16x8 pa3){
  #pragma unroll
  for(int d0=0;d0<4;++d0){s16x4 lo[4],hi[4];
    #pragma unroll
    for(int ks=0;ks<4;++ks){
      asm volatile("ds_read_b64_tr_b16 %0,%1 offset:%c2":"=&v"(lo[ks]):"v"(vb),"i"(d0*4096+ks*1024):"memory");
      asm volatile("ds_read_b64_tr_b16 %0,%1 offset:%c2":"=&v"(hi[ks]):"v"(vb),"i"(d0*4096+ks*1024+512):"memory");}
    asm volatile("s_waitcnt lgkmcnt(0)":::"memory");SBAR();
    #define PK(k) (bf16x8){lo[k][0],lo[k][1],lo[k][2],lo[k][3],hi[k][0],hi[k][1],hi[k][2],hi[k][3]}
    o[d0]=__builtin_amdgcn_mfma_f32_32x32x16_bf16(pa0,PK(0),o[d0],0,0,0);
    o[d0]=__builtin_amdgcn_mfma_f32_32x32x16_bf16(pa1,PK(1),o[d0],0,0,0);
    o[d0]=__builtin_amdgcn_mfma_f32_32x32x16_bf16(pa2,PK(2),o[d0],0,0,0);
    o[d0]=__builtin_amdgcn_mfma_f32_32x32x16_bf16(pa3,PK(3),o[d0],0,0,0);
    #undef PK
  }
}
__device__ __forceinline__ void attn_unit(int b,int qcol,int vcol,int qb,int comp,float lam,const float*subln,int ocol,const bf16*Q,const bf16*__restrict__ K,const bf16*__restrict__ V,bf16*OUT,char*shm,bool first,bool has_next,int nb,int nqcol,int nvcol){
  int tid=threadIdx.x; asm volatile("":"+v"(tid));
  const int lane=tid&63,r32=lane&31,hi=lane>>5; const int wid=__builtin_amdgcn_readfirstlane(tid>>6);
  const long rowbase=(long)b*SEQ; const int q0=qb*QB;
  const bf16*Qw=Q+(rowbase+q0+wid*QBLK)*DM+qcol;
  const bf16*Kh=K+rowbase*DM+qcol,*Vh=V+rowbase*DM+vcol;
  const unsigned lds0=(unsigned)(uintptr_t)shm;
  const bf16*ksrc=Kh+(long)lane*DM+wid*8;
  const bf16*vsrc=Vh+(long)(16*(wid&3)+(lane>>2))*DM+(wid>>2)*32+(lane&3)*8;
  const unsigned kdst=lds0+LDS_K+wid*1024, vdst=lds0+LDS_V+wid*1024;
  #define DMA_K(t,slot) glds16(ksrc+(long)(t)*KVBLK*DM,(unsigned)__builtin_amdgcn_readfirstlane(kdst+(slot)))
  #define DMA_V(t,slot) do{ glds16(vsrc+(long)(t)*KVBLK*DM,(unsigned)__builtin_amdgcn_readfirstlane(vdst+2*(slot))); glds16(vsrc+64+(long)(t)*KVBLK*DM,(unsigned)__builtin_amdgcn_readfirstlane(vdst+8192+2*(slot))); }while(0)
  const int vb0=(int)(lds0+LDS_V)+((lane>>4)&1)*32+(lane&3)*8+(4*hi+((lane&15)>>2))*64;
  const char*Kbase=shm+LDS_K; bf16x8 kf[8];
  const lds_cptr shm3=(lds_cptr)shm; const lds_cptr kp0=shm3+LDS_K+hi*1024+r32*16; const lds_cptr vp0=shm3+LDS_V+((lane>>4)&1)*32+(lane&3)*8+(4*hi+((lane&15)>>2))*64;
  const int NT=(q0+QB)/KVBLK;
  if(first){DMA_K(0,0);DMA_V(0,0);DMA_K(1,KSLOT);}
  bf16x8 qr[4];
  #pragma unroll
  for(int d0=0;d0<4;++d0)qr[d0]=*reinterpret_cast<const bf16x8*>(&Qw[(long)r32*DM+d0*16+hi*8]);
  float l_reg=0.f;f32x16 o[4];o[0]=f32x16{};o[1]=f32x16{};o[2]=f32x16{};o[3]=f32x16{};
  const int qrel=wid*QBLK+r32;
  #define CMASK(P0,P1,t) do{int jb_=(t)-(NT-4); if(jb_>=0)cmask(P0,P1,jb_,qrel,hi);}while(0)
  f32x16 pA0,pA1,pB0,pB1;
  int sl_prev=0,sl_cur=0,sl_next=KSLOT;
  #define ROT() do{sl_prev=sl_cur;sl_cur=sl_next;sl_next=(sl_next==(NSLOT-1)*KSLOT)?0:sl_next+KSLOT;}while(0)
  DMA_K(2,2*KSLOT);
  WAIT_BAR(4);
  qkt(pA0,pA1,Kbase,qr,r32,hi);asm volatile("s_nop 15\n\ts_nop 7":"+v"(pA0),"+v"(pA1));CMASK(pA0,pA1,0);
  _Pragma("unroll") for(int r=0;r<16;++r){pA0[r]=__builtin_amdgcn_exp2f(pA0[r]);pA1[r]=__builtin_amdgcn_exp2f(pA1[r]);}
  WAIT_BAR(0);
  DMA_K(3,0);DMA_V(1,KSLOT);
  ROT();
  kload8(kf,kp0+sl_cur);
  WAIT_BAR(3);
  s16x4 vlo[8],vhi[8]; u32x4 pw0,pw1,pw2,pw3;
  const f32x16 zero16=f32x16{};
  #define PKW(P,B) cvtpk_s(P[B],P[B+1])
  #define PAF(k) __builtin_bit_cast(bf16x8,pw##k)
  #define VFR(i) (bf16x8){vlo[i][0],vlo[i][1],vlo[i][2],vlo[i][3],vhi[i][0],vhi[i][1],vhi[i][2],vhi[i][3]}
  #define PIN(x) asm volatile("":"+v"(x))
  #define GAPA(MF,A0,A1,A2,A3,W0,W1,PW) do{ MF; sacc+=A0; sacc+=A1; sacc+=A2; sacc+=A3; PIN(sacc); W0; W1; PIN(PW); SBAR(); }while(0)
  #define EX(v) __builtin_amdgcn_exp2f(v)
  #define GAPB(MF,X,B) do{ MF; X[B]=EX(X[B]); X[B+1]=EX(X[B+1]); PIN(X); SBAR(); }while(0)
  #define VRD(i) do{ vlo[i]=vtr(vp_+(((i)>>2)*4096+((i)&3)*1024)); vhi[i]=vtr(vp_+(((i)>>2)*4096+((i)&3)*1024+512)); }while(0)
  #define VRD2(i) do{ vlo[i]=vtr(vp_+((((i)>>2)+2)*4096+((i)&3)*1024)); vhi[i]=vtr(vp_+((((i)>>2)+2)*4096+((i)&3)*1024+512)); SBAR(); }while(0)
  #define KRD(G,j) do{ if(G){ kload2(kf,kp0+sl_next,j); SBAR(); } }while(0)
  #define STEP(C0,C1,P0,P1,t,GK,GV,GL) do{ SBAR(); \
    const lds_cptr vp_=vp0+2*sl_prev; \
    VRD(0); SBAR(); float sacc=(P0[0]+P0[1]); \
    GAPA(C0=__builtin_amdgcn_mfma_f32_32x32x16_bf16(kf[0],qr[0],zero16,0,0,0), P0[2],P0[3],P0[4],P0[5],     pw0[0]=PKW(P0,0), pw0[1]=PKW(P0,2), pw0); \
    VRD(4); SBAR(); GAPA(C1=__builtin_amdgcn_mfma_f32_32x32x16_bf16(kf[1],qr[0],zero16,0,0,0), P0[6],P0[7],P0[8],P0[9],     pw0[2]=PKW(P0,4), pw0[3]=PKW(P0,6), pw0); \
    VRD(1); SBAR(); GAPA(C0=__builtin_amdgcn_mfma_f32_32x32x16_bf16(kf[2],qr[1],C0,0,0,0),   P0[10],P0[11],P0[12],P0[13], pw1[0]=PKW(P0,8), pw1[1]=PKW(P0,10), pw1); \
    VRD(5); SBAR(); GAPA(C1=__builtin_amdgcn_mfma_f32_32x32x16_bf16(kf[3],qr[1],C1,0,0,0),   P0[14],P0[15],P1[0],P1[1],   pw1[2]=PKW(P0,12),pw1[3]=PKW(P0,14), pw1); \
    VRD(2); SBAR(); GAPA(C0=__builtin_amdgcn_mfma_f32_32x32x16_bf16(kf[4],qr[2],C0,0,0,0),   P1[2],P1[3],P1[4],P1[5],     pw2[0]=PKW(P1,0), pw2[1]=PKW(P1,2), pw2); \
    VRD(6); SBAR(); GAPA(C1=__builtin_amdgcn_mfma_f32_32x32x16_bf16(kf[5],qr[2],C1,0,0,0),   P1[6],P1[7],P1[8],P1[9],     pw2[2]=PKW(P1,4), pw2[3]=PKW(P1,6), pw2); \
    VRD(3); SBAR(); GAPA(C0=__builtin_amdgcn_mfma_f32_32x32x16_bf16(kf[6],qr[3],C0,0,0,0),   P1[10],P1[11],P1[12],P1[13], pw3[0]=PKW(P1,8), pw3[1]=PKW(P1,10), pw3); \
    VRD(7); SBAR(); GAPA(C1=__builtin_amdgcn_mfma_f32_32x32x16_bf16(kf[7],qr[3],C1,0,0,0),   P1[14],P1[15],0.f,0.f,       pw3[2]=PKW(P1,12),pw3[3]=PKW(P1,14), pw3); \
    l_reg+=sacc; \
    if(GK){DMA_K((t)+3,sl_cur);} if(GV){DMA_V((t)+1,sl_next);} \
    CMASK(C0,C1,t); \
    SBAR(); \
    GAPB(o[0]=__builtin_amdgcn_mfma_f32_32x32x16_bf16(PAF(0),VFR(0),o[0],0,0,0), C0,0); \
    VRD2(0); GAPB(o[1]=__builtin_amdgcn_mfma_f32_32x32x16_bf16(PAF(0),VFR(4),o[1],0,0,0), C0,2); \
    VRD2(4); KRD(GL,0); GAPB(o[0]=__builtin_amdgcn_mfma_f32_32x32x16_bf16(PAF(1),VFR(1),o[0],0,0,0), C0,4); \
    VRD2(1); KRD(GL,1); GAPB(o[1]=__builtin_amdgcn_mfma_f32_32x32x16_bf16(PAF(1),VFR(5),o[1],0,0,0), C0,6); \
    VRD2(5); KRD(GL,2); GAPB(o[0]=__builtin_amdgcn_mfma_f32_32x32x16_bf16(PAF(2),VFR(2),o[0],0,0,0), C0,8); \
    VRD2(2); KRD(GL,3); GAPB(o[1]=__builtin_amdgcn_mfma_f32_32x32x16_bf16(PAF(2),VFR(6),o[1],0,0,0), C0,10); \
    VRD2(6); GAPB(o[0]=__builtin_amdgcn_mfma_f32_32x32x16_bf16(PAF(3),VFR(3),o[0],0,0,0), C0,12); \
    VRD2(3); GAPB(o[1]=__builtin_amdgcn_mfma_f32_32x32x16_bf16(PAF(3),VFR(7),o[1],0,0,0), C0,14); \
    VRD2(7); \
    GAPB(o[2]=__builtin_amdgcn_mfma_f32_32x32x16_bf16(PAF(0),VFR(0),o[2],0,0,0), C1,0); \
    GAPB(o[3]=__builtin_amdgcn_mfma_f32_32x32x16_bf16(PAF(0),VFR(4),o[3],0,0,0), C1,2); \
    GAPB(o[2]=__builtin_amdgcn_mfma_f32_32x32x16_bf16(PAF(1),VFR(1),o[2],0,0,0), C1,4); \
    GAPB(o[3]=__builtin_amdgcn_mfma_f32_32x32x16_bf16(PAF(1),VFR(5),o[3],0,0,0), C1,6); \
    GAPB(o[2]=__builtin_amdgcn_mfma_f32_32x32x16_bf16(PAF(2),VFR(2),o[2],0,0,0), C1,8); \
    GAPB(o[3]=__builtin_amdgcn_mfma_f32_32x32x16_bf16(PAF(2),VFR(6),o[3],0,0,0), C1,10); \
    GAPB(o[2]=__builtin_amdgcn_mfma_f32_32x32x16_bf16(PAF(3),VFR(3),o[2],0,0,0), C1,12); \
    GAPB(o[3]=__builtin_amdgcn_mfma_f32_32x32x16_bf16(PAF(3),VFR(7),o[3],0,0,0), C1,14); \
    }while(0)
  int t=1;
  if(wid>=4)__builtin_amdgcn_s_setprio(1);
  #undef CMASK
  #define CMASK(P0,P1,t) do{}while(0)
  for(;t+5<NT;t+=2){
    STEP(pB0,pB1,pA0,pA1,t,true,true,true);     WAIT_BAR(3); ROT();
    STEP(pA0,pA1,pB0,pB1,t+1,true,true,true);   WAIT_BAR(3); ROT();
  }
  #undef CMASK
  #define CMASK(P0,P1,t) do{int jb_=(t)-(NT-4); if(jb_>=0)cmask(P0,P1,jb_,qrel,hi);}while(0)
  #define ENDW(tt) do{ if((tt)+3<NT){WAIT_BAR(3);} else if((tt)+2<NT){WAIT_BAR(2);} else {WAIT_BAR(0);} }while(0)
  for(;t+1<NT;t+=2){
    STEP(pB0,pB1,pA0,pA1,t,(t+3<NT),(t+1<NT),(t+1<NT));       ENDW(t);   ROT();
    STEP(pA0,pA1,pB0,pB1,t+1,(t+4<NT),(t+2<NT),(t+2<NT));     ENDW(t+1); ROT();
  }
  STEP(pB0,pB1,pA0,pA1,NT-1,false,false,false);
  __builtin_amdgcn_s_setprio(0);
  { float sacc=pB0[0]+pB0[1]; _Pragma("unroll") for(int r=2;r<16;++r)sacc+=pB0[r]; _Pragma("unroll") for(int r=0;r<16;++r)sacc+=pB1[r]; l_reg+=sacc;
    pw0=(u32x4){PKW(pB0,0),PKW(pB0,2),PKW(pB0,4),PKW(pB0,6)};pw1=(u32x4){PKW(pB0,8),PKW(pB0,10),PKW(pB0,12),PKW(pB0,14)};pw2=(u32x4){PKW(pB1,0),PKW(pB1,2),PKW(pB1,4),PKW(pB1,6)};pw3=(u32x4){PKW(pB1,8),PKW(pB1,10),PKW(pB1,12),PKW(pB1,14)};
    SBAR(); pv4(o,vb0+2*sl_cur,PAF(0),PAF(1),PAF(2),PAF(3)); }
  asm volatile("s_waitcnt lgkmcnt(0)\n\ts_barrier":::"memory");
  if(has_next){ const long nrow=(long)nb*SEQ; const bf16*nk=K+nrow*DM+nqcol+(long)lane*DM+wid*8; const bf16*nv=V+nrow*DM+nvcol+(long)(16*(wid&3)+(lane>>2))*DM+(wid>>2)*32+(lane&3)*8;
    glds16(nk,(unsigned)__builtin_amdgcn_readfirstlane(kdst)); glds16(nv,(unsigned)__builtin_amdgcn_readfirstlane(vdst)); glds16(nv+64,(unsigned)__builtin_amdgcn_readfirstlane(vdst+8192)); glds16(nk+(long)KVBLK*DM,(unsigned)__builtin_amdgcn_readfirstlane(kdst+KSLOT)); }
  #undef PKW
  #undef PAF
  #undef VFR
  #undef PIN
  #undef GAPA
  #undef GAPB
  #undef EX
  #undef VRD
  #undef VRD2
  #undef KRD
  #undef STEP
  #undef ENDW
  {auto rr=__builtin_amdgcn_permlane32_swap(__float_as_uint(l_reg),__float_as_uint(l_reg),false,false);l_reg=__uint_as_float(rr[0])+__uint_as_float(rr[1]);}
  { int tz=threadIdx.x; asm volatile("":"+v"(tz)); const int lane2=tz&63,r2=lane2&31,hi2=lane2>>5,wid2=tz>>6;
    float*wsf2=(float*)(shm+LDS_WS)+wid2*64;
    if(hi2==0)wsf2[32+r2]=l_reg;asm volatile("s_waitcnt lgkmcnt(0)":::"memory");
    float rli[16];
    #pragma unroll
    for(int r=0;r<16;++r)rli[r]=__builtin_amdgcn_rcpf(wsf2[32+crow(r,hi2)]);
    bf16*stg=(bf16*)(shm+LDS_OST)+wid2*4096;
    if(comp==0){
      #pragma unroll
      for(int r=0;r<16;++r){const int orow=crow(r,hi2);
        #pragma unroll
        for(int d0=0;d0<4;++d0)stg[orow*128+d0*32+r2]=__float2bfloat16(o[d0][r]*rli[r]);}
    } else {
      float sg[4];
      #pragma unroll
      for(int d0=0;d0<4;++d0)sg[d0]=subln[d0*32+r2]*(1.0f-0.35550906759310784f);
      #pragma unroll
      for(int r=0;r<16;++r){const int orow=crow(r,hi2); float ss=0.f;
        #pragma unroll
        for(int d0=0;d0<4;++d0){const float o1=__bfloat162float(stg[orow*128+d0*32+r2]); const float dv=o1-lam*(o[d0][r]*rli[r]); o[d0][r]=dv; ss+=dv*dv;}
        ss+=__shfl_xor(ss,1);ss+=__shfl_xor(ss,2);ss+=__shfl_xor(ss,4);ss+=__shfl_xor(ss,8);ss+=__shfl_xor(ss,16);
        const float rn=__builtin_amdgcn_rsqf(ss*(1.f/128.f)+1e-6f);
        #pragma unroll
        for(int d0=0;d0<4;++d0)stg[orow*128+d0*32+r2]=__float2bfloat16(o[d0][r]*rn*sg[d0]);}
      asm volatile("s_waitcnt lgkmcnt(0)":::"memory");
      unsigned char*Ow=(unsigned char*)OUT+(rowbase+q0+wid2*QBLK)*OPITCH+ocol;
      #pragma unroll
      for(int i=0;i<8;++i){const int row=i*4+(lane2>>4),ch=lane2&15; const u32x4 v=*(const u32x4*)(stg+row*128+ch*8);
        u32x2 w8; w8.x=gm::pk_fp8x4(bflo(v.x)*16.f,bfhi(v.x)*16.f,bflo(v.y)*16.f,bfhi(v.y)*16.f); w8.y=gm::pk_fp8x4(bflo(v.z)*16.f,bfhi(v.z)*16.f,bflo(v.w)*16.f,bfhi(v.w)*16.f);
        *(u32x2*)(Ow+(long)row*OPITCH+ch*8)=w8;} }
  }
  asm volatile("s_waitcnt lgkmcnt(0)\n\ts_barrier":::"memory");
  #undef DMA_K
  #undef DMA_V
  #undef CMASK
  #undef ROT
}
__device__ __forceinline__ void diff_attn_phase(char*lds,const bf16*Q,const bf16*K,const bf16*V,bf16*OUT,float lam,const float*subln,int G,int bid,int vcu){
  const bool bal=(G==256);
  auto unit=[&](int i,int&hd,int&qb,int&c)->bool{ const int item=i>>1; c=i&1;
    if(bal){ if(i>=12)return false;
      if(item<4){ hd=vcu>>3; const int s=vcu&7; qb=(item==0)?s:(item==1)?15-s:(item==2)?16+s:31-s; }
      else{ hd=32+(vcu>>4); const int s=vcu&15; qb=(item==4)?s:31-s; } }
    else{ const int id=bid+item*G; if(id>=48*NQB)return false; hd=id/NQB; qb=NQB-1-(id%NQB); }
    return true; };
  int hd,qb,c; bool ok=unit(0,hd,qb,c);
  for(int i=0;ok;++i){
    int nhd=0,nqb=0,nc=0; const bool hn=unit(i+1,nhd,nqb,nc);
    const int b=hd/NHEAD,h=hd%NHEAD,nbb=nhd/NHEAD,nh=nhd%NHEAD;
    attn_unit(b,h*128+64*c,h*128,qb,c,lam,subln,h*128,Q,K,V,OUT,lds,i==0,hn,nbb,nh*128+64*nc,nh*128);
    hd=nhd;qb=nqb;c=nc;ok=hn;
  }
}
#undef SBAR
#undef WAIT_BAR
}
__device__ __forceinline__ void subln_phase(const Ctx& C) {
    const bf16_t* O1 = WSP(bf16_t, WS_BIG + BG_O1); const bf16_t* O2 = WSP(bf16_t, WS_BIG + BG_O2); bf16_t* cat = WSP(bf16_t, WS_S1);
    const int lane = C.lane;
    const float p01 = wave_sum(C.in(17)[lane] * C.in(17)[64 + lane]), p23 = wave_sum(C.in(17)[128 + lane] * C.in(17)[192 + lane]);
    const float lam = expf(p01) - expf(p23) + LAMBDA_INIT;
    const int sub = C.tid & 15;
    const f32x4 g0 = *(const f32x4*)(C.in(18) + 8 * sub), g1 = *(const f32x4*)(C.in(18) + 8 * sub + 4);
    const int NGRP = T * DH;
    for (int grp = (C.vcu * 512 + C.tid) >> 4; grp < NGRP; grp += (C.G * 512) >> 4) {
        const size_t off = (size_t)grp * DDV + 8 * sub;
        const u32x4 a = *(const u32x4*)(O1 + off), b = *(const u32x4*)(O2 + off);
        float v[8] = {bflo(a.x) - lam * bflo(b.x), bfhi(a.x) - lam * bfhi(b.x), bflo(a.y) - lam * bflo(b.y), bfhi(a.y) - lam * bfhi(b.y),
                      bflo(a.z) - lam * bflo(b.z), bfhi(a.z) - lam * bfhi(b.z), bflo(a.w) - lam * bflo(b.w), bfhi(a.w) - lam * bfhi(b.w)};
        float ss = 0.f;
#pragma unroll
        for (int i = 0; i < 8; ++i) ss += v[i] * v[i];
        ss += __shfl_xor(ss, 1); ss += __shfl_xor(ss, 2); ss += __shfl_xor(ss, 4); ss += __shfl_xor(ss, 8);
        const float rn = (1.0f / sqrtf(ss * (1.f / DDV) + EPS)) * (1.0f - LAMBDA_INIT);
        u32x4 w; w.x = cvtpk(v[0] * rn * g0[0], v[1] * rn * g0[1]); w.y = cvtpk(v[2] * rn * g0[2], v[3] * rn * g0[3]); w.z = cvtpk(v[4] * rn * g1[0], v[5] * rn * g1[1]); w.w = cvtpk(v[6] * rn * g1[2], v[7] * rn * g1[3]);
        const int tok = grp / DH, h = grp % DH;
        *(u32x4*)(cat + (size_t)tok * D + h * DDV + 8 * sub) = w;
    }
}
#ifndef MK_PROBE
#define MK_PROBE 0
#endif
#define REPN(k) ((MK_PROBE == (k)) ? 3 : 1)
#ifndef MK_N_LAUNCHES
#define MK_N_LAUNCHES 1
#endif
constexpr int NPHASE = 19;
struct Args { const void* in[28]; float* out; unsigned char* ws; int ph_lo, ph_hi; };
__global__ void __launch_bounds__(512, 2) yoco_fwd(Args args) {
    extern __shared__ __attribute__((aligned(16))) unsigned char lds_raw[];
    Ctx C;
    C.lds = (LAS unsigned char*)lds_raw;
    C.tid = threadIdx.x; C.lane = C.tid & 63; C.wave = __builtin_amdgcn_readfirstlane(C.tid >> 6);
    C.G = gridDim.x; C.bid = blockIdx.x; C.vcu = (C.G % 8 == 0) ? (C.bid % 8) * (C.G / 8) + C.bid / 8 : C.bid;
    C.ka = (karg_t)__builtin_amdgcn_kernarg_segment_ptr();
    C.out = args.out; C.ws = args.ws;
    volatile LAS unsigned* MISC = (volatile LAS unsigned*)(C.lds + MISC_OFF);
    for (int u = C.tid; u < 256; u += 512) MISC[u] = 0u;
    __syncthreads();
    unsigned* ctl = (unsigned*)(C.ws + WS_CTL);
    XcdBarrier bar; bar.bar = ctl + CW_BAR; bar.x = 0; bar.st = nullptr;
    const int lo = args.ph_lo, hi = args.ph_hi;
    if (hi - lo > 1) bar = xcd_barrier_post(ctl + CW_BAR, MISC + 8);
#ifndef MK_PHASE_MASK
#define MK_PHASE_MASK 0xFFFFFFFFu
#endif
#ifndef MK_DYN
#define MK_DYN 0
#endif
#define TKT(k) ((MK_DYN && (C.G % 8 == 0)) ? ctl + 32768 + (k) * 512 : (unsigned*)nullptr)
#define TSLOT ((LAS int*)(C.lds + MISC_OFF + 640))
#define IN(k) (((MK_PHASE_MASK >> (k)) & 1u) && lo <= (k) && (k) < hi)
#define SEAM(k) do { if (IN(k) && IN((k) + 1)) xcd_barrier(bar); } while (0)
    unsigned char* big = C.ws + WS_BIG;
    float* rstd = WSP(float, WS_RSTD);

    if (IN(0)) { p0_prologue(C);
#if MK_PROBE == 1
        xcd_barrier(bar); p0_prologue(C);
#endif
#if MK_PROBE == 24
        for (int q = 0; q < 16; ++q) xcd_barrier(bar);
#endif

    } SEAM(0);
    if (IN(1)) { ProbInA P; P.pm0 = 0;
        P.ord.init(T / 256, 12, C.G, C.bid, TKT(1), TSLOT);
 P.xb = (const char*)(C.ws + WS_S0); P.w = (const char*)(C.ws + WS_WINA); P.big = big; P.rstd = rstd; gm::gemm_phase(C.lds, P);
        { ProbInA8 Q; Q.ord.init(T / 256, 8, C.G, C.bid, TKT(1), TSLOT); Q.a = (const char*)(C.ws + WS_X8); Q.w = (const char*)(C.ws + WS_WINA + (size_t)3072 * D * 2); Q.big = big; Q.rstd = rstd; gm::gemm_phase8(C.lds, Q); }
    }
    if (MK_N_LAUNCHES != 1) { SEAM(1); }
    if (IN(2)) for (int rep = 0; rep < REPN(20); ++rep) {
        const int nmk = C.G > 64 ? 32 : 0;
        if (C.bid < 32 || nmk == 0) { ProbMemKV P; P.G = nmk ? 32 : C.G; P.c = C.bid; P.memb = (const char*)(C.ws + WS_MEMB); P.w = (const char*)(C.ws + WS_WMEM); P.outp = WSP(float, WS_MEMKV); P.rstd = WSP(float, WS_MISC + MS_RSTDMEM); gm::gemm_phase(C.lds, P); }
        if (C.bid >= nmk) gates_phase(C, (C.bid - nmk) * 8 + C.wave, (C.G - nmk) * 8);
    } SEAM(2);
    if (IN(3)) { mlstm_a(C); } SEAM(3);
    if (IN(4)) { mlstm_b(C); } SEAM(4);
    if (IN(5)) {
#ifndef SKIP_MLC
 mlstm_c(C);
#endif
#ifndef SKIP_MA
 memattn_phase(C, 0, WSP(bf16_t, WS_BIG + BG_MQ), WSP(bf16_t, WS_S1));
#endif
 }
 SEAM(5);
    if (IN(6)) { ProbOut<false> P; P.ord.init(T / 256, D / 256, C.G, C.bid, TKT(6), TSLOT); P.a = (const char*)(C.ws + WS_S1); P.w = (const char*)(C.ws + WS_WOUTA); P.resid = WSP(bf16_t, WS_S0);
        P.outp = WSP(bf16_t, WS_S2); gm::gemm_phase(C.lds, P); } SEAM(6);
    if (IN(7)) { router_phase(C, 0, WSP(bf16_t, WS_S2), rstd + T, 0);
#if MK_PROBE == 26
        xcd_barrier(bar); router_phase(C, 0, WSP(bf16_t, WS_S2), rstd + T, 2); xcd_barrier(bar); router_phase(C, 0, WSP(bf16_t, WS_S2), rstd + T, 3);
#endif
    } SEAM(7);
    if (IN(8)) { moe_tables(C, 0); ProbGU8 P; P.G = C.G; P.c = C.bid; P.tb = moe_tb(C.lds); P.xb = (const char*)(C.ws + WS_X8); P.w = (const char*)(C.ws + WS_WGU); P.ltok = WSP(int, WS_LIST); P.lrs = WSP(float, WS_LIST + 8 * MiB); P.act = C.ws + WS_BIG + BG_ACT;
#if MK_PROBE == 42
        int nr_ = 2; asm volatile("" : "+s"(nr_)); for (int rep_ = 0; rep_ < nr_; ++rep_)
#endif
        gm::gemm_phase8(C.lds, P); } SEAM(8);
    if (IN(9)) { moe_tables(C, 0); ProbDown8 P; P.G = C.G; P.c = C.bid; P.tb = moe_tb(C.lds); P.act = (const char*)(C.ws + WS_BIG + BG_ACT); P.w = (const char*)(C.ws + WS_WD); P.lw = WSP(float, WS_LIST + 4 * MiB); P.yb = WSP(bf16_t, WS_BIG + BG_YB);
#if MK_PROBE == 43
        int nr_ = 2; asm volatile("" : "+s"(nr_)); for (int rep_ = 0; rep_ < nr_; ++rep_)
#endif
        gm::gemm_phase8(C.lds, P); } SEAM(9);
    if (IN(10)) { moe_tables(C, 0); for (int rep = 0; rep < REPN(21); ++rep) combine_phase<false>(C, WSP(bf16_t, WS_S2), WSP(bf16_t, WS_BIG + BG_YB), WSP(bf16_t, WS_S0), rstd + 2 * T, nullptr); } SEAM(10);
    if (IN(11)) { ProbL1F8 P; P.ord.init(T / 256, NL1 / 256, C.G, C.bid, TKT(11), TSLOT); P.a = (const char*)(C.ws + WS_X8); P.w = (const char*)(C.ws + WS_WL1); P.big = big; P.rstd = rstd + 2 * T;
        P.pos = (const int*)C.in(2); P.kgain = C.in(14); P.qgain = C.in(16);
        gm::gemm_phase8(C.lds, P); } SEAM(11);
    if (IN(12)) {
        float lam; { const float* lv = C.in(17); const float p01 = wave_sum(lv[C.lane] * lv[64 + C.lane]), p23 = wave_sum(lv[128 + C.lane] * lv[192 + C.lane]); lam = expf(p01) - expf(p23) + LAMBDA_INIT; }
#if MK_PROBE == 41
        int nr_ = 2; asm volatile("" : "+s"(nr_)); for (int rep_ = 0; rep_ < nr_; ++rep_)
#endif
        attn2::diff_attn_phase((char*)lds_raw, (const attn2::bf16*)(big + BG_QR), (const attn2::bf16*)(big + BG_KR), (const attn2::bf16*)(big + BG_VN), (attn2::bf16*)(C.ws + WS_S1), lam, C.in(18), C.G, C.bid, C.vcu);
        __syncthreads();
        memattn_phase(C, 1, WSP(bf16_t, WS_BIG + BG_MQ2), WSP(bf16_t, WS_S1));
    } if (IN(12) && IN(14)) xcd_barrier(bar);
    if (IN(14)) { ProbOut8 P; P.ord.init(T / 256, D / 256, C.G, C.bid, TKT(14), TSLOT); P.a = (const char*)(C.ws + WS_S1); P.w = (const char*)(C.ws + WS_WOUTB); P.resid = WSP(bf16_t, WS_S0); P.outp = WSP(bf16_t, WS_S2); gm::gemm_phase8(C.lds, P); } SEAM(14);
    if (IN(15)) { router_phase(C, 1, WSP(bf16_t, WS_S2), rstd + 3 * T, 1); } SEAM(15);
    if (IN(16)) { moe_tables(C, 1); ProbGU8 P; P.G = C.G; P.c = C.bid; P.tb = moe_tb(C.lds); P.xb = (const char*)(C.ws + WS_X8); P.w = (const char*)(C.ws + WS_WGU + (size_t)128 * MiB); P.ltok = WSP(int, WS_LIST); P.lrs = WSP(float, WS_LIST + 8 * MiB); P.act = C.ws + WS_BIG + BG_ACT; gm::gemm_phase8(C.lds, P); } SEAM(16);
    if (IN(17)) { moe_tables(C, 1); ProbDown8 P; P.G = C.G; P.c = C.bid; P.tb = moe_tb(C.lds); P.act = (const char*)(C.ws + WS_BIG + BG_ACT); P.w = (const char*)(C.ws + WS_WD + (size_t)64 * MiB); P.lw = WSP(float, WS_LIST + 4 * MiB); P.yb = WSP(bf16_t, WS_BIG + BG_YB); gm::gemm_phase8(C.lds, P); } SEAM(17);
    if (IN(18)) { moe_tables(C, 1); for (int rep = 0; rep < REPN(23); ++rep) combine_phase<true>(C, WSP(bf16_t, WS_S2), WSP(bf16_t, WS_BIG + BG_YB), nullptr, nullptr, C.out); }
#undef IN
#undef SEAM
}

extern "C" void kernel_launch(void* const* d_in, const int* in_sizes, int n_in, void* d_out, int out_size, void* d_ws, size_t ws_size, hipStream_t stream) {
    static int grid = 0;
    if (grid == 0) {
        if (n_in != 28 || out_size != T * D || ws_size < WS_END8) { fprintf(stderr, "kernel_launch: unexpected shapes: n_in %d out %d ws %zu (need %zu)\n", n_in, out_size, ws_size, (size_t)WS_END8); grid = -1; return; }
        int dev = 0, cus = 0, per_cu = 0;
        if (hipGetDevice(&dev) != hipSuccess || hipDeviceGetAttribute(&cus, hipDeviceAttributeMultiprocessorCount, dev) != hipSuccess) { grid = -1; return; }
        if (hipFuncSetAttribute((const void*)yoco_fwd, hipFuncAttributeMaxDynamicSharedMemorySize, LDS_BYTES) != hipSuccess) { fprintf(stderr, "kernel_launch: hipFuncSetAttribute failed\n"); grid = -1; return; }
        if (hipOccupancyMaxActiveBlocksPerMultiprocessor(&per_cu, (const void*)yoco_fwd, 512, LDS_BYTES) != hipSuccess || per_cu < 1) { fprintf(stderr, "kernel_launch: occupancy query says %d\n", per_cu); (void)hipGetLastError(); if (per_cu < 1) { grid = -1; return; } }
        grid = cus;
    }
    if (grid < 0) return;
    hipMemsetAsync((char*)d_ws + WS_CTL, 0, CTL_BYTES, stream);
    Args a{};
    for (int i = 0; i < 28; ++i) a.in[i] = d_in[i];
    a.out = (float*)d_out; a.ws = (unsigned char*)d_ws;
#if MK_N_LAUNCHES == 1
    a.ph_lo = 0; a.ph_hi = NPHASE;
    hipLaunchKernelGGL(yoco_fwd, dim3(grid), dim3(512), LDS_BYTES, stream, a);
#else
    for (int p = 0; p < NPHASE; ++p) { a.ph_lo = p; a.ph_hi = p + 1; hipLaunchKernelGGL(yoco_fwd, dim3(grid), dim3(512), LDS_BYTES, stream, a); }
#endif
}
```

```cpp
#include <hip/hip_runtime.h>
#include <cstdio>
#include <cstdint>

#define LAS __attribute__((address_space(3)))
#define GAS __attribute__((address_space(1)))
typedef unsigned short bf16_t;
typedef short bf16x8 __attribute__((ext_vector_type(8)));
typedef short s16x4 __attribute__((ext_vector_type(4)));
typedef float f32x4 __attribute__((ext_vector_type(4)));
typedef float f32x2 __attribute__((ext_vector_type(2)));
typedef float f32x16 __attribute__((ext_vector_type(16)));
typedef unsigned u32x4 __attribute__((ext_vector_type(4)));
typedef unsigned u32x2 __attribute__((ext_vector_type(2)));
typedef __bf16 bf16x2_t __attribute__((ext_vector_type(2)));

constexpr int T = 32768, D = 2048, NB = 4, SEQ = 8192;
constexpr int MEMS = 256, MEMH = 4, MEMW = 512, MEMHD = 128;
constexpr int LH = 6, LDV = 256, LDQK = 128, LCH = 128, LNC = 64;
constexpr int DH = 12, DHD = 64, DDV = 128;
constexpr int NE = 32, NG = 4, EPG = 8, DFF = 1024;
constexpr float EPS = 1e-6f;
constexpr int A_IN = 5132;
constexpr int NA = 5120;
constexpr int NL1 = 5120;
constexpr int MAXSLOT = 73728;
constexpr float LAMBDA_INIT = 0.35550906759310784f;
constexpr float LOG2E = 1.4426950408889634f;

constexpr size_t MiB = 1u << 20;
constexpr size_t WS_CTL = 0, CTL_BYTES = 1 * MiB;
constexpr size_t WS_RSTD = 1 * MiB;
constexpr size_t WS_GATES = 2 * MiB;
constexpr size_t WS_ROPE = 4 * MiB;
constexpr size_t WS_MEMKV = 12 * MiB;
constexpr size_t WS_MISC = 20 * MiB;
constexpr size_t WS_LIST = 23 * MiB;
constexpr size_t WS_MEMB = 36 * MiB;
constexpr size_t WS_WINA = 40 * MiB;
constexpr size_t WS_WOUTA = 60 * MiB;
constexpr size_t WS_WL1 = 68 * MiB;
constexpr size_t WS_WOUTB = 88 * MiB;
constexpr size_t WS_WMEM = 96 * MiB;
constexpr size_t WS_WGU = 104 * MiB;
constexpr size_t WS_WD = 616 * MiB;
constexpr size_t WS_S0 = 872 * MiB;
constexpr size_t WS_S1 = 1002 * MiB;
constexpr size_t WS_S2 = 1132 * MiB;
constexpr size_t WS_BIG = 1262 * MiB;
constexpr size_t WS_END = 1774 * MiB;
constexpr size_t BG_QN = 0, BG_KN = 48 * MiB, BG_VT = 96 * MiB, BG_ON = 192 * MiB, BG_MQ = 288 * MiB, BG_DCT = 320 * MiB, BG_CT = 416 * MiB;
constexpr size_t BG_ACT = 0, BG_YB = 144 * MiB;
constexpr size_t BG_KR = 0, BG_VN = 96 * MiB, BG_QR = 192 * MiB, BG_MQ2 = 288 * MiB, BG_O1 = 320 * MiB, BG_O2 = 416 * MiB;
constexpr size_t MS_RSTDMEM = 0;
constexpr size_t MS_BL = 8192, MS_ML = 8192 + 6144, MS_MST = 8192 + 2 * 6144;
constexpr size_t MS_DN = 32768;
constexpr size_t MS_NST = 32768 + 786432;
constexpr size_t MS_WR = 32768 + 2 * 786432;
constexpr size_t MS_WG = MS_WR + 786432;
static_assert(MS_WG + 131072 <= 3 * MiB, "misc");
constexpr int CW_BAR = 4096;
constexpr int CW_CNT = 16384;

constexpr int LDS_BYTES = 147456;
constexpr int MISC_OFF = 147456 - 1024;

__device__ __forceinline__ unsigned cvtpk(float lo, float hi) { f32x2 v = {lo, hi}; bf16x2_t b = __builtin_convertvector(v, bf16x2_t); return __builtin_bit_cast(unsigned, b); }
__device__ __forceinline__ float bf2f(unsigned short b) { return __uint_as_float(((unsigned)b) << 16); }
__device__ __forceinline__ float bflo(unsigned w) { return __uint_as_float(w << 16); }
__device__ __forceinline__ float bfhi(unsigned w) { return __uint_as_float(w & 0xffff0000u); }
__device__ __forceinline__ unsigned short f2bf(float f) { return (unsigned short)(cvtpk(f, 0.f) & 0xffffu); }
__device__ __forceinline__ float wave_sum(float v) {
#pragma unroll
    for (int o = 1; o < 64; o <<= 1) v += __shfl_xor(v, o);
    return v;
}
#define LDS_WAIT() asm volatile("s_waitcnt lgkmcnt(0)" ::: "memory")
#define VM_WAIT() asm volatile("s_waitcnt vmcnt(0)" ::: "memory")

#define XB_TMO      128
#define XB_XCNT(j)  (256  + 64 * (j))
#define XB_XSUB(j)  (1280 + 64 * (j))
#define XB_XGEN(j)  (2304 + 64 * (j))
#define XB_TOP      3328
#define XB_TOPGEN   3392
#define XCD_BAR_WORDS 3456
#define XB_SPIN_CAP (1u << 18)
__device__ __forceinline__ unsigned xb_ld(unsigned* p)              { return __hip_atomic_load(p, __ATOMIC_RELAXED, __HIP_MEMORY_SCOPE_AGENT); }
__device__ __forceinline__ unsigned xb_add(unsigned* p, unsigned v) { return __hip_atomic_fetch_add(p, v, __ATOMIC_RELAXED, __HIP_MEMORY_SCOPE_AGENT); }
__device__ __forceinline__ unsigned xb_xcc_id() { return (unsigned)__builtin_amdgcn_s_getreg((3 << 11) | 20) & 0xFu; }
#define XB_SPIN(cond, bar) do { unsigned _sp = 0; while (cond) { __builtin_amdgcn_s_sleep(1); \
    if ((++_sp & 255u) == 0u) { if (xb_ld(&(bar)[XB_TMO])) break; if (_sp > XB_SPIN_CAP) { atomicAdd(&(bar)[XB_TMO], 1u); break; } } } } while (0)
struct XcdBarrier { unsigned* bar; unsigned x; volatile LAS unsigned* st; };
__device__ __forceinline__ XcdBarrier xcd_barrier_post(unsigned* bar, volatile LAS unsigned* st) {
    XcdBarrier b; b.bar = bar; b.x = xb_xcc_id(); b.st = st;
    if (threadIdx.x == 0) (void)xb_add(&bar[XB_XCNT(b.x)], 1u);
    return b;
}
__device__ __forceinline__ void xcd_barrier_complete(unsigned* bar, unsigned x, unsigned& nloc, unsigned& nx) {
    const unsigned G = gridDim.x * gridDim.y * gridDim.z;
    unsigned sum, cnt, mine, sp = 0u;
    for (;;) {
        sum = 0u; cnt = 0u; mine = 0u;
#pragma unroll
        for (unsigned j = 0; j < 16; ++j) { const unsigned c = xb_ld(&bar[XB_XCNT(j)]); sum += c; cnt += (c > 0u) ? 1u : 0u; mine = (j == x) ? c : mine; }
        if (sum == G) break;
        __builtin_amdgcn_s_sleep(1);
        if ((++sp & 255u) == 0u) { if (xb_ld(&bar[XB_TMO])) break; if (sp > XB_SPIN_CAP) { atomicAdd(&bar[XB_TMO], 1u); break; } }
    }
    nloc = mine > 0u ? mine : 1u; nx = cnt > 0u ? cnt : 1u;
}
__device__ __forceinline__ void xcd_barrier(const XcdBarrier& b) {
    asm volatile("s_waitcnt vmcnt(0)" ::: "memory");
    __syncthreads();
    if (threadIdx.x == 0) {
        unsigned* bar = b.bar;
        __builtin_amdgcn_s_waitcnt(0);
        unsigned nloc = b.st[0], nx = b.st[1];
        if (nloc == 0u) { xcd_barrier_complete(bar, b.x, nloc, nx); b.st[0] = nloc; b.st[1] = nx; }
        const unsigned old = xb_add(&bar[XB_XSUB(b.x)], 1u);
        const unsigned gen = old / nloc;
        if (old + 1u == (gen + 1u) * nloc) {
            __builtin_amdgcn_fence(__ATOMIC_RELEASE, "agent");
            asm volatile("s_waitcnt vmcnt(0)" ::: "memory");
            const unsigned og = xb_add(&bar[XB_TOP], 1u);
            const unsigned tg = og / nx;
            if (og + 1u == (tg + 1u) * nx) xb_add(&bar[XB_TOPGEN], 1u);
            else XB_SPIN(xb_ld(&bar[XB_TOPGEN]) == tg, bar);
            __builtin_amdgcn_fence(__ATOMIC_ACQUIRE, "agent");
            xb_add(&bar[XB_XGEN(b.x)], 1u);
            asm volatile("s_waitcnt vmcnt(0)" ::: "memory");
        } else {
            XB_SPIN(xb_ld(&bar[XB_XGEN(b.x)]) == gen, bar);
            __builtin_amdgcn_fence(__ATOMIC_ACQUIRE, "agent");
            asm volatile("s_waitcnt vmcnt(0)" ::: "memory");
        }
    }
    __syncthreads();
}
namespace gm {
constexpr int BM = 256, BK = 64, HALF = 128, HTB = HALF * BK * 2, STAGE_BYTES = 8 * HTB, NXCD = 8, WGM = 8;
__host__ __device__ __forceinline__ int lds_byte(int r, int c) { const int st = (r >> 4) * 2 + (c >> 5), rr = r & 15, cc = c & 31, ob = rr * 64 + cc * 2; return st * 1024 + (ob ^ (((ob >> 9) & 1) << 5)); }
__host__ __device__ __forceinline__ void stage_rc(int b, int& R, int& C) { const int st = b / 1024, sb = b % 1024, swz = sb ^ (((sb >> 9) & 1) << 5); R = (st >> 1) * 16 + swz / 64; C = (st & 1) * 32 + (swz % 64) / 2; }
__host__ __device__ __forceinline__ int perm32(int rho) { const int n = rho >> 4, i = rho & 15; return 8 * (i >> 2) + 4 * n + (i & 3); }

struct Unit { const char* a; const char* b; int pm, pn, e, x; };

struct Order {
    int nM, nN, nwg, G, c; unsigned* tk; LAS int* slot;
    __device__ __forceinline__ void init(int nM_, int nN_, int G_, int c_, unsigned* tk_ = nullptr, LAS int* slot_ = nullptr) { nM = nM_; nN = nN_; nwg = nM * nN; G = G_; c = c_; tk = tk_; slot = slot_; }
    __device__ __forceinline__ long pick(int i) const {
        long L = (long)i * G + c;
        if (tk) {
            if (i >= 2) L = slot[i & 1];
            if (i >= 1 && threadIdx.x == 0) { int v = nwg;
#pragma unroll 1
                for (int j = 0; j < 8 && v >= nwg; ++j) { const int lb = (c + j) & 7; const unsigned t = __hip_atomic_fetch_add(tk + lb * 64, 1u, __ATOMIC_RELAXED, __HIP_MEMORY_SCOPE_AGENT); v = 2 * G + 8 * (int)t + lb; }
                slot[(i + 1) & 1] = v; }
        }
        return L;
    }
    __device__ __forceinline__ bool get(int i, int& pm, int& pn) const {
        const long L = pick(i); if (L >= nwg) return false;
        int wgid = (int)L; { const int q = nwg / NXCD, r = nwg % NXCD, xcd = wgid % NXCD, off = wgid / NXCD; wgid = (xcd < r ? xcd * (q + 1) : r * (q + 1) + (xcd - r) * q) + off; }
        const int nig = WGM * nN, gid = wgid / nig, fm = gid * WGM, gsz = (nM - fm) < WGM ? (nM - fm) : WGM;
        pm = fm + ((wgid % nig) % gsz); pn = (wgid % nig) / gsz; return true;
    }
};

template <class P>
__device__ __forceinline__ void gemm_phase(LAS unsigned char* lds, const P& p) {
    const int tid = threadIdx.x, wid = __builtin_amdgcn_readfirstlane(tid >> 6), lane = tid & 63, wr = wid >> 2, wc = wid & 3, fr = lane & 15, fq = lane >> 4;
    constexpr int K = P::K, nt = K / BK;
    unsigned voffA[2], voffB[2];
#pragma unroll
    for (int i = 0; i < 2; ++i) { int R, C; stage_rc(tid * 16 + i * 8192, R, C); const int Rb = (R & ~31) + perm32(R & 31);
        voffA[i] = (unsigned)(R * K + C) * 2u; voffB[i] = (unsigned)(Rb * K + C) * 2u; }
    constexpr size_t kstep = (size_t)(BK * 2);
    constexpr size_t hstep = (size_t)HALF * K * 2;
    const unsigned ldsw = (unsigned)wid * 1024u;
    const int aoff = lds_byte(wr * 64 + fr, fq * 8), boff = lds_byte(wc * 32 + fr, fq * 8);
#define GM_SA(b, h) (((b) * 2 + (h)) * HTB)
#define GM_SB(b, h) ((4 + (b) * 2 + (h)) * HTB)
#define GM_STAGE_B(bufoff, kbase, h) do { const char* _g = (kbase) + (size_t)(h) * hstep; _Pragma("unroll") for (int _i = 0; _i < 2; ++_i) \
        __builtin_amdgcn_global_load_lds((const unsigned*)(_g + voffB[_i]), (LAS unsigned*)(lds + (bufoff) + ldsw + _i * 8192), 16, 0, 0); } while (0)
#define GM_STAGE_A(bufoff, kbase, h, VV) do { const char* _g = (kbase) + (P::GATHER ? (size_t)0 : (size_t)(h) * hstep); _Pragma("unroll") for (int _i = 0; _i < 2; ++_i) { \
        const unsigned _o = P::GATHER ? VV[h][_i] : voffA[_i]; \
        __builtin_amdgcn_global_load_lds((const unsigned*)(_g + _o), (LAS unsigned*)(lds + (bufoff) + ldsw + _i * 8192), 16, 0, 0); } } while (0)
#define GM_LDA(dst, b, h) do { _Pragma("unroll") for (int m = 0; m < 4; ++m) _Pragma("unroll") for (int k = 0; k < 2; ++k) dst[m][k] = *(const LAS bf16x8*)(lds + GM_SA(b, h) + aoff + m * 2048 + k * 1024); } while (0)
#define GM_LDB(dst, b, h) do { _Pragma("unroll") for (int n = 0; n < 2; ++n) _Pragma("unroll") for (int k = 0; k < 2; ++k) dst[n][k] = *(const LAS bf16x8*)(lds + GM_SB(b, h) + boff + n * 2048 + k * 1024); } while (0)
#define GM_MMA(ai, bj, At, Bt) do { __builtin_amdgcn_s_setprio(1); _Pragma("unroll") for (int k = 0; k < 2; ++k) _Pragma("unroll") for (int m = 0; m < 4; ++m) _Pragma("unroll") for (int n = 0; n < 2; ++n) \
        acc[ai][bj][m][n] = __builtin_amdgcn_mfma_f32_16x16x32_bf16(Bt[n][k], At[m][k], acc[ai][bj][m][n], 0, 0, 0); __builtin_amdgcn_s_setprio(0); } while (0)
#define GM_WAIT_V(n) asm volatile("s_waitcnt vmcnt(" #n ")" ::: "memory")
#define GM_WAIT_L(n) asm volatile("s_waitcnt lgkmcnt(" #n ")" ::: "memory")
#define GM_BAR __builtin_amdgcn_s_barrier()
#define GM_SCHED __builtin_amdgcn_sched_barrier(0)
#define GM_GATHER_LOAD(VV, U) do { _Pragma("unroll") for (int _h = 0; _h < 2; ++_h) _Pragma("unroll") for (int _i = 0; _i < 2; ++_i) { int R, C; stage_rc(tid * 16 + _i * 8192, R, C); \
        VV[_h][_i] = p.row_off(U, _h * HALF + R) + (unsigned)C * 2u; } GM_WAIT_V(0); } while (0)
    Unit cur, nxt; int ui = 0;
    if (!p.next(0, cur)) return;
    f32x4 acc[2][2][4][2];
#pragma unroll
    for (int a = 0; a < 2; ++a)
#pragma unroll
        for (int b = 0; b < 2; ++b)
#pragma unroll
            for (int m = 0; m < 4; ++m)
#pragma unroll
                for (int n = 0; n < 2; ++n) acc[a][b][m][n] = (f32x4){0.f, 0.f, 0.f, 0.f};
    bf16x8 At[4][2], B0[2][2], B1[2][2];
    const char* cA = cur.a; const char* cB = cur.b;
    unsigned vC[2][2] = {{0u, 0u}, {0u, 0u}};
    if constexpr (P::GATHER) { GM_GATHER_LOAD(vC, cur); }
    GM_STAGE_B(GM_SB(0, 0), cB, 0); GM_STAGE_B(GM_SB(0, 1), cB, 1); GM_STAGE_A(GM_SA(0, 0), cA, 0, vC); GM_STAGE_A(GM_SA(0, 1), cA, 1, vC);
    if (wr == 1) GM_BAR;
    GM_WAIT_V(2); GM_BAR;
    GM_STAGE_B(GM_SB(1, 0), cB + kstep, 0); GM_STAGE_A(GM_SA(1, 0), cA + kstep, 0, vC); GM_STAGE_B(GM_SB(1, 1), cB + kstep, 1);
    GM_WAIT_V(6); GM_BAR;
    for (;;) {
        const bool has_next = p.next(ui + 1, nxt);
        const char* nA = has_next ? nxt.a : cA; const char* nB = has_next ? nxt.b : cB;
#pragma unroll 1
        for (int t = 0; t < nt; t += 2) {
            const bool last = (t == nt - 2);
            const char* a1 = cA + (size_t)(t + 1) * kstep;
            const char* a2 = last ? nA : cA + (size_t)(t + 2) * kstep; const char* b2 = last ? nB : cB + (size_t)(t + 2) * kstep;
            const char* a3 = a2 + kstep; const char* b3 = b2 + kstep;
            GM_LDB(B0, 0, 0); GM_LDB(B1, 0, 1); GM_SCHED; GM_LDA(At, 0, 0); GM_STAGE_A(GM_SA(1, 1), a1, 1, vC);
            if constexpr (P::GATHER) { if (last && has_next) { GM_GATHER_LOAD(vC, nxt); } }
            GM_WAIT_V(8); GM_WAIT_L(0); GM_BAR; GM_MMA(0, 0, At, B0); GM_MMA(0, 1, At, B1); GM_BAR; GM_SCHED;
            GM_LDA(At, 0, 1); GM_STAGE_B(GM_SB(0, 0), b2, 0); GM_STAGE_B(GM_SB(0, 1), b2, 1); GM_STAGE_A(GM_SA(0, 0), a2, 0, vC);
            GM_WAIT_V(8); GM_WAIT_L(0); GM_BAR; GM_MMA(1, 0, At, B0); GM_MMA(1, 1, At, B1); GM_BAR; GM_SCHED;
            GM_LDB(B0, 1, 0); GM_LDB(B1, 1, 1); GM_SCHED; GM_LDA(At, 1, 0); GM_STAGE_A(GM_SA(0, 1), a2, 1, vC);
            GM_WAIT_V(8); GM_WAIT_L(0); GM_BAR; GM_MMA(0, 0, At, B0); GM_MMA(0, 1, At, B1); GM_BAR; GM_SCHED;
            GM_LDA(At, 1, 1); GM_STAGE_B(GM_SB(1, 0), b3, 0); GM_STAGE_B(GM_SB(1, 1), b3, 1); GM_STAGE_A(GM_SA(1, 0), a3, 0, vC);
            GM_WAIT_V(8); GM_WAIT_L(0); GM_BAR; GM_MMA(1, 0, At, B0); GM_MMA(1, 1, At, B1); GM_BAR; GM_SCHED;
        }
        if (wr == 0) GM_BAR;
        { int tz = threadIdx.x; asm volatile("" : "+v"(tz)); const int w2 = tz >> 6, l2 = tz & 63;
          p.epi(acc, cur, w2 >> 2, w2 & 3, l2 & 15, l2 >> 4); }
        if (!has_next) break;
#pragma unroll
        for (int a = 0; a < 2; ++a)
#pragma unroll
            for (int b = 0; b < 2; ++b)
#pragma unroll
                for (int m = 0; m < 4; ++m)
#pragma unroll
                    for (int n = 0; n < 2; ++n) acc[a][b][m][n] = (f32x4){0.f, 0.f, 0.f, 0.f};
        cur = nxt; cA = nA; cB = nB; ++ui;
        if (wr == 1) GM_BAR;
    }
    GM_WAIT_V(0);
    GM_BAR;
#undef GM_SA
#undef GM_SB
#undef GM_STAGE_A
#undef GM_STAGE_B
#undef GM_LDA
#undef GM_LDB
#undef GM_MMA
#undef GM_WAIT_V
#undef GM_WAIT_L
#undef GM_BAR
#undef GM_SCHED
#undef GM_GATHER_LOAD
}

__device__ __forceinline__ void store_tile_bf16(const f32x4 (&acc)[2][2][4][2], bf16_t* obase, size_t ldc, const float* rowscale, const float* colscale, bool act, int wr, int wc, int fr, int fq) {
    f32x4 cs[2][2];
#pragma unroll
    for (int bj = 0; bj < 2; ++bj)
#pragma unroll
        for (int n = 0; n < 2; ++n) cs[bj][n] = colscale ? *(const f32x4*)(colscale + bj * HALF + wc * 32 + 8 * fq + 4 * n) : (f32x4){1.f, 1.f, 1.f, 1.f};
    float rs8[8];
#pragma unroll
    for (int i = 0; i < 8; ++i) rs8[i] = rowscale ? rowscale[(i >> 2) * HALF + wr * 64 + (i & 3) * 16 + fr] : 1.f;
#pragma unroll
    for (int ai = 0; ai < 2; ++ai)
#pragma unroll
        for (int m = 0; m < 4; ++m) {
            const int r = ai * HALF + wr * 64 + m * 16 + fr; const float rs = rs8[ai * 4 + m];
            bf16_t* rowp = obase + (size_t)r * ldc + wc * 32 + 8 * fq;
#pragma unroll
            for (int bj = 0; bj < 2; ++bj) {
                f32x4 v0 = acc[ai][bj][m][0] * cs[bj][0] * rs, v1 = acc[ai][bj][m][1] * cs[bj][1] * rs;
                if (act) {
#pragma unroll
                    for (int j = 0; j < 4; ++j) { v0[j] = __builtin_amdgcn_rcpf(1.f + __builtin_amdgcn_exp2f(-LOG2E * v0[j])); v1[j] = __builtin_amdgcn_rcpf(1.f + __builtin_amdgcn_exp2f(-LOG2E * v1[j])); } }
                u32x4 w; w.x = cvtpk(v0[0], v0[1]); w.y = cvtpk(v0[2], v0[3]); w.z = cvtpk(v1[0], v1[1]); w.w = cvtpk(v1[2], v1[3]);
                *(u32x4*)(rowp + bj * HALF) = w; }
            asm volatile("" ::: "memory");
        }
}
}
namespace gm {
typedef int v8i_t __attribute__((ext_vector_type(8)));
__host__ __device__ __forceinline__ int perm32b(int rho) { return 16 * ((rho >> 2) & 1) + 4 * (rho >> 3) + (rho & 3); }
__host__ __device__ __forceinline__ int lds_byte8(int r, int c) { const int st = (r >> 4) * 2 + (c >> 5), rr = r & 15, cc = c & 31, ob = rr * 64 + cc * 2; return st * 1024 + (ob ^ (((ob >> 8) & 3) << 4)); }
__host__ __device__ __forceinline__ void stage_rc8(int b, int& R, int& C) { const int st = b / 1024, sb = b % 1024, swz = sb ^ (((sb >> 8) & 3) << 4); R = (st >> 1) * 16 + swz / 64; C = (st & 1) * 32 + (swz % 64) / 2; }
template <class P>
__device__ __forceinline__ void gemm_phase8(LAS unsigned char* lds, const P& p) {
    const int tid = threadIdx.x, wid = __builtin_amdgcn_readfirstlane(tid >> 6), lane = tid & 63, wr = wid >> 2, wc = wid & 3;
    constexpr int K = P::K, nt = K / BK;
    unsigned voffA[2], voffB[2];
#pragma unroll
    for (int i = 0; i < 2; ++i) { int R, C; stage_rc8(tid * 16 + i * 8192, R, C); const int Rb = (R & ~31) + perm32b(R & 31);
        voffA[i] = (unsigned)(R * K + C) * 2u; voffB[i] = (unsigned)(Rb * K + C) * 2u; }
    constexpr size_t kstep = (size_t)(BK * 2);
    constexpr size_t hstep = (size_t)HALF * K * 2;
    const unsigned ldsw = (unsigned)wid * 1024u;
    const int aoff = lds_byte8(wr * 64 + (lane & 31), 16 * (lane >> 5)), boff = lds_byte8(wc * 32 + (lane & 31), 16 * (lane >> 5));
#define GM_SA(b, h) (((b) * 2 + (h)) * HTB)
#define GM_SB(b, h) ((4 + (b) * 2 + (h)) * HTB)
#define GM_STAGE_B(bufoff, kbase, h) do { const char* _g = (kbase) + (size_t)(h) * hstep; _Pragma("unroll") for (int _i = 0; _i < 2; ++_i) \
        __builtin_amdgcn_global_load_lds((const unsigned*)(_g + voffB[_i]), (LAS unsigned*)(lds + (bufoff) + ldsw + _i * 8192), 16, 0, 0); } while (0)
#define GM_STAGE_A(bufoff, kbase, h, VV) do { const char* _g = (kbase) + (P::GATHER ? (size_t)0 : (size_t)(h) * hstep); _Pragma("unroll") for (int _i = 0; _i < 2; ++_i) { \
        const unsigned _o = P::GATHER ? VV[h][_i] : voffA[_i]; \
        __builtin_amdgcn_global_load_lds((const unsigned*)(_g + _o), (LAS unsigned*)(lds + (bufoff) + ldsw + _i * 8192), 16, 0, 0); } } while (0)
#define GM_LDA(dst, b, h) do { _Pragma("unroll") for (int m = 0; m < 4; ++m) _Pragma("unroll") for (int k = 0; k < 2; ++k) dst[m][k] = *(const LAS bf16x8*)(lds + GM_SA(b, h) + (aoff ^ (k * 16)) + (m >> 1) * 4096 + (m & 1) * 1024); } while (0)
#define GM_LDB(dst, b, h) do { _Pragma("unroll") for (int n = 0; n < 2; ++n) _Pragma("unroll") for (int k = 0; k < 2; ++k) dst[n][k] = *(const LAS bf16x8*)(lds + GM_SB(b, h) + (boff ^ (k * 16)) + n * 1024); } while (0)
#define GM_V8(lo, hi) __builtin_bit_cast(v8i_t, __builtin_shufflevector(lo, hi, 0, 1, 2, 3, 4, 5, 6, 7, 8, 9, 10, 11, 12, 13, 14, 15))
#define GM_MMA(ai, bj, At, Bt) do { __builtin_amdgcn_s_setprio(1); _Pragma("unroll") for (int s = 0; s < 2; ++s) _Pragma("unroll") for (int mb = 0; mb < 2; ++mb) \
        acc[ai][bj][mb] = __builtin_amdgcn_mfma_scale_f32_32x32x64_f8f6f4(GM_V8(Bt[s][0], Bt[s][1]), GM_V8(At[mb * 2 + s][0], At[mb * 2 + s][1]), acc[ai][bj][mb], 0, 0, 0, 0x7F7F7F7F, 0, 0x7F7F7F7F); \
        __builtin_amdgcn_s_setprio(0); } while (0)
#define GM_WAIT_V(n) asm volatile("s_waitcnt vmcnt(" #n ")" ::: "memory")
#define GM_WAIT_L(n) asm volatile("s_waitcnt lgkmcnt(" #n ")" ::: "memory")
#define GM_BAR __builtin_amdgcn_s_barrier()
#define GM_SCHED __builtin_amdgcn_sched_barrier(0)
#define GM_GATHER_LOAD(VV, U) do { _Pragma("unroll") for (int _h = 0; _h < 2; ++_h) _Pragma("unroll") for (int _i = 0; _i < 2; ++_i) { int R, C; stage_rc8(tid * 16 + _i * 8192, R, C); \
        VV[_h][_i] = p.row_off(U, _h * HALF + R) + (unsigned)C * 2u; } GM_WAIT_V(0); } while (0)
    Unit cur, nxt; int ui = 0;
    if (!p.next(0, cur)) return;
    f32x16 acc[2][2][2];
#pragma unroll
    for (int a = 0; a < 2; ++a)
#pragma unroll
        for (int b = 0; b < 2; ++b)
#pragma unroll
            for (int m = 0; m < 2; ++m) acc[a][b][m] = f32x16{};
    bf16x8 At[4][2], B0[2][2], B1[2][2];
    const char* cA = cur.a; const char* cB = cur.b;
    unsigned vC[2][2] = {{0u, 0u}, {0u, 0u}};
    if constexpr (P::GATHER) { GM_GATHER_LOAD(vC, cur); }
    GM_STAGE_B(GM_SB(0, 0), cB, 0); GM_STAGE_B(GM_SB(0, 1), cB, 1); GM_STAGE_A(GM_SA(0, 0), cA, 0, vC); GM_STAGE_A(GM_SA(0, 1), cA, 1, vC);
    if (wr == 1) GM_BAR;
    GM_WAIT_V(2); GM_BAR;
    GM_STAGE_B(GM_SB(1, 0), cB + kstep, 0); GM_STAGE_A(GM_SA(1, 0), cA + kstep, 0, vC); GM_STAGE_B(GM_SB(1, 1), cB + kstep, 1);
    GM_WAIT_V(6); GM_BAR;
    for (;;) {
        const bool has_next = p.next(ui + 1, nxt);
        const char* nA = has_next ? nxt.a : cA; const char* nB = has_next ? nxt.b : cB;
#pragma unroll 1
        for (int t = 0; t < nt; t += 2) {
            const bool last = (t == nt - 2);
            const char* a1 = cA + (size_t)(t + 1) * kstep;
            const char* a2 = last ? nA : cA + (size_t)(t + 2) * kstep; const char* b2 = last ? nB : cB + (size_t)(t + 2) * kstep;
            const char* a3 = a2 + kstep; const char* b3 = b2 + kstep;
            GM_LDB(B0, 0, 0); GM_LDB(B1, 0, 1); GM_SCHED; GM_LDA(At, 0, 0); GM_STAGE_A(GM_SA(1, 1), a1, 1, vC);
            if constexpr (P::GATHER) { if (last && has_next) { GM_GATHER_LOAD(vC, nxt); } }
            GM_WAIT_V(8); GM_WAIT_L(0); GM_BAR; GM_MMA(0, 0, At, B0); GM_MMA(0, 1, At, B1); GM_BAR; GM_SCHED;
            GM_LDA(At, 0, 1); GM_STAGE_B(GM_SB(0, 0), b2, 0); GM_STAGE_B(GM_SB(0, 1), b2, 1); GM_STAGE_A(GM_SA(0, 0), a2, 0, vC);
            GM_WAIT_V(8); GM_WAIT_L(0); GM_BAR; GM_MMA(1, 0, At, B0); GM_MMA(1, 1, At, B1); GM_BAR; GM_SCHED;
            GM_LDB(B0, 1, 0); GM_LDB(B1, 1, 1); GM_SCHED; GM_LDA(At, 1, 0); GM_STAGE_A(GM_SA(0, 1), a2, 1, vC);
            GM_WAIT_V(8); GM_WAIT_L(0); GM_BAR; GM_MMA(0, 0, At, B0); GM_MMA(0, 1, At, B1); GM_BAR; GM_SCHED;
            GM_LDA(At, 1, 1); GM_STAGE_B(GM_SB(1, 0), b3, 0); GM_STAGE_B(GM_SB(1, 1), b3, 1); GM_STAGE_A(GM_SA(1, 0), a3, 0, vC);
            GM_WAIT_V(8); GM_WAIT_L(0); GM_BAR; GM_MMA(1, 0, At, B0); GM_MMA(1, 1, At, B1); GM_BAR; GM_SCHED;
        }
        if (wr == 0) GM_BAR;
        { int tz = threadIdx.x; asm volatile("" : "+v"(tz)); const int w2 = tz >> 6, l2 = tz & 63;
          p.epi8(acc, cur, w2 >> 2, w2 & 3, l2 & 31, l2 >> 5); }
        if (!has_next) break;
#pragma unroll
        for (int a = 0; a < 2; ++a)
#pragma unroll
            for (int b = 0; b < 2; ++b)
#pragma unroll
                for (int m = 0; m < 2; ++m) acc[a][b][m] = f32x16{};
        cur = nxt; cA = nA; cB = nB; ++ui;
        if (wr == 1) GM_BAR;
    }
    GM_WAIT_V(0);
    GM_BAR;
#undef GM_SA
#undef GM_SB
#undef GM_STAGE_A
#undef GM_STAGE_B
#undef GM_LDA
#undef GM_LDB
#undef GM_V8
#undef GM_MMA
#undef GM_WAIT_V
#undef GM_WAIT_L
#undef GM_BAR
#undef GM_SCHED
#undef GM_GATHER_LOAD
}
__device__ __forceinline__ unsigned pk_fp8x4(float a, float b, float c, float d) {
    a = fminf(fmaxf(a, -448.f), 448.f); b = fminf(fmaxf(b, -448.f), 448.f); c = fminf(fmaxf(c, -448.f), 448.f); d = fminf(fmaxf(d, -448.f), 448.f);
    int w = 0; w = __builtin_amdgcn_cvt_pk_fp8_f32(a, b, w, false); w = __builtin_amdgcn_cvt_pk_fp8_f32(c, d, w, true); return (unsigned)w;
}
}
typedef __attribute__((address_space(4))) const unsigned long long* karg_t;
typedef __attribute__((address_space(4))) const unsigned long long* karg_t;
struct Ctx {
    karg_t ka;
    float* out; unsigned char* ws;
    LAS unsigned char* lds;
    int tid, lane, wave, G, vcu, bid;
    __device__ __forceinline__ const float* in(int k) const { karg_t p = ka; asm volatile("" : "+s"(p)); return (const float*)(const GAS float*)p[k]; }
};
#define WSP(T_, off) ((T_*)(C.ws + (off)))

struct ProbInA {
    static constexpr bool GATHER = false; static constexpr int K = 2048;
    gm::Order ord; const char* xb; const char* w; unsigned char* big; const float* rstd; int pm0;
    __device__ __forceinline__ bool next(int i, gm::Unit& u) const {
        int pm, pn; if (!ord.get(i, pm, pn)) return false; pm += pm0; u.pm = pm; u.pn = pn; u.e = 0; u.x = 0;
        const bool sw = (pn >= 6 && pn < 12);
        const char* xa = xb + (size_t)pm * 256 * K * 2; const char* wa = w + (size_t)pn * 256 * K * 2;
        u.a = sw ? wa : xa; u.b = sw ? xa : wa; return true;
    }
    __device__ __forceinline__ unsigned row_off(const gm::Unit&, int) const { return 0u; }
    __device__ __forceinline__ void epi(const f32x4 (&acc)[2][2][4][2], const gm::Unit& u, int wr, int wc, int fr, int fq) const {
        const int pm = u.pm, pn = u.pn;
        bf16_t* ob; size_t ldc; const float* rsp = rstd + pm * 256; const float* csp = nullptr; bool act = false;
        if (pn >= 6 && pn < 12) {
            const int b = pm >> 5, hd = pn - 6;
            ob = (bf16_t*)(big + BG_VT) + ((size_t)((b * LH + hd) * LDV)) * SEQ + (size_t)(pm & 31) * 256; ldc = SEQ; csp = rsp; rsp = nullptr;
        } else if (pn < 3) { ob = (bf16_t*)(big + BG_QN) + (size_t)pm * 256 * 768 + pn * 256; ldc = 768; }
        else if (pn < 6) { ob = (bf16_t*)(big + BG_KN) + (size_t)pm * 256 * 768 + (pn - 3) * 256; ldc = 768; }
        else if (pn < 18) { ob = (bf16_t*)(big + BG_ON) + (size_t)pm * 256 * 1536 + (pn - 12) * 256; ldc = 1536; act = true; }
        else { ob = (bf16_t*)(big + BG_MQ) + (size_t)pm * 256 * 512 + (pn - 18) * 256; ldc = 512; }
        gm::store_tile_bf16(acc, ob, ldc, rsp, csp, act, wr, wc, fr, fq);
    }
};
struct ProbMemKV {
    static constexpr bool GATHER = false; static constexpr int K = 2048;
    int G, c; const char* memb; const char* w; float* outp; const float* rstd;
    __device__ __forceinline__ bool next(int i, gm::Unit& u) const {
        const int L = i * G + c; if (L >= 32) return false;
        const int l = L >> 4, pm = (L >> 2) & 3, pn = L & 3; u.pm = pm; u.pn = pn; u.e = l; u.x = 0;
        u.a = memb + (size_t)pm * 256 * K * 2; u.b = w + ((size_t)l * 1024 + pn * 256) * K * 2; return true;
    }
    __device__ __forceinline__ unsigned row_off(const gm::Unit&, int) const { return 0u; }
    __device__ __forceinline__ void epi(const f32x4 (&acc)[2][2][4][2], const gm::Unit& u, int wr, int wc, int fr, int fq) const {
        float* ob = outp + ((size_t)u.e * 1024 + u.pm * 256) * 1024 + u.pn * 256;
        float rs8[8];
#pragma unroll
        for (int i = 0; i < 8; ++i) rs8[i] = rstd[u.pm * 256 + (i >> 2) * 128 + wr * 64 + (i & 3) * 16 + fr];
#pragma unroll
        for (int ai = 0; ai < 2; ++ai)
#pragma unroll
            for (int m = 0; m < 4; ++m) { const int r = ai * 128 + wr * 64 + m * 16 + fr; const float rs = rs8[ai * 4 + m]; float* rowp = ob + (size_t)r * 1024 + wc * 32 + 8 * fq;
#pragma unroll
                for (int bj = 0; bj < 2; ++bj) { *(f32x4*)(rowp + bj * 128) = acc[ai][bj][m][0] * rs; *(f32x4*)(rowp + bj * 128 + 4) = acc[ai][bj][m][1] * rs; } }
    }
};
template <bool RESID_F32> struct ProbOut {
    static constexpr bool GATHER = false; static constexpr int K = 2048;
    gm::Order ord; const char* a; const char* w; const void* resid; bf16_t* outp;
    __device__ __forceinline__ bool next(int i, gm::Unit& u) const {
        int pm, pn; if (!ord.get(i, pm, pn)) return false; u.pm = pm; u.pn = pn; u.e = 0; u.x = 0;
        u.a = a + (size_t)pm * 256 * K * 2; u.b = w + (size_t)pn * 256 * K * 2; return true;
    }
    __device__ __forceinline__ unsigned row_off(const gm::Unit&, int) const { return 0u; }
    __device__ __forceinline__ void epi(const f32x4 (&acc)[2][2][4][2], const gm::Unit& u, int wr, int wc, int fr, int fq) const {
#pragma unroll
        for (int ai = 0; ai < 2; ++ai) {
            const size_t off0 = ((size_t)u.pm * 256 + ai * 128 + wr * 64 + fr) * D + u.pn * 256 + wc * 32 + 8 * fq;
            f32x4 rf[4][2][2]; u32x4 rb[4][2];
#pragma unroll
            for (int m = 0; m < 4; ++m)
#pragma unroll
                for (int bj = 0; bj < 2; ++bj) {
                    if (RESID_F32) { const float* rp = (const float*)resid + off0 + (size_t)m * 16 * D + bj * 128; rf[m][bj][0] = *(const f32x4*)rp; rf[m][bj][1] = *(const f32x4*)(rp + 4); }
                    else rb[m][bj] = *(const u32x4*)((const bf16_t*)resid + off0 + (size_t)m * 16 * D + bj * 128); }
#pragma unroll
            for (int m = 0; m < 4; ++m)
#pragma unroll
                for (int bj = 0; bj < 2; ++bj) {
                    f32x4 v0 = acc[ai][bj][m][0], v1 = acc[ai][bj][m][1];
                    if (RESID_F32) { v0 += rf[m][bj][0]; v1 += rf[m][bj][1]; }
                    else { const u32x4 rw = rb[m][bj]; v0 += (f32x4){bflo(rw.x), bfhi(rw.x), bflo(rw.y), bfhi(rw.y)}; v1 += (f32x4){bflo(rw.z), bfhi(rw.z), bflo(rw.w), bfhi(rw.w)}; }
                    u32x4 w4; w4.x = cvtpk(v0[0], v0[1]); w4.y = cvtpk(v0[2], v0[3]); w4.z = cvtpk(v1[0], v1[1]); w4.w = cvtpk(v1[2], v1[3]);
                    *(u32x4*)(outp + off0 + (size_t)m * 16 * D + bj * 128) = w4; }
            asm volatile("" ::: "memory");
        }
    }
};
__device__ __forceinline__ LAS int* moe_tb(LAS unsigned char* lds) { return (LAS int*)(lds + MISC_OFF + 128); }
__device__ __forceinline__ void moe_tables(const Ctx& C, int layer) {
    LAS int* tb = moe_tb(C.lds);
    if (C.tid < 64) { const unsigned* cw = (const unsigned*)(C.ws + WS_CTL) + CW_CNT + layer * 32 * 64; const int e = C.tid & 31;
        const int c = (int)__hip_atomic_load(cw + e * 64, __ATOMIC_RELAXED, __HIP_MEMORY_SCOPE_AGENT);
        int incl = (c + 255) >> 8;
#pragma unroll
        for (int o = 1; o < 32; o <<= 1) { const int t = __shfl_up(incl, o); if (e >= o) incl += t; }
        if (C.tid < 32) { tb[40 + e] = c; tb[e] = incl - ((c + 255) >> 8); if (e == 31) tb[32] = incl; } }
    __syncthreads();
}
__device__ __forceinline__ bool moe_unit(LAS int* tb, int i, int G, int c, gm::Unit& u) {
    int g, pn;
    if ((G & 63) == 0) { const int x = c & 7, j = c >> 3; g = i * (G >> 3) + x * (G >> 6) + (j >> 3); pn = j & 7; }
    else { const int L = i * G + c; g = L >> 3; pn = L & 7; }
    if (g >= tb[32]) return false;
    int e = 0;
#pragma unroll 1
    for (int k = 16; k >= 1; k >>= 1) if (tb[e + k] <= g) e += k;
    u.e = e; u.x = g - tb[e]; u.pm = g; u.pn = pn; return true;
}
struct ProbGU {
    static constexpr bool GATHER = true; static constexpr int K = 2048;
    int G, c; LAS int* tb; const char* xb; const char* w; const int* ltok; const float* lrs; bf16_t* act;
    __device__ __forceinline__ bool next(int i, gm::Unit& u) const {
        if (!moe_unit(tb, i, G, c, u)) return false;
        u.a = xb; u.b = w + ((size_t)u.e * 2048 + u.pn * 256) * K * 2; return true;
    }
    __device__ __forceinline__ unsigned row_off(const gm::Unit& u, int r) const {
        const int slot = u.x * 256 + r; const int idx = slot < tb[40 + u.e] ? ltok[(size_t)u.e * T + slot] : T; return (unsigned)idx * (unsigned)(K * 2);
    }
    __device__ __forceinline__ void epi(const f32x4 (&acc)[2][2][4][2], const gm::Unit& u, int wr, int wc, int fr, int fq) const {
        const int cnt = tb[40 + u.e];
        float rs8[8];
#pragma unroll
        for (int i = 0; i < 8; ++i) { const int slot = u.x * 256 + (i >> 2) * 128 + wr * 64 + (i & 3) * 16 + fr; rs8[i] = slot < cnt ? lrs[(size_t)u.e * T + slot] : 0.f; }
#pragma unroll
        for (int ai = 0; ai < 2; ++ai)
#pragma unroll
            for (int m = 0; m < 4; ++m) { const int r = ai * 128 + wr * 64 + m * 16 + fr; const float rs = rs8[ai * 4 + m];
                float o[8];
#pragma unroll
                for (int n = 0; n < 2; ++n)
#pragma unroll
                    for (int j = 0; j < 4; ++j) { const float g = acc[ai][0][m][n][j] * rs, uu = acc[ai][1][m][n][j] * rs; o[n * 4 + j] = g * __builtin_amdgcn_rcpf(1.f + __builtin_amdgcn_exp2f(-LOG2E * g)) * uu; }
                u32x4 w4; w4.x = cvtpk(o[0], o[1]); w4.y = cvtpk(o[2], o[3]); w4.z = cvtpk(o[4], o[5]); w4.w = cvtpk(o[6], o[7]);
                *(u32x4*)(act + ((size_t)u.pm * 256 + r) * DFF + u.pn * 128 + wc * 32 + 8 * fq) = w4; asm volatile("" ::: "memory"); }
    }
};
struct ProbDown {
    static constexpr bool GATHER = false; static constexpr int K = 1024;
    int G, c; LAS int* tb; const char* act; const char* w; const float* lw; bf16_t* yb;
    __device__ __forceinline__ bool next(int i, gm::Unit& u) const {
        if (!moe_unit(tb, i, G, c, u)) return false;
        u.a = act + (size_t)u.pm * 256 * K * 2; u.b = w + ((size_t)u.e * 2048 + u.pn * 256) * K * 2; return true;
    }
    __device__ __forceinline__ unsigned row_off(const gm::Unit&, int) const { return 0u; }
    __device__ __forceinline__ void epi(const f32x4 (&acc)[2][2][4][2], const gm::Unit& u, int wr, int wc, int fr, int fq) const {
        const int cnt = tb[40 + u.e];
#pragma unroll
        for (int ai = 0; ai < 2; ++ai)
#pragma unroll
            for (int m = 0; m < 4; ++m) { const int r = ai * 128 + wr * 64 + m * 16 + fr; const int slot = u.x * 256 + r; const float ws = slot < cnt ? lw[(size_t)u.e * T + slot] : 0.f;
                bf16_t* rowp = yb + ((size_t)u.pm * 256 + r) * D + u.pn * 256 + wc * 32 + 8 * fq;
#pragma unroll
                for (int bj = 0; bj < 2; ++bj) { const f32x4 v0 = acc[ai][bj][m][0] * ws, v1 = acc[ai][bj][m][1] * ws;
                    u32x4 w4; w4.x = cvtpk(v0[0], v0[1]); w4.y = cvtpk(v0[2], v0[3]); w4.z = cvtpk(v1[0], v1[1]); w4.w = cvtpk(v1[2], v1[3]);
                    *(u32x4*)(rowp + bj * 128) = w4; } }
    }
};
struct ProbL1 {
    static constexpr bool GATHER = false; static constexpr int K = 2048;
    gm::Order ord; const char* xb; const char* w; unsigned char* big; const float* rstd; const int* pos; const float* kgain; const float* qgain;
    __device__ __forceinline__ bool next(int i, gm::Unit& u) const {
        int pm, pn; if (!ord.get(i, pm, pn)) return false; pn = pn < 6 ? pn : pn + 6;
        u.pm = pm; u.pn = pn; u.e = 0; u.x = 0;
        u.a = xb + (size_t)pm * 256 * K * 2; u.b = w + (size_t)pn * 256 * K * 2; return true;
    }
    __device__ __forceinline__ unsigned row_off(const gm::Unit&, int) const { return 0u; }
    __device__ __forceinline__ void epi(const f32x4 (&acc)[2][2][4][2], const gm::Unit& u, int wr, int wc, int fr, int fq) const {
        const int pm = u.pm, pn = u.pn;
        if (pn >= 18) { gm::store_tile_bf16(acc, (bf16_t*)(big + BG_MQ2) + (size_t)pm * 256 * 512 + (pn - 18) * 256, 512, rstd + pm * 256, nullptr, false, wr, wc, fr, fq); return; }
        const bool isq = pn >= 12; const int pl = isq ? pn - 12 : pn;
        bf16_t* ob = (bf16_t*)(big + (isq ? BG_QR : BG_KR)); const float* gain = isq ? qgain : kgain; const float osc = isq ? 0.125f * LOG2E : 1.f;
        float rs8[8]; int ps8[8];
#pragma unroll
        for (int i = 0; i < 8; ++i) { const size_t tok = (size_t)pm * 256 + (i >> 2) * 128 + wr * 64 + (i & 3) * 16 + fr; rs8[i] = rstd[tok]; ps8[i] = pos[tok]; }
        f32x4 g1[2], g2[2], invf[2];
#pragma unroll
        for (int n = 0; n < 2; ++n) { g1[n] = *(const f32x4*)(gain + 8 * fq + 4 * n); g2[n] = *(const f32x4*)(gain + 32 + 8 * fq + 4 * n);
#pragma unroll
            for (int j = 0; j < 4; ++j) invf[n][j] = exp2f(-(float)(8 * fq + 4 * n + j) * (13.287712379549449f / 32.f)) * 0.15915494309189535f; }
#pragma unroll
        for (int ai = 0; ai < 2; ++ai)
#pragma unroll
            for (int m = 0; m < 4; ++m) { const size_t tok = (size_t)pm * 256 + ai * 128 + wr * 64 + m * 16 + fr; const float rs = rs8[ai * 4 + m]; const float pf = (float)ps8[ai * 4 + m];
                float ss = 0.f;
#pragma unroll
                for (int n = 0; n < 2; ++n) { const f32x4 a1 = acc[ai][0][m][n], a2 = acc[ai][1][m][n];
                    ss += (a1[0] * a1[0] + a1[1] * a1[1]) + (a1[2] * a1[2] + a1[3] * a1[3]) + (a2[0] * a2[0] + a2[1] * a2[1]) + (a2[2] * a2[2] + a2[3] * a2[3]); }
                ss *= rs * rs; ss += __shfl_xor(ss, 16); ss += __shfl_xor(ss, 32);
                const float rn = rs * osc * __builtin_amdgcn_rsqf(ss * (1.f / 64.f) + EPS);
                u32x4 w1, w2; unsigned* pw1 = (unsigned*)&w1; unsigned* pw2 = (unsigned*)&w2;
#pragma unroll
                for (int n = 0; n < 2; ++n) { f32x4 cc, sn;
#pragma unroll
                    for (int j = 0; j < 4; ++j) { const float fr_ = __builtin_amdgcn_fractf(pf * invf[n][j]); cc[j] = __builtin_amdgcn_cosf(fr_); sn[j] = __builtin_amdgcn_sinf(fr_); }
                    const f32x4 y1 = acc[ai][0][m][n] * rn * g1[n], y2 = acc[ai][1][m][n] * rn * g2[n];
                    const f32x4 o1 = y1 * cc - y2 * sn, o2 = y1 * sn + y2 * cc;
                    pw1[2 * n] = cvtpk(o1[0], o1[1]); pw1[2 * n + 1] = cvtpk(o1[2], o1[3]); pw2[2 * n] = cvtpk(o2[0], o2[1]); pw2[2 * n + 1] = cvtpk(o2[2], o2[3]); }
                bf16_t* rowp = ob + tok * 1536 + pl * 256 + wc * 64 + 8 * fq;
                *(u32x4*)rowp = w1; *(u32x4*)(rowp + 32) = w2; }
    }
};
constexpr float SX8 = 4.f, SW8 = 256.f, SA8 = 8.f, SD8 = 128.f, SY8 = 64.f;
constexpr float SC8 = 16.f, SWO8 = 256.f;
constexpr size_t WS_X8 = WS_END;
constexpr size_t WS_END8 = WS_END + 66 * MiB;
struct ProbGU8 {
    static constexpr bool GATHER = true; static constexpr int K = 1024;
    int G, c; LAS int* tb; const char* xb; const char* w; const int* ltok; const float* lrs; unsigned char* act;
    __device__ __forceinline__ bool next(int i, gm::Unit& u) const {
        if (!moe_unit(tb, i, G, c, u)) return false;
        u.a = xb; u.b = w + ((size_t)u.e * 2048 + u.pn * 256) * 2048; return true;
    }
    __device__ __forceinline__ unsigned row_off(const gm::Unit& u, int r) const {
        const int slot = u.x * 256 + r, cnt = tb[40 + u.e]; const int v = ltok[(size_t)u.e * T + (slot < cnt ? slot : cnt - 1)];
        return (unsigned)(slot < cnt ? v : T) * 2048u;
    }
    __device__ __forceinline__ void epi8(const f32x16 (&acc)[2][2][2], const gm::Unit& u, int wr, int wc, int c32, int h) const {
        const int cnt = tb[40 + u.e];
        float rs4[4];
#pragma unroll
        for (int i = 0; i < 4; ++i) { const int slot = u.x * 256 + (i >> 1) * 128 + wr * 64 + (i & 1) * 32 + c32; const float v = lrs[(size_t)u.e * T + (slot < cnt ? slot : cnt - 1)]; rs4[i] = slot < cnt ? v * (1.0f / (SX8 * SW8)) : 0.f; }
#pragma unroll
        for (int ai = 0; ai < 2; ++ai)
#pragma unroll
            for (int mb = 0; mb < 2; ++mb) { const int r = ai * 128 + wr * 64 + mb * 32 + c32; const float rs = rs4[ai * 2 + mb];
                float o[16];
#pragma unroll
                for (int i = 0; i < 16; ++i) { const float g = acc[ai][0][mb][i] * rs, uu = acc[ai][1][mb][i] * rs; o[i] = g * __builtin_amdgcn_rcpf(1.f + __builtin_amdgcn_exp2f(-LOG2E * g)) * uu * SA8; }
                u32x4 w4; w4.x = gm::pk_fp8x4(o[0], o[1], o[2], o[3]); w4.y = gm::pk_fp8x4(o[4], o[5], o[6], o[7]); w4.z = gm::pk_fp8x4(o[8], o[9], o[10], o[11]); w4.w = gm::pk_fp8x4(o[12], o[13], o[14], o[15]);
                *(u32x4*)(act + ((size_t)u.pm * 256 + r) * DFF + u.pn * 128 + wc * 32 + 16 * h) = w4; }
    }
};
struct ProbDown8 {
    static constexpr bool GATHER = false; static constexpr int K = 512;
    int G, c; LAS int* tb; const char* act; const char* w; const float* lw; bf16_t* yb;
    __device__ __forceinline__ bool next(int i, gm::Unit& u) const {
        if (!moe_unit(tb, i, G, c, u)) return false;
        u.a = act + (size_t)u.pm * 256 * 1024; u.b = w + ((size_t)u.e * 2048 + u.pn * 256) * 1024; return true;
    }
    __device__ __forceinline__ unsigned row_off(const gm::Unit&, int) const { return 0u; }
    __device__ __forceinline__ void epi8(const f32x16 (&acc)[2][2][2], const gm::Unit& u, int wr, int wc, int c32, int h) const {
        const int cnt = tb[40 + u.e];
        float ws4[4];
#pragma unroll
        for (int i = 0; i < 4; ++i) { const int slot = u.x * 256 + (i >> 1) * 128 + wr * 64 + (i & 1) * 32 + c32; const float v = lw[(size_t)u.e * T + (slot < cnt ? slot : cnt - 1)]; ws4[i] = slot < cnt ? v * (SY8 / (SA8 * SD8)) : 0.f; }
#pragma unroll
        for (int ai = 0; ai < 2; ++ai)
#pragma unroll
            for (int mb = 0; mb < 2; ++mb) { const int r = ai * 128 + wr * 64 + mb * 32 + c32; const float ws = ws4[ai * 2 + mb];
                unsigned char* rowp = (unsigned char*)yb + ((size_t)u.pm * 256 + r) * D + u.pn * 256 + wc * 32 + 16 * h;
#pragma unroll
                for (int bj = 0; bj < 2; ++bj) { u32x4 w0;
                    w0.x = gm::pk_fp8x4(acc[ai][bj][mb][0] * ws, acc[ai][bj][mb][1] * ws, acc[ai][bj][mb][2] * ws, acc[ai][bj][mb][3] * ws);
                    w0.y = gm::pk_fp8x4(acc[ai][bj][mb][4] * ws, acc[ai][bj][mb][5] * ws, acc[ai][bj][mb][6] * ws, acc[ai][bj][mb][7] * ws);
                    w0.z = gm::pk_fp8x4(acc[ai][bj][mb][8] * ws, acc[ai][bj][mb][9] * ws, acc[ai][bj][mb][10] * ws, acc[ai][bj][mb][11] * ws);
                    w0.w = gm::pk_fp8x4(acc[ai][bj][mb][12] * ws, acc[ai][bj][mb][13] * ws, acc[ai][bj][mb][14] * ws, acc[ai][bj][mb][15] * ws);
                    *(u32x4*)(rowp + bj * 128) = w0; }
                asm volatile("" ::: "memory"); }
    }
};

struct ProbOut8 {
    static constexpr bool GATHER = false; static constexpr int K = 1024;
    gm::Order ord; const char* a; const char* w; const bf16_t* resid; bf16_t* outp;
    __device__ __forceinline__ bool next(int i, gm::Unit& u) const {
        int pm, pn; if (!ord.get(i, pm, pn)) return false; u.pm = pm; u.pn = pn; u.e = 0; u.x = 0;
        u.a = a + (size_t)pm * 256 * 2048; u.b = w + (size_t)pn * 256 * 2048; return true;
    }
    __device__ __forceinline__ unsigned row_off(const gm::Unit&, int) const { return 0u; }
    __device__ __forceinline__ void epi8(const f32x16 (&acc)[2][2][2], const gm::Unit& u, int wr, int wc, int c32, int h) const {
        constexpr float sc = 1.0f / (SC8 * SWO8);
#pragma unroll
        for (int ai = 0; ai < 2; ++ai) {
            const size_t off0 = ((size_t)u.pm * 256 + ai * 128 + wr * 64 + c32) * D + u.pn * 256 + wc * 32 + 16 * h;
            u32x4 rb[2][2][2];
#pragma unroll
            for (int mb = 0; mb < 2; ++mb)
#pragma unroll
                for (int bj = 0; bj < 2; ++bj) { const bf16_t* rp = resid + off0 + (size_t)mb * 32 * D + bj * 128; rb[mb][bj][0] = *(const u32x4*)rp; rb[mb][bj][1] = *(const u32x4*)(rp + 8); }
#pragma unroll
            for (int mb = 0; mb < 2; ++mb)
#pragma unroll
                for (int bj = 0; bj < 2; ++bj) { bf16_t* op = outp + off0 + (size_t)mb * 32 * D + bj * 128;
#pragma unroll
                    for (int q = 0; q < 2; ++q) { const u32x4 rw = rb[mb][bj][q]; const f32x16& a = acc[ai][bj][mb];
                        u32x4 w4; w4.x = cvtpk(a[8 * q + 0] * sc + bflo(rw.x), a[8 * q + 1] * sc + bfhi(rw.x)); w4.y = cvtpk(a[8 * q + 2] * sc + bflo(rw.y), a[8 * q + 3] * sc + bfhi(rw.y));
                        w4.z = cvtpk(a[8 * q + 4] * sc + bflo(rw.z), a[8 * q + 5] * sc + bfhi(rw.z)); w4.w = cvtpk(a[8 * q + 6] * sc + bflo(rw.w), a[8 * q + 7] * sc + bfhi(rw.w));
                        *(u32x4*)(op + 8 * q) = w4; } }
            asm volatile("" ::: "memory");
        }
    }
};

struct ProbL1V8 {
    static constexpr bool GATHER = false; static constexpr int K = 1024;
    gm::Order ord; const char* a; const char* w; bf16_t* vn; bf16_t* mq; const float* rstd;
    __device__ __forceinline__ bool next(int i, gm::Unit& u) const {
        int pm, pn; if (!ord.get(i, pm, pn)) return false; u.pm = pm; u.pn = pn; u.e = 0; u.x = 0;
        u.a = a + (size_t)pm * 256 * 2048; u.b = w + (size_t)pn * 256 * 2048; return true;
    }
    __device__ __forceinline__ unsigned row_off(const gm::Unit&, int) const { return 0u; }
    __device__ __forceinline__ void epi8(const f32x16 (&acc)[2][2][2], const gm::Unit& u, int wr, int wc, int c32, int h) const {
        float rs4[4];
#pragma unroll
        for (int i = 0; i < 4; ++i) rs4[i] = rstd[(size_t)u.pm * 256 + (i >> 1) * 128 + wr * 64 + (i & 1) * 32 + c32] * (1.0f / (SX8 * SW8));
#pragma unroll
        for (int ai = 0; ai < 2; ++ai)
#pragma unroll
            for (int mb = 0; mb < 2; ++mb) { const float rs = rs4[ai * 2 + mb];
                const size_t row = (size_t)u.pm * 256 + ai * 128 + wr * 64 + mb * 32 + c32;
                bf16_t* rowp = (u.pn < 6 ? vn + row * 1536 + u.pn * 256 : mq + row * 512 + (u.pn - 6) * 256) + wc * 32 + 16 * h;
#pragma unroll
                for (int bj = 0; bj < 2; ++bj) { const f32x16& a = acc[ai][bj][mb];
#pragma unroll
                    for (int q = 0; q < 2; ++q) { u32x4 w4; w4.x = cvtpk(a[8 * q + 0] * rs, a[8 * q + 1] * rs); w4.y = cvtpk(a[8 * q + 2] * rs, a[8 * q + 3] * rs); w4.z = cvtpk(a[8 * q + 4] * rs, a[8 * q + 5] * rs); w4.w = cvtpk(a[8 * q + 6] * rs, a[8 * q + 7] * rs);
                        *(u32x4*)(rowp + bj * 128 + 8 * q) = w4; } }
                asm volatile("" ::: "memory"); }
    }
};

struct ProbL1F8 {
    static constexpr bool GATHER = false; static constexpr int K = 1024;
    gm::Order ord; const char* a; const char* w; unsigned char* big; const float* rstd; const int* pos; const float* kgain; const float* qgain;
    __device__ __forceinline__ bool next(int i, gm::Unit& u) const {
        int pm, pn; if (!ord.get(i, pm, pn)) return false; u.pm = pm; u.pn = pn; u.e = 0; u.x = 0;
        u.a = a + (size_t)pm * 256 * 2048; u.b = w + (size_t)pn * 256 * 2048; return true;
    }
    __device__ __forceinline__ unsigned row_off(const gm::Unit&, int) const { return 0u; }
    __device__ __forceinline__ void epi8(const f32x16 (&acc)[2][2][2], const gm::Unit& u, int wr, int wc, int c32, int h) const {
        const int pm = u.pm, pn = u.pn;
        float rs4[4];
#pragma unroll
        for (int i = 0; i < 4; ++i) rs4[i] = rstd[(size_t)pm * 256 + (i >> 1) * 128 + wr * 64 + (i & 1) * 32 + c32] * (1.0f / (SX8 * SW8));
        const bool isv = pn >= 6 && pn < 12, ismq = pn >= 18;
        if (isv || ismq) {
#pragma unroll
            for (int ai = 0; ai < 2; ++ai)
#pragma unroll
                for (int mb = 0; mb < 2; ++mb) { const float rs = rs4[ai * 2 + mb];
                    const size_t row = (size_t)pm * 256 + ai * 128 + wr * 64 + mb * 32 + c32;
                    bf16_t* rowp = (isv ? (bf16_t*)(big + BG_VN) + row * 1536 + (pn - 6) * 256 : (bf16_t*)(big + BG_MQ2) + row * 512 + (pn - 18) * 256) + wc * 32 + 16 * h;
#pragma unroll
                    for (int bj = 0; bj < 2; ++bj) { const f32x16& a = acc[ai][bj][mb];
#pragma unroll
                        for (int q = 0; q < 2; ++q) { u32x4 w4; w4.x = cvtpk(a[8 * q + 0] * rs, a[8 * q + 1] * rs); w4.y = cvtpk(a[8 * q + 2] * rs, a[8 * q + 3] * rs); w4.z = cvtpk(a[8 * q + 4] * rs, a[8 * q + 5] * rs); w4.w = cvtpk(a[8 * q + 6] * rs, a[8 * q + 7] * rs);
                            *(u32x4*)(rowp + bj * 128 + 8 * q) = w4; } }
                    asm volatile("" ::: "memory"); }
            return;
        }
        const bool isq = pn >= 12; const int pl = isq ? pn - 12 : pn;
        bf16_t* ob = (bf16_t*)(big + (isq ? BG_QR : BG_KR)); const float* gain = isq ? qgain : kgain; const float osc = isq ? 0.125f * LOG2E : 1.f;
        int ps4[4];
#pragma unroll
        for (int i = 0; i < 4; ++i) ps4[i] = pos[(size_t)pm * 256 + (i >> 1) * 128 + wr * 64 + (i & 1) * 32 + c32];
        f32x4 g1[4], g2[4];
#pragma unroll
        for (int q = 0; q < 4; ++q) { g1[q] = *(const f32x4*)(gain + 16 * h + 4 * q); g2[q] = *(const f32x4*)(gain + 32 + 16 * h + 4 * q); }
        const float fbase = (float)(16 * h) * (13.287712379549449f / 32.f);
#pragma unroll
        for (int ai = 0; ai < 2; ++ai)
#pragma unroll
            for (int mb = 0; mb < 2; ++mb) { const float rs = rs4[ai * 2 + mb]; const float pf = (float)ps4[ai * 2 + mb] * 0.15915494309189535f;
                const size_t tok = (size_t)pm * 256 + ai * 128 + wr * 64 + mb * 32 + c32;
                const f32x16& a1 = acc[ai][0][mb]; const f32x16& a2 = acc[ai][1][mb];
                float ss = 0.f;
#pragma unroll
                for (int i = 0; i < 16; ++i) ss += a1[i] * a1[i] + a2[i] * a2[i];
                ss *= rs * rs; ss += __shfl_xor(ss, 32);
                const float rn = rs * osc * __builtin_amdgcn_rsqf(ss * (1.f / 64.f) + EPS);
                bf16_t* rowp = ob + tok * 1536 + pl * 256 + wc * 64 + 16 * h;
#pragma unroll
                for (int q = 0; q < 2; ++q) { float o1[8], o2[8];
#pragma unroll
                    for (int j = 0; j < 8; ++j) { const int i = 8 * q + j;
                        const float fr_ = __builtin_amdgcn_fractf(pf * __builtin_amdgcn_exp2f(-(fbase + (float)i * (13.287712379549449f / 32.f)))); const float cc = __builtin_amdgcn_cosf(fr_), sn = __builtin_amdgcn_sinf(fr_);
                        const float y1 = a1[i] * rn * g1[i >> 2][i & 3], y2 = a2[i] * rn * g2[i >> 2][i & 3]; o1[j] = y1 * cc - y2 * sn; o2[j] = y1 * sn + y2 * cc; }
                    u32x4 w1, w2;
                    w1.x = cvtpk(o1[0], o1[1]); w1.y = cvtpk(o1[2], o1[3]); w1.z = cvtpk(o1[4], o1[5]); w1.w = cvtpk(o1[6], o1[7]);
                    w2.x = cvtpk(o2[0], o2[1]); w2.y = cvtpk(o2[2], o2[3]); w2.z = cvtpk(o2[4], o2[5]); w2.w = cvtpk(o2[6], o2[7]);
                    *(u32x4*)(rowp + 8 * q) = w1; *(u32x4*)(rowp + 32 + 8 * q) = w2; }
                asm volatile("" ::: "memory"); }
    }
};

struct ProbInA8 {
    static constexpr bool GATHER = false; static constexpr int K = 1024;
    gm::Order ord; const char* a; const char* w; unsigned char* big; const float* rstd;
    __device__ __forceinline__ bool next(int i, gm::Unit& u) const {
        int pm, pn; if (!ord.get(i, pm, pn)) return false; u.pm = pm; u.pn = pn; u.e = 0; u.x = 0;
        const char* xa = a + (size_t)pm * 256 * 2048; const char* wa = w + (size_t)pn * 256 * 2048; const bool sw = pn >= 8;
        u.a = sw ? wa : xa; u.b = sw ? xa : wa; return true;
    }
    __device__ __forceinline__ unsigned row_off(const gm::Unit&, int) const { return 0u; }
    __device__ __forceinline__ void epi8(const f32x16 (&acc)[2][2][2], const gm::Unit& u, int wr, int wc, int c32, int h) const {
        const int pm = u.pm, pn = u.pn; const bool isg = pn < 6;
        if (pn >= 8) {
            const int b = pm >> 5, hd = pn - 8;
            bf16_t* ob = (bf16_t*)(big + BG_VT) + ((size_t)((b * LH + hd) * LDV)) * SEQ + (size_t)(pm & 31) * 256;
            f32x4 cs[2][4];
#pragma unroll
            for (int bj = 0; bj < 2; ++bj)
#pragma unroll
                for (int q = 0; q < 4; ++q) cs[bj][q] = *(const f32x4*)(rstd + (size_t)pm * 256 + bj * 128 + wc * 32 + 16 * h + 4 * q) * (1.0f / (SX8 * SW8));
#pragma unroll
            for (int ai = 0; ai < 2; ++ai)
#pragma unroll
                for (int mb = 0; mb < 2; ++mb) { bf16_t* rowp = ob + (size_t)(ai * 128 + wr * 64 + mb * 32 + c32) * SEQ + wc * 32 + 16 * h;
#pragma unroll
                    for (int bj = 0; bj < 2; ++bj) { const f32x16& a = acc[ai][bj][mb];
#pragma unroll
                        for (int q = 0; q < 2; ++q) { const f32x4 c0 = cs[bj][2 * q], c1 = cs[bj][2 * q + 1];
                            u32x4 w4; w4.x = cvtpk(a[8 * q + 0] * c0[0], a[8 * q + 1] * c0[1]); w4.y = cvtpk(a[8 * q + 2] * c0[2], a[8 * q + 3] * c0[3]); w4.z = cvtpk(a[8 * q + 4] * c1[0], a[8 * q + 5] * c1[1]); w4.w = cvtpk(a[8 * q + 6] * c1[2], a[8 * q + 7] * c1[3]);
                            *(u32x4*)(rowp + bj * 128 + 8 * q) = w4; } }
                    asm volatile("" ::: "memory"); }
            return;
        }
        float rs4[4];
#pragma unroll
        for (int i = 0; i < 4; ++i) rs4[i] = rstd[(size_t)pm * 256 + (i >> 1) * 128 + wr * 64 + (i & 1) * 32 + c32] * (1.0f / (SX8 * SW8));
#pragma unroll
        for (int ai = 0; ai < 2; ++ai)
#pragma unroll
            for (int mb = 0; mb < 2; ++mb) { const float rs = rs4[ai * 2 + mb];
                const size_t row = (size_t)pm * 256 + ai * 128 + wr * 64 + mb * 32 + c32;
                bf16_t* rowp = (isg ? (bf16_t*)(big + BG_ON) + row * 1536 + pn * 256 : (bf16_t*)(big + BG_MQ) + row * 512 + (pn - 6) * 256) + wc * 32 + 16 * h;
#pragma unroll
                for (int bj = 0; bj < 2; ++bj) { const f32x16& a = acc[ai][bj][mb];
#pragma unroll
                    for (int q = 0; q < 2; ++q) { float v[8];
#pragma unroll
                        for (int j = 0; j < 8; ++j) { const float t = a[8 * q + j] * rs; v[j] = isg ? __builtin_amdgcn_rcpf(1.f + __builtin_amdgcn_exp2f(-LOG2E * t)) : t; }
                        u32x4 w4; w4.x = cvtpk(v[0], v[1]); w4.y = cvtpk(v[2], v[3]); w4.z = cvtpk(v[4], v[5]); w4.w = cvtpk(v[6], v[7]);
                        *(u32x4*)(rowp + bj * 128 + 8 * q) = w4; } }
                asm volatile("" ::: "memory"); }
    }
};
__device__ __forceinline__ void xpose_item(const float* W, size_t ld, int k0, int n0, bf16_t* dst, int dstep, int Kd, const float* scale, float mul, LAS float* scr, int lane) {
    const int kr = lane >> 4, q = lane & 15;
    f32x4 v[16];
#pragma unroll
    for (int i = 0; i < 16; ++i) v[i] = __builtin_nontemporal_load((const f32x4*)(W + (size_t)(k0 + 4 * i + kr) * ld + n0 + 4 * q));
#pragma unroll
    for (int i = 0; i < 16; ++i) { const int k = 4 * i + kr; const float s = scale ? scale[k0 + k] * mul : mul; *(LAS f32x4*)(scr + k * 64 + 4 * (q ^ ((k >> 3) & 7))) = v[i] * s; }
    LDS_WAIT(); asm volatile("" ::: "memory");
    const int c = lane & 7;
#pragma unroll
    for (int j = 0; j < 8; ++j) { const int n = (lane >> 3) + 8 * j; const LAS float* sp = scr + (8 * c) * 64 + 4 * ((n >> 2) ^ c) + (n & 3);
        u32x4 o; o.x = cvtpk(sp[0], sp[64]); o.y = cvtpk(sp[128], sp[192]); o.z = cvtpk(sp[256], sp[320]); o.w = cvtpk(sp[384], sp[448]);
        *(u32x4*)(dst + (size_t)((n & 31) + (n >> 5) * dstep) * Kd + k0 + 8 * c) = o; }
    LDS_WAIT(); asm volatile("" ::: "memory");
}
__device__ __forceinline__ void xpose_item8(const float* W, size_t ld, int k0, int n0, unsigned char* dst, int Kd, const float* scale, float mul, LAS float* scr, int lane) {
    const int kr = lane >> 4, q = lane & 15;
    f32x4 v[16];
#pragma unroll
    for (int i = 0; i < 16; ++i) v[i] = __builtin_nontemporal_load((const f32x4*)(W + (size_t)(k0 + 4 * i + kr) * ld + n0 + 4 * q));
#pragma unroll
    for (int i = 0; i < 16; ++i) { const int k = 4 * i + kr; const float s = scale ? scale[k0 + k] * mul : mul; *(LAS f32x4*)(scr + k * 64 + 4 * (q ^ ((k >> 3) & 7))) = v[i] * s; }
    LDS_WAIT(); asm volatile("" ::: "memory");
    const int c = lane & 7;
#pragma unroll
    for (int j = 0; j < 8; ++j) { const int n = (lane >> 3) + 8 * j; const LAS float* sp = scr + (8 * c) * 64 + 4 * ((n >> 2) ^ c) + (n & 3);
        u32x2 o; o.x = gm::pk_fp8x4(sp[0], sp[64], sp[128], sp[192]); o.y = gm::pk_fp8x4(sp[256], sp[320], sp[384], sp[448]);
        *(u32x2*)(dst + (size_t)n * Kd + k0 + 8 * c) = o; }
    LDS_WAIT(); asm volatile("" ::: "memory");
}
__device__ __forceinline__ void cast_row(const float* xrow, bf16_t* orow, float* rstd_out, int lane) {
    const f32x4* xr = (const f32x4*)xrow + lane; f32x4 v[8]; float s = 0.f;
#pragma unroll
    for (int j = 0; j < 8; ++j) { v[j] = xr[64 * j]; s += (v[j].x * v[j].x + v[j].y * v[j].y) + (v[j].z * v[j].z + v[j].w * v[j].w); }
    s = wave_sum(s);
    u32x2* o8 = (u32x2*)orow + lane;
#pragma unroll
    for (int j = 0; j < 8; ++j) { u32x2 w; w.x = cvtpk(v[j].x, v[j].y); w.y = cvtpk(v[j].z, v[j].w); o8[64 * j] = w; }
    if (lane == 0) *rstd_out = 1.0f / sqrtf(s * (1.f / D) + EPS);
}
__device__ __forceinline__ void cast_row2(const float* xr0, const float* xr1, bf16_t* o0, bf16_t* o1, float* r0, float* r1, int lane, unsigned char* e0, unsigned char* e1) {
    const f32x4* p0 = (const f32x4*)xr0 + lane; const f32x4* p1 = (const f32x4*)xr1 + lane; f32x4 v[8], w[8]; float s0 = 0.f, s1 = 0.f;
#pragma unroll
    for (int j = 0; j < 8; ++j) { v[j] = p0[64 * j]; w[j] = p1[64 * j]; }
#pragma unroll
    for (int j = 0; j < 8; ++j) { s0 += (v[j].x * v[j].x + v[j].y * v[j].y) + (v[j].z * v[j].z + v[j].w * v[j].w); s1 += (w[j].x * w[j].x + w[j].y * w[j].y) + (w[j].z * w[j].z + w[j].w * w[j].w); }
    s0 = wave_sum(s0); s1 = wave_sum(s1);
    u32x2* q0 = (u32x2*)o0 + lane; u32x2* q1 = (u32x2*)o1 + lane;
#pragma unroll
    for (int j = 0; j < 8; ++j) { u32x2 a; a.x = cvtpk(v[j].x, v[j].y); a.y = cvtpk(v[j].z, v[j].w); q0[64 * j] = a; u32x2 b; b.x = cvtpk(w[j].x, w[j].y); b.y = cvtpk(w[j].z, w[j].w); q1[64 * j] = b; }
#pragma unroll
    for (int j = 0; j < 8; ++j) { ((unsigned*)e0 + lane)[64 * j] = gm::pk_fp8x4(v[j].x * 4.f, v[j].y * 4.f, v[j].z * 4.f, v[j].w * 4.f); ((unsigned*)e1 + lane)[64 * j] = gm::pk_fp8x4(w[j].x * 4.f, w[j].y * 4.f, w[j].z * 4.f, w[j].w * 4.f); }
    if (lane == 0) { *r0 = 1.0f / sqrtf(s0 * (1.f / D) + EPS); *r1 = 1.0f / sqrtf(s1 * (1.f / D) + EPS); }
}
__device__ __forceinline__ void p0_prologue(const Ctx& C) {
    LAS float* scr = (LAS float*)(C.lds + C.wave * 16384);
    const int gw = C.vcu * 8 + C.wave, NGW = C.G * 8, lane = C.lane;
    { bf16_t* xb = WSP(bf16_t, WS_S0); float* rstd0 = WSP(float, WS_RSTD);
      for (int m = gw; m < T / 2; m += NGW) cast_row2(C.in(0) + (size_t)m * D, C.in(0) + (size_t)(m + T / 2) * D, xb + (size_t)m * D, xb + (size_t)(m + T / 2) * D, rstd0 + m, rstd0 + m + T / 2, lane, C.ws + WS_END + (size_t)m * D, C.ws + WS_END + (size_t)(m + T / 2) * D);
      bf16_t* memb = WSP(bf16_t, WS_MEMB); float* rsm = WSP(float, WS_MISC + MS_RSTDMEM);
      for (int m = gw; m < NB * MEMS; m += NGW) cast_row(C.in(1) + (size_t)m * D, memb + (size_t)m * D, rsm + m, lane); }
    { const int gt = C.vcu * 512 + C.tid, NGT = C.G * 512;
      bf16_t* wr = WSP(bf16_t, WS_MISC + MS_WR);
      for (int i = gt; i < 2 * 48 * 2048; i += NGT) { const int l = i / (48 * 2048), n = (i / 2048) % 48, k = i % 2048; float v = 0.f;
          if (n < 4) v = C.in(21)[((size_t)l * D + k) * NG + n]; else if (n < 36) v = C.in(23)[((size_t)l * D + k) * NE + (n - 4)];
          v *= C.in(20)[l * D + k]; const unsigned short hi = f2bf(v); const unsigned short lo = f2bf(v - bf2f(hi));
          wr[(size_t)(l * 2 + 0) * 48 * 2048 + n * 2048 + k] = hi; wr[(size_t)(l * 2 + 1) * 48 * 2048 + n * 2048 + k] = lo; }
      bf16_t* wg = WSP(bf16_t, WS_MISC + MS_WG);
      for (int i = gt; i < 16 * 2048; i += NGT) { const int n = i / 2048, k = i % 2048; float v = 0.f; if (n < 12) v = C.in(8)[(size_t)k * A_IN + 4608 + n] * C.in(3)[k];
          const unsigned short hi = f2bf(v); const unsigned short lo = f2bf(v - bf2f(hi)); wg[n * 2048 + k] = hi; wg[16 * 2048 + n * 2048 + k] = lo; }
      unsigned* zr = (unsigned*)(WSP(bf16_t, WS_S2) + (size_t)T * D);
      for (int i = gt; i < 1024; i += NGT) zr[i] = 0u;
      unsigned* zr8 = (unsigned*)(C.ws + WS_X8 + (size_t)T * 2048);
      for (int i = gt; i < 512; i += NGT) zr8[i] = 0u; }
    constexpr int I_A = 32 * 80, I_O = 32 * 32, I_L = 32 * 80, I_M = 32 * 16, I_G = 32 * 16, I_D = 16 * 32;
    constexpr int N_SMALL = I_A + I_O + I_L + I_O + 2 * I_M;
    constexpr int NITEMS = N_SMALL + 64 * (2 * I_G + I_D);
    struct XP { const float* W; size_t ld; int k0, n0; unsigned char* dst; int dstep, Kd; const float* scale; float mul; int f8; };
    auto params = [&](int it) -> XP {
        XP x; int r = it; x.dstep = 32; x.f8 = 0; x.mul = 1.f; x.scale = nullptr;
        if (r < I_A) { const int kb = r / 80, nb = r % 80; const int dr = nb * 64; x.W = C.in(8); x.ld = A_IN; x.k0 = kb * 64; x.n0 = dr < 4608 ? dr : dr + 12; x.dst = C.ws + WS_WINA + (size_t)dr * D * 2; x.Kd = D; x.scale = C.in(3); x.mul = dr < 768 ? 0.08838834764831845f : 1.f;
            if (dr >= 3072) { x.f8 = 1; x.mul = 256.f; x.dst = C.ws + WS_WINA + (size_t)3072 * D * 2 + (size_t)(dr - 3072) * D; }
            if (dr >= 1536 && dr < 3072) { x.f8 = 1; x.mul = 256.f; x.dst = C.ws + WS_WINA + (size_t)3072 * D * 2 + (size_t)(2048 + dr - 1536) * D; }
            return x; } r -= I_A;
        if (r < I_O) { const int kb = r / 32, nb = r % 32; x.W = C.in(11); x.ld = D; x.k0 = kb * 64; x.n0 = nb * 64; x.dst = C.ws + WS_WOUTA + (size_t)nb * 64 * D * 2; x.Kd = D; return x; } r -= I_O;
        if (r < I_L) { const int kb = r / 80, nb = r % 80; const int dr0 = nb * 64;
            const bool isk = dr0 < 1536, isv = dr0 >= 1536 && dr0 < 3072, isq = dr0 >= 3072 && dr0 < 4608;
            x.W = (isk || isv) ? C.in(13) : C.in(15); x.ld = (isk || isv) ? 3072 : 2048; x.n0 = (isk || isv) ? dr0 : dr0 - 3072; x.k0 = kb * 64;
            int dr = dr0;
            if (isk || isq) { const int base = isk ? 0 : 3072, loc = dr0 - base, tile = loc >> 8, wc = (loc >> 6) & 3; dr = base + tile * 256 + wc * 32; x.dstep = 128; }
            x.dst = C.ws + WS_WL1 + (size_t)dr * D; x.Kd = D; x.scale = (isk || isv) ? C.in(12) : C.in(3) + D; x.f8 = 1; x.mul = SW8;
            return x; } r -= I_L;
        if (r < I_O) { const int kb = r / 32, nb = r % 32; x.W = C.in(19); x.ld = D; x.k0 = kb * 64; x.n0 = nb * 64; x.dst = C.ws + WS_WOUTB + (size_t)nb * 64 * D; x.Kd = D; x.f8 = 1; x.mul = SWO8; return x; } r -= I_O;
        if (r < 2 * I_M) { const int l = r / I_M, q = r % I_M, kb = q / 16, nb = q % 16; x.W = C.in(5) + (size_t)l * D * 1024; x.ld = 1024; x.k0 = kb * 64; x.n0 = nb * 64; x.dst = C.ws + WS_WMEM + ((size_t)l * 1024 + nb * 64) * D * 2; x.Kd = D; x.scale = C.in(4) + l * D; return x; } r -= 2 * I_M;
        { const int le = r / (2 * I_G + I_D), q = r % (2 * I_G + I_D), l = le >> 5; x.f8 = 1;
          if (q < 2 * I_G) { const int up = q >= I_G, qq = q - up * I_G, kb = qq / 16, nb = qq % 16; const int h0 = nb * 64; const int dr = 256 * (h0 >> 7) + (h0 & 127) + up * 128;
              x.W = (up ? C.in(26) : C.in(25)) + (size_t)le * D * DFF; x.ld = DFF; x.k0 = kb * 64; x.n0 = h0; x.dst = C.ws + WS_WGU + ((size_t)le * 2048 + dr) * D; x.Kd = D; x.scale = C.in(20) + l * D; x.mul = SW8; }
          else { const int qq = q - 2 * I_G, kb = qq / 32, nb = qq % 32; x.W = C.in(27) + (size_t)le * DFF * D; x.ld = D; x.k0 = kb * 64; x.n0 = nb * 64; x.dst = C.ws + WS_WD + ((size_t)le * 2048 + nb * 64) * DFF; x.Kd = DFF; x.mul = SD8; } }
        return x;
    };
    const int kr = lane >> 4, q16 = lane & 15, c8 = lane & 7;
#define XP_LOAD(X, V) do { _Pragma("unroll") for (int i = 0; i < 16; ++i) V[i] = __builtin_nontemporal_load((const f32x4*)(X.W + (size_t)(X.k0 + 4 * i + kr) * X.ld + X.n0 + 4 * q16)); } while (0)
    auto xp_store = [&](const XP& x, const f32x4 (&v)[16]) {
#pragma unroll
        for (int i = 0; i < 16; ++i) { const int k = 4 * i + kr; const float sc = x.scale ? x.scale[x.k0 + k] * x.mul : x.mul; *(LAS f32x4*)(scr + k * 64 + 4 * (q16 ^ ((k >> 3) & 7))) = v[i] * sc; }
        LDS_WAIT(); asm volatile("" ::: "memory");
        if (x.f8) {
#pragma unroll
            for (int j = 0; j < 8; ++j) { const int n = (lane >> 3) + 8 * j; const LAS float* sp = scr + (8 * c8) * 64 + 4 * ((n >> 2) ^ c8) + (n & 3);
                u32x2 o; o.x = gm::pk_fp8x4(sp[0], sp[64], sp[128], sp[192]); o.y = gm::pk_fp8x4(sp[256], sp[320], sp[384], sp[448]);
                *(u32x2*)(x.dst + (size_t)((n & 31) + (n >> 5) * x.dstep) * x.Kd + x.k0 + 8 * c8) = o; }
        } else {
#pragma unroll
            for (int j = 0; j < 8; ++j) { const int n = (lane >> 3) + 8 * j; const LAS float* sp = scr + (8 * c8) * 64 + 4 * ((n >> 2) ^ c8) + (n & 3);
                u32x4 o; o.x = cvtpk(sp[0], sp[64]); o.y = cvtpk(sp[128], sp[192]); o.z = cvtpk(sp[256], sp[320]); o.w = cvtpk(sp[384], sp[448]);
                *(u32x4*)(x.dst + ((size_t)((n & 31) + (n >> 5) * x.dstep) * x.Kd + x.k0 + 8 * c8) * 2) = o; }
        }
        LDS_WAIT(); asm volatile("" ::: "memory");
    };
    if (gw < NITEMS) {
        auto remap = [&](int it) { return it < NITEMS - N_SMALL ? it + N_SMALL : it - (NITEMS - N_SMALL); };
        XP cur = params(remap(gw)); f32x4 v[16]; XP_LOAD(cur, v);
#pragma unroll 1
        for (int it = gw; it < NITEMS; it += NGW) {
            const int nit = it + NGW; const bool hn = nit < NITEMS;
            XP nx = cur; f32x4 w[16];
            if (hn) { nx = params(remap(nit)); XP_LOAD(nx, w); }
            xp_store(cur, v);
            if (hn) { cur = nx;
#pragma unroll
                for (int i = 0; i < 16; ++i) v[i] = w[i]; }
        }
    }
#undef XP_LOAD
}
template <int NBK>
__device__ __forceinline__ void skinny16(const bf16_t* xrows, const bf16_t* whi, const bf16_t* wlo, f32x4 (&acc)[NBK], float& ss, int lane, unsigned char* x8rows = nullptr) {
    const int t = lane & 15, g = lane >> 4;
    const bf16_t* xp = xrows + (size_t)t * D + 16 * g;
    const bf16_t* hp = whi + (size_t)t * D + 16 * g; const bf16_t* lp = wlo + (size_t)t * D + 16 * g;
#pragma unroll
    for (int nb = 0; nb < NBK; ++nb) acc[nb] = (f32x4){0.f, 0.f, 0.f, 0.f};
    float s = 0.f;
#define SK_LOAD(X, S_) do { xa##X = *(const u32x4*)(xp + 64 * (S_)); xc##X = *(const u32x4*)(xp + 64 * (S_) + 8); \
        _Pragma("unroll") for (int nb = 0; nb < NBK; ++nb) { h0##X[nb] = *(const bf16x8*)(hp + (size_t)nb * 16 * D + 64 * (S_)); h1##X[nb] = *(const bf16x8*)(hp + (size_t)nb * 16 * D + 64 * (S_) + 8); \
            l0##X[nb] = *(const bf16x8*)(lp + (size_t)nb * 16 * D + 64 * (S_)); l1##X[nb] = *(const bf16x8*)(lp + (size_t)nb * 16 * D + 64 * (S_) + 8); } } while (0)
#define SK_COMP(X, S_) do { const u32x4 xa = xa##X, xc = xc##X; \
        s += (bflo(xa.x) * bflo(xa.x) + bfhi(xa.x) * bfhi(xa.x)) + (bflo(xa.y) * bflo(xa.y) + bfhi(xa.y) * bfhi(xa.y)) + (bflo(xa.z) * bflo(xa.z) + bfhi(xa.z) * bfhi(xa.z)) + (bflo(xa.w) * bflo(xa.w) + bfhi(xa.w) * bfhi(xa.w)); \
        s += (bflo(xc.x) * bflo(xc.x) + bfhi(xc.x) * bfhi(xc.x)) + (bflo(xc.y) * bflo(xc.y) + bfhi(xc.y) * bfhi(xc.y)) + (bflo(xc.z) * bflo(xc.z) + bfhi(xc.z) * bfhi(xc.z)) + (bflo(xc.w) * bflo(xc.w) + bfhi(xc.w) * bfhi(xc.w)); \
        const bf16x8 fa = __builtin_bit_cast(bf16x8, xa), fc = __builtin_bit_cast(bf16x8, xc); \
        if (x8rows) { u32x4 q8; q8.x = gm::pk_fp8x4(bflo(xa.x) * SX8, bfhi(xa.x) * SX8, bflo(xa.y) * SX8, bfhi(xa.y) * SX8); q8.y = gm::pk_fp8x4(bflo(xa.z) * SX8, bfhi(xa.z) * SX8, bflo(xa.w) * SX8, bfhi(xa.w) * SX8); \
            q8.z = gm::pk_fp8x4(bflo(xc.x) * SX8, bfhi(xc.x) * SX8, bflo(xc.y) * SX8, bfhi(xc.y) * SX8); q8.w = gm::pk_fp8x4(bflo(xc.z) * SX8, bfhi(xc.z) * SX8, bflo(xc.w) * SX8, bfhi(xc.w) * SX8); \
            *(u32x4*)(x8rows + (size_t)t * D + 16 * g + 64 * (S_)) = q8; } \
        _Pragma("unroll") for (int nb = 0; nb < NBK; ++nb) { \
            acc[nb] = __builtin_amdgcn_mfma_f32_16x16x32_bf16(h0##X[nb], fa, acc[nb], 0, 0, 0); acc[nb] = __builtin_amdgcn_mfma_f32_16x16x32_bf16(h1##X[nb], fc, acc[nb], 0, 0, 0); \
            acc[nb] = __builtin_amdgcn_mfma_f32_16x16x32_bf16(l0##X[nb], fa, acc[nb], 0, 0, 0); acc[nb] = __builtin_amdgcn_mfma_f32_16x16x32_bf16(l1##X[nb], fc, acc[nb], 0, 0, 0); } } while (0)
    u32x4 xaA, xcA, xaB, xcB; bf16x8 h0A[NBK], h1A[NBK], l0A[NBK], l1A[NBK], h0B[NBK], h1B[NBK], l0B[NBK], l1B[NBK];
    SK_LOAD(A, 0);
#pragma unroll 1
    for (int S = 0; S < 32; S += 2) {
        SK_LOAD(B, S + 1);
        SK_COMP(A, S);
        if (S + 2 < 32) SK_LOAD(A, S + 2);
        SK_COMP(B, S + 1);
    }
#undef SK_LOAD
#undef SK_COMP
    s += __shfl_xor(s, 16); s += __shfl_xor(s, 32); ss = s;
}
__device__ __forceinline__ void gates_phase(const Ctx& C, int w0, int nw) {
    const bf16_t* xb = WSP(bf16_t, WS_S0); const bf16_t* wg = WSP(bf16_t, WS_MISC + MS_WG); const float* rstd0 = WSP(float, WS_RSTD); float* gates = WSP(float, WS_GATES);
    const int lane = C.lane, t = lane & 15, g = lane >> 4;
    for (int tile = w0; tile < T / 16; tile += nw) {
        f32x4 acc[1]; float ss; skinny16<1>(xb + (size_t)tile * 16 * D, wg, wg + 16 * 2048, acc, ss, lane);
        const int tok = tile * 16 + t; const float rs = rstd0[tok];
        if (g < 3) { f32x4 o;
#pragma unroll
            for (int r = 0; r < 4; ++r) o[r] = acc[0][r] * rs + C.in(9)[4 * g + r];
            *(f32x4*)(gates + (size_t)tok * 16 + 4 * g) = o; }
    }
}
__device__ __forceinline__ void router_logits(const Ctx& C, const bf16_t* xrows, const bf16_t* whi, const bf16_t* wlo, LAS unsigned char* Wb, f32x4 (&acc)[3], float& ss, unsigned char* x8rows) {
    const int lane = C.lane, tid = C.tid, t = lane & 15, g = lane >> 4;
    const bf16_t* xp = xrows + (size_t)t * D + 16 * g;
#pragma unroll
    for (int nb = 0; nb < 3; ++nb) acc[nb] = (f32x4){0.f, 0.f, 0.f, 0.f};
    float s = 0.f;
    u32x4 wreg[6];
#define RL_WLOAD(c_) do { _Pragma("unroll") for (int j = 0; j < 6; ++j) { const int p = tid + 512 * j, hl = p / 1536, rem = p % 1536, n = rem >> 5, q = rem & 31; \
        wreg[j] = *(const u32x4*)((hl ? wlo : whi) + (size_t)n * D + 256 * (c_) + 8 * q); } } while (0)
    RL_WLOAD(0);
#pragma unroll 1
    for (int c = 0; c < 8; ++c) {
        u32x4 xa[4], xc[4];
#pragma unroll
        for (int S = 0; S < 4; ++S) { xa[S] = *(const u32x4*)(xp + 256 * c + 64 * S); xc[S] = *(const u32x4*)(xp + 256 * c + 64 * S + 8); }
        __syncthreads();
#pragma unroll
        for (int j = 0; j < 6; ++j) { const int p = tid + 512 * j, hl = p / 1536, rem = p % 1536, n = rem >> 5, q = rem & 31; *(LAS u32x4*)(Wb + hl * (48 * 528) + n * 528 + q * 16) = wreg[j]; }
        if (c + 1 < 8) RL_WLOAD(c + 1);
        __syncthreads();
#pragma unroll
        for (int S = 0; S < 4; ++S) {
            const u32x4 a = xa[S], b = xc[S];
            s += (bflo(a.x) * bflo(a.x) + bfhi(a.x) * bfhi(a.x)) + (bflo(a.y) * bflo(a.y) + bfhi(a.y) * bfhi(a.y)) + (bflo(a.z) * bflo(a.z) + bfhi(a.z) * bfhi(a.z)) + (bflo(a.w) * bflo(a.w) + bfhi(a.w) * bfhi(a.w));
            s += (bflo(b.x) * bflo(b.x) + bfhi(b.x) * bfhi(b.x)) + (bflo(b.y) * bflo(b.y) + bfhi(b.y) * bfhi(b.y)) + (bflo(b.z) * bflo(b.z) + bfhi(b.z) * bfhi(b.z)) + (bflo(b.w) * bflo(b.w) + bfhi(b.w) * bfhi(b.w));
            const bf16x8 fa = __builtin_bit_cast(bf16x8, a), fc = __builtin_bit_cast(bf16x8, b);
            { u32x4 q8; q8.x = gm::pk_fp8x4(bflo(a.x) * SX8, bfhi(a.x) * SX8, bflo(a.y) * SX8, bfhi(a.y) * SX8); q8.y = gm::pk_fp8x4(bflo(a.z) * SX8, bfhi(a.z) * SX8, bflo(a.w) * SX8, bfhi(a.w) * SX8);
              q8.z = gm::pk_fp8x4(bflo(b.x) * SX8, bfhi(b.x) * SX8, bflo(b.y) * SX8, bfhi(b.y) * SX8); q8.w = gm::pk_fp8x4(bflo(b.z) * SX8, bfhi(b.z) * SX8, bflo(b.w) * SX8, bfhi(b.w) * SX8);
              *(u32x4*)(x8rows + (size_t)t * D + 16 * g + 256 * c + 64 * S) = q8; }
#pragma unroll
            for (int nb = 0; nb < 3; ++nb) { const LAS unsigned char* wp = Wb + (16 * nb + t) * 528 + (64 * S + 16 * g) * 2;
                const bf16x8 h0 = *(const LAS bf16x8*)wp, h1 = *(const LAS bf16x8*)(wp + 16), l0 = *(const LAS bf16x8*)(wp + 48 * 528), l1 = *(const LAS bf16x8*)(wp + 48 * 528 + 16);
                acc[nb] = __builtin_amdgcn_mfma_f32_16x16x32_bf16(h0, fa, acc[nb], 0, 0, 0); acc[nb] = __builtin_amdgcn_mfma_f32_16x16x32_bf16(h1, fc, acc[nb], 0, 0, 0);
                acc[nb] = __builtin_amdgcn_mfma_f32_16x16x32_bf16(l0, fa, acc[nb], 0, 0, 0); acc[nb] = __builtin_amdgcn_mfma_f32_16x16x32_bf16(l1, fc, acc[nb], 0, 0, 0); }
        }
    }
#undef RL_WLOAD
    s += __shfl_xor(s, 16); s += __shfl_xor(s, 32); ss = s;
}
__device__ __forceinline__ void router_phase(const Ctx& C, int layer, const bf16_t* xb, float* rstd_out, int cslot) {
    const bf16_t* whi = WSP(bf16_t, WS_MISC + MS_WR) + (size_t)layer * 2 * 48 * 2048; const bf16_t* wlo = whi + 48 * 2048;
    const float* bg = C.in(22) + layer * NG; const float* be = C.in(24) + layer * NE;
    int* ltok = WSP(int, WS_LIST); float* lw = WSP(float, WS_LIST + 4 * MiB); float* lrs = WSP(float, WS_LIST + 8 * MiB); int* tokslot = WSP(int, WS_LIST + 12 * MiB);
    unsigned* cw = (unsigned*)(C.ws + WS_CTL) + CW_CNT + cslot * 32 * 64;
    LAS float* scr = (LAS float*)(C.lds + C.wave * 3200); LAS int* lcnt = (LAS int*)(C.lds + 25600); LAS int* lbase = lcnt + 32;
    const int lane = C.lane, t = lane & 15, g = lane >> 4;
    for (int tile = C.bid; tile < T / 128; tile += C.G) {
        if (C.tid < 32) lcnt[C.tid] = 0;
        __syncthreads();
        const int tok0 = tile * 128 + C.wave * 16;
        f32x4 acc[3]; float ss; router_logits(C, xb + (size_t)tok0 * D, whi, wlo, C.lds + 26112, acc, ss, C.ws + WS_X8 + (size_t)tok0 * D);
#pragma unroll
        for (int nb = 0; nb < 3; ++nb)
#pragma unroll
            for (int r = 0; r < 4; ++r) scr[t * 49 + 16 * nb + 4 * g + r] = acc[nb][r];
        LDS_WAIT(); asm volatile("" ::: "memory");
        int e1 = 0, e2 = 0, lp1 = 0, lp2 = 0; float w1 = 0.f, w2 = 0.f, rs = 0.f;
        if (lane < 16) {
            rs = 1.0f / sqrtf(ss * (1.f / D) + EPS);
            const LAS float* row = scr + lane * 49;
            float lg0 = row[0] * rs + bg[0], lg1 = row[1] * rs + bg[1], lg2 = row[2] * rs + bg[2], lg3 = row[3] * rs + bg[3];
            int gi = 0; float gm = lg0; if (lg1 > gm) { gm = lg1; gi = 1; } if (lg2 > gm) { gm = lg2; gi = 2; } if (lg3 > gm) { gm = lg3; gi = 3; }
            const float gsum = expf(lg0 - gm) + expf(lg1 - gm) + expf(lg2 - gm) + expf(lg3 - gm); const float gw = 1.0f / gsum;
            float le[8];
#pragma unroll
            for (int i = 0; i < 8; ++i) le[i] = row[4 + 8 * gi + i] * rs + be[8 * gi + i];
            int i1 = 0; float m1 = le[0];
#pragma unroll
            for (int i = 1; i < 8; ++i) if (le[i] > m1) { m1 = le[i]; i1 = i; }
            int i2 = -1; float m2 = -INFINITY;
#pragma unroll
            for (int i = 0; i < 8; ++i) if (i != i1 && le[i] > m2) { m2 = le[i]; i2 = i; }
            const float d = expf(m2 - m1); const float ew1 = 1.0f / (1.0f + d), ew2 = d / (1.0f + d);
            e1 = 8 * gi + i1; e2 = 8 * gi + i2; w1 = gw * ew1; w2 = gw * ew2;
            lp1 = atomicAdd((int*)(lcnt + e1), 1); lp2 = atomicAdd((int*)(lcnt + e2), 1);
            rstd_out[tok0 + lane] = rs;
        }
        __syncthreads();
        if (C.tid < 32) { const int c = lcnt[C.tid]; int b = 0; if (c > 0) b = (int)__hip_atomic_fetch_add(cw + C.tid * 64, (unsigned)c, __ATOMIC_RELAXED, __HIP_MEMORY_SCOPE_AGENT); lbase[C.tid] = b; }
        __syncthreads();
        if (lane < 16) { const int tok = tok0 + lane; const int p1 = lbase[e1] + lp1, p2 = lbase[e2] + lp2;
            ltok[(size_t)e1 * T + p1] = tok; lw[(size_t)e1 * T + p1] = w1; lrs[(size_t)e1 * T + p1] = rs;
            ltok[(size_t)e2 * T + p2] = tok; lw[(size_t)e2 * T + p2] = w2; lrs[(size_t)e2 * T + p2] = rs;
            tokslot[2 * tok] = (e1 << 16) | p1; tokslot[2 * tok + 1] = (e2 << 16) | p2; }
    }
}
template <bool F32OUT>
__device__ __forceinline__ void combine_phase(const Ctx& C, const bf16_t* xold, const bf16_t* yb, bf16_t* xnew, float* rstd_out, float* outf) {
    LAS int* tb = moe_tb(C.lds); const int* tokslot = WSP(int, WS_LIST + 12 * MiB);
    const int gw = C.vcu * 8 + C.wave, NGW = C.G * 8, lane = C.lane;
    int tok = gw; if (tok >= T) return;
    int s0 = tokslot[2 * tok], s1 = tokslot[2 * tok + 1];
#pragma unroll 1
    for (; tok < T; tok += NGW) {
        const size_t r0 = (size_t)tb[s0 >> 16] * 256 + (s0 & 0xffff), r1 = (size_t)tb[s1 >> 16] * 256 + (s1 & 0xffff);
        const u32x4* px = (const u32x4*)(xold + (size_t)tok * D) + lane; const u32x2* p0 = (const u32x2*)((const unsigned char*)yb + r0 * D) + lane; const u32x2* p1 = (const u32x2*)((const unsigned char*)yb + r1 * D) + lane;
        u32x4 a[4]; u32x2 b[4], c[4];
#pragma unroll
        for (int j = 0; j < 4; ++j) { a[j] = px[64 * j]; b[j] = p0[64 * j]; c[j] = p1[64 * j]; }
        const int tn = tok + NGW; if (tn < T) { s0 = tokslot[2 * tn]; s1 = tokslot[2 * tn + 1]; }
        __builtin_amdgcn_sched_barrier(0);
        float ss = 0.f;
#pragma unroll
        for (int j = 0; j < 4; ++j) { float v[8];
            const f32x2 b0 = __builtin_amdgcn_cvt_pk_f32_fp8((int)b[j].x, false), b1 = __builtin_amdgcn_cvt_pk_f32_fp8((int)b[j].x, true), b2 = __builtin_amdgcn_cvt_pk_f32_fp8((int)b[j].y, false), b3 = __builtin_amdgcn_cvt_pk_f32_fp8((int)b[j].y, true);
            const f32x2 c0 = __builtin_amdgcn_cvt_pk_f32_fp8((int)c[j].x, false), c1 = __builtin_amdgcn_cvt_pk_f32_fp8((int)c[j].x, true), c2 = __builtin_amdgcn_cvt_pk_f32_fp8((int)c[j].y, false), c3 = __builtin_amdgcn_cvt_pk_f32_fp8((int)c[j].y, true);
            constexpr float iy = 1.0f / SY8;
            v[0] = bflo(a[j].x) + (b0.x + c0.x) * iy; v[1] = bfhi(a[j].x) + (b0.y + c0.y) * iy; v[2] = bflo(a[j].y) + (b1.x + c1.x) * iy; v[3] = bfhi(a[j].y) + (b1.y + c1.y) * iy;
            v[4] = bflo(a[j].z) + (b2.x + c2.x) * iy; v[5] = bfhi(a[j].z) + (b2.y + c2.y) * iy; v[6] = bflo(a[j].w) + (b3.x + c3.x) * iy; v[7] = bfhi(a[j].w) + (b3.y + c3.y) * iy;
            if (F32OUT) { float* o = outf + (size_t)tok * D + (64 * j + lane) * 8; *(f32x4*)o = (f32x4){v[0], v[1], v[2], v[3]}; *(f32x4*)(o + 4) = (f32x4){v[4], v[5], v[6], v[7]}; }
            else { u32x4 w; w.x = cvtpk(v[0], v[1]); w.y = cvtpk(v[2], v[3]); w.z = cvtpk(v[4], v[5]); w.w = cvtpk(v[6], v[7]);
                ss += (bflo(w.x) * bflo(w.x) + bfhi(w.x) * bfhi(w.x)) + (bflo(w.y) * bflo(w.y) + bfhi(w.y) * bfhi(w.y)) + (bflo(w.z) * bflo(w.z) + bfhi(w.z) * bfhi(w.z)) + (bflo(w.w) * bflo(w.w) + bfhi(w.w) * bfhi(w.w));
                ((u32x4*)(xnew + (size_t)tok * D) + lane)[64 * j] = w;
                u32x2 w8; w8.x = gm::pk_fp8x4(v[0] * SX8, v[1] * SX8, v[2] * SX8, v[3] * SX8); w8.y = gm::pk_fp8x4(v[4] * SX8, v[5] * SX8, v[6] * SX8, v[7] * SX8);
                ((u32x2*)(C.ws + WS_X8 + (size_t)tok * D) + lane)[64 * j] = w8; } }
        if (!F32OUT) { ss = wave_sum(ss); if (lane == 0) rstd_out[tok] = 1.0f / sqrtf(ss * (1.f / D) + EPS); }
    }
}
__device__ __forceinline__ float logsigmoidf(float f) { return fminf(f, 0.f) - log1pf(expf(-fabsf(f))); }
__device__ __forceinline__ float wave_incl_sum(float v, int lane) {
#pragma unroll
    for (int o = 1; o < 64; o <<= 1) { const float t = __shfl_up(v, o); if (lane >= o) v += t; }
    return v;
}
__device__ __forceinline__ float wave_incl_max(float v, int lane) {
#pragma unroll
    for (int o = 1; o < 64; o <<= 1) { const float t = __shfl_up(v, o); if (lane >= o) v = fmaxf(v, t); }
    return v;
}
__device__ __forceinline__ float wave_max(float v) {
#pragma unroll
    for (int o = 1; o < 64; o <<= 1) v = fmaxf(v, __shfl_xor(v, o));
    return v;
}
constexpr int LROW = 272;
__device__ __forceinline__ void mlstm_a(const Ctx& C) {
    const float* gates = WSP(float, WS_GATES); const bf16_t* Kn = WSP(bf16_t, WS_BIG + BG_KN); const bf16_t* VT = WSP(bf16_t, WS_BIG + BG_VT);
    bf16_t* dCT = WSP(bf16_t, WS_BIG + BG_DCT); float* bl = WSP(float, WS_MISC + MS_BL); float* ml = WSP(float, WS_MISC + MS_ML); float* dn = WSP(float, WS_MISC + MS_DN);
    LAS unsigned char* KwT = C.lds; LAS float* wst = (LAS float*)(C.lds + 128 * LROW);
    float* gsa = WSP(float, WS_ROPE); float* gsb = gsa + 24 * LNC * 128; float* gspm = gsb + 24 * LNC * 128;
    const int tid = C.tid, lane = C.lane, wave = C.wave, fr = lane & 15, g = lane >> 4;
    for (int u = C.bid; u < 24 * LNC; u += C.G) {
        const int bh = u >> 6, j = u & 63, b = bh / LH, h = bh % LH; const size_t tok0 = (size_t)b * SEQ + j * LCH;
        if (wave == 0) {
            const float* gp = gates + (tok0 + 2 * lane) * 16;
            const float i0 = gp[h], i1 = gp[16 + h], x0 = logsigmoidf(gp[6 + h]), x1 = logsigmoidf(gp[16 + 6 + h]);
            const float ps = x0 + x1, incl = wave_incl_sum(ps, lane), excl = incl - ps, b0 = excl + x0, b1 = excl + ps;
            const float blast = __shfl(incl, 63);
            const float st0 = blast - b0 + i0, st1 = blast - b1 + i1; const float mloc = wave_max(fmaxf(st0, st1));
            wst[2 * lane] = expf(st0 - mloc); wst[2 * lane + 1] = expf(st1 - mloc);
            if (lane == 0) { bl[u] = blast; ml[u] = mloc; }
            { const float a0 = i0 - b0, a1 = i1 - b1; const float pmx = wave_incl_max(fmaxf(a0, a1), lane); const float pprev = __shfl_up(pmx, 1); const float pm0 = lane > 0 ? fmaxf(pprev, a0) : a0;
              *(f32x2*)(gsa + (size_t)u * 128 + 2 * lane) = (f32x2){a0, a1}; *(f32x2*)(gsb + (size_t)u * 128 + 2 * lane) = (f32x2){b0, b1}; *(f32x2*)(gspm + (size_t)u * 128 + 2 * lane) = (f32x2){pm0, pmx}; }
        }
        __syncthreads();
        { const int s = tid >> 2, dq = tid & 3; const float w = wst[s]; const bf16_t* kp = Kn + (tok0 + s) * 768 + h * 128 + dq * 32;
#pragma unroll
          for (int i = 0; i < 4; ++i) { const u32x4 kv = *(const u32x4*)(kp + 8 * i); const unsigned kw[4] = {kv.x, kv.y, kv.z, kv.w};
#pragma unroll
              for (int q = 0; q < 4; ++q) { const int d = dq * 32 + 8 * i + 2 * q; const unsigned pk = cvtpk(bflo(kw[q]) * w, bfhi(kw[q]) * w);
                  *(LAS unsigned short*)(KwT + d * LROW + s * 2) = (unsigned short)(pk & 0xffffu); *(LAS unsigned short*)(KwT + (d + 1) * LROW + s * 2) = (unsigned short)(pk >> 16); } } }
        __syncthreads();
        if (tid < 128) { float s = 0.f;
#pragma unroll
            for (int i = 0; i < 16; ++i) { const u32x4 v = *(const LAS u32x4*)(KwT + tid * LROW + i * 16); s += (bflo(v.x) + bfhi(v.x)) + (bflo(v.y) + bfhi(v.y)) + (bflo(v.z) + bfhi(v.z)) + (bflo(v.w) + bfhi(v.w)); }
            dn[(size_t)u * 128 + tid] = s; }
        bf16x8 vf[2][4];
#pragma unroll
        for (int vi = 0; vi < 2; ++vi)
#pragma unroll
            for (int ks = 0; ks < 4; ++ks) vf[vi][ks] = *(const bf16x8*)(VT + ((size_t)bh * LDV + 16 * (2 * wave + vi) + fr) * SEQ + j * LCH + 32 * ks + 8 * g);
#pragma unroll
        for (int db = 0; db < 8; ++db) {
            bf16x8 kf[4];
#pragma unroll
            for (int ks = 0; ks < 4; ++ks) kf[ks] = *(const LAS bf16x8*)(KwT + (16 * db + fr) * LROW + (32 * ks + 8 * g) * 2);
#pragma unroll
            for (int vi = 0; vi < 2; ++vi) { f32x4 a = {0.f, 0.f, 0.f, 0.f};
#pragma unroll
                for (int ks = 0; ks < 4; ++ks) a = __builtin_amdgcn_mfma_f32_16x16x32_bf16(kf[ks], vf[vi][ks], a, 0, 0, 0);
                u32x2 w; w.x = cvtpk(a[0], a[1]); w.y = cvtpk(a[2], a[3]);
                *(u32x2*)(dCT + (((size_t)u * LDV) + 16 * (2 * wave + vi) + fr) * 128 + 16 * db + 4 * g) = w; }
        }
        __syncthreads();
    }
}
__device__ __forceinline__ void mlstm_b(const Ctx& C) {
    const bf16_t* dCT = WSP(bf16_t, WS_BIG + BG_DCT); bf16_t* CT = WSP(bf16_t, WS_BIG + BG_CT);
    const float* bl = WSP(float, WS_MISC + MS_BL); const float* ml = WSP(float, WS_MISC + MS_ML); float* mst = WSP(float, WS_MISC + MS_MST);
    const float* dn = WSP(float, WS_MISC + MS_DN); float* nst = WSP(float, WS_MISC + MS_NST);
    LAS float* sdec = (LAS float*)C.lds; LAS float* swg = sdec + 64; LAS float* sbl = sdec + 128; LAS float* sml = sdec + 192;
    const int tid = C.tid;
    for (int blk = C.vcu; blk < 24 * 8; blk += C.G) {
        const int bh = blk >> 3;
        if (tid < 64) { sbl[tid] = bl[bh * LNC + tid]; sml[tid] = ml[bh * LNC + tid]; }
        __syncthreads();
        if (tid == 0) { float m = 0.f;
            for (int j = 0; j < LNC; ++j) { if ((blk & 7) == 0) mst[bh * LNC + j] = m; const float mn = fmaxf(sbl[j] + m, sml[j]); sdec[j] = expf(sbl[j] + m - mn); swg[j] = expf(sml[j] - mn); m = mn; } }
        __syncthreads();
        const size_t base = (size_t)bh * LNC * 4096 + (blk & 7) * 512 + tid;
        float c[8] = {0.f, 0.f, 0.f, 0.f, 0.f, 0.f, 0.f, 0.f};
        u32x4 dr[8];
#pragma unroll
        for (int i = 0; i < 8; ++i) dr[i] = *((const u32x4*)dCT + base + (size_t)i * 4096);
#pragma unroll 1
        for (int j0 = 0; j0 < LNC; j0 += 8) {
#pragma unroll
            for (int i = 0; i < 8; ++i) { const int j = j0 + i; const u32x4 dv = dr[i];
                if (j + 8 < LNC) dr[i] = *((const u32x4*)dCT + base + (size_t)(j + 8) * 4096);
                u32x4 o; o.x = cvtpk(c[0], c[1]); o.y = cvtpk(c[2], c[3]); o.z = cvtpk(c[4], c[5]); o.w = cvtpk(c[6], c[7]);
                *((u32x4*)CT + base + (size_t)j * 4096) = o;
                const float dec = sdec[j], wg = swg[j];
                c[0] = dec * c[0] + wg * bflo(dv.x); c[1] = dec * c[1] + wg * bfhi(dv.x); c[2] = dec * c[2] + wg * bflo(dv.y); c[3] = dec * c[3] + wg * bfhi(dv.y);
                c[4] = dec * c[4] + wg * bflo(dv.z); c[5] = dec * c[5] + wg * bfhi(dv.z); c[6] = dec * c[6] + wg * bflo(dv.w); c[7] = dec * c[7] + wg * bfhi(dv.w); }
        }
        if (tid < 16) { const int d = (blk & 7) * 16 + tid; float n = 0.f; const float* dp = dn + (size_t)bh * LNC * 128 + d; float* np = nst + (size_t)bh * LNC * 128 + d;
            float dq[16];
#pragma unroll
            for (int i = 0; i < 16; ++i) dq[i] = dp[(size_t)i * 128];
#pragma unroll 1
            for (int j0 = 0; j0 < LNC; j0 += 16) {
#pragma unroll
                for (int i = 0; i < 16; ++i) { const int j = j0 + i; const float dv = dq[i]; if (j + 16 < LNC) dq[i] = dp[(size_t)(j + 16) * 128]; np[(size_t)j * 128] = n; n = sdec[j] * n + swg[j] * dv; } } }
        __syncthreads();
    }
}
__device__ __forceinline__ void mlstm_c(const Ctx& C) {
    const bf16_t* Qn = WSP(bf16_t, WS_BIG + BG_QN); const bf16_t* Kn = WSP(bf16_t, WS_BIG + BG_KN); const bf16_t* VT = WSP(bf16_t, WS_BIG + BG_VT);
    const bf16_t* On = WSP(bf16_t, WS_BIG + BG_ON); const bf16_t* CT = WSP(bf16_t, WS_BIG + BG_CT); const float* mst = WSP(float, WS_MISC + MS_MST); const float* nst = WSP(float, WS_MISC + MS_NST);
    bf16_t* cat = WSP(bf16_t, WS_S1); const float* gsa = WSP(float, WS_ROPE); const float* gsb = gsa + 24 * LNC * 128; const float* gspm = gsb + 24 * LNC * 128;
    LAS unsigned char* VTs = C.lds; LAS unsigned char* CTs = C.lds + 256 * LROW; LAS float* sa = (LAS float*)(C.lds + 512 * LROW); LAS float* sb = sa + 128; LAS float* spm = sb + 128; LAS float* sn = spm + 128;
    const int tid = C.tid, lane = C.lane, wave = C.wave, fr = lane & 15, g = lane >> 4;
    for (int u = C.bid; u < 24 * LNC; u += C.G) {
        const int bh = u >> 6, j = u & 63, b = bh / LH, h = bh % LH; const size_t tok0 = (size_t)b * SEQ + j * LCH;
        { const int q = tid >> 7, e = tid & 127; const float* src = q == 0 ? gsa : q == 1 ? gsb : q == 2 ? gspm : nst; LAS float* dst = q == 0 ? sa : q == 1 ? sb : q == 2 ? spm : sn;
          const int v = tid >> 1, hf = tid & 1; const bf16_t* vp = VT + ((size_t)bh * LDV + v) * SEQ + j * LCH + hf * 64; const bf16_t* cq = CT + ((size_t)u * LDV + v) * 128 + hf * 64;
          const float sv = src[(size_t)u * 128 + e]; u32x4 cc[8], vv[8];
#pragma unroll
          for (int i = 0; i < 8; ++i) { vv[i] = *(const u32x4*)(vp + 8 * i); cc[i] = *(const u32x4*)(cq + 8 * i); }
          __builtin_amdgcn_sched_barrier(0);
          dst[e] = sv;
#pragma unroll
          for (int i = 0; i < 8; ++i) { *(LAS u32x4*)(VTs + v * LROW + (hf * 64 + 8 * i) * 2) = vv[i]; *(LAS u32x4*)(CTs + v * LROW + (hf * 64 + 8 * i) * 2) = cc[i]; } }
        __syncthreads();
        {
            const int t = 16 * wave + fr; const size_t tok = tok0 + t;
            const float mprev = mst[u]; const float Mt = fmaxf(mprev, spm[t]); const float bt = sb[t]; const float winter = expf(mprev - Mt); const float mt = bt + Mt;
            bf16x8 bq[4]; float qn = 0.f;
#pragma unroll
            for (int ks = 0; ks < 4; ++ks) { const u32x4 qv = *(const u32x4*)(Qn + tok * 768 + h * 128 + 32 * ks + 8 * g); bq[ks] = __builtin_bit_cast(bf16x8, qv);
                const LAS float* np = sn + 32 * ks + 8 * g;
                qn += bflo(qv.x) * np[0] + bfhi(qv.x) * np[1] + bflo(qv.y) * np[2] + bfhi(qv.y) * np[3] + bflo(qv.z) * np[4] + bfhi(qv.z) * np[5] + bflo(qv.w) * np[6] + bfhi(qv.w) * np[7]; }
            qn += __shfl_xor(qn, 16); qn += __shfl_xor(qn, 32);
            f32x4 acc[16];
#pragma unroll
            for (int vb = 0; vb < 16; ++vb) { f32x4 a = {0.f, 0.f, 0.f, 0.f};
#pragma unroll
                for (int ks = 0; ks < 4; ++ks) { const bf16x8 cf = *(const LAS bf16x8*)(CTs + (16 * vb + fr) * LROW + (32 * ks + 8 * g) * 2); a = __builtin_amdgcn_mfma_f32_16x16x32_bf16(cf, bq[ks], a, 0, 0, 0); }
                acc[vb] = a * winter; if ((vb & 3) == 3) asm volatile("" ::: "memory"); }
            f32x4 sw[8]; float den = 0.f;
#pragma unroll
            for (int kh = 0; kh < 2; ++kh) {
                bf16x8 kfr[4][4];
#pragma unroll
                for (int k4 = 0; k4 < 4; ++k4) if (kh * 4 + k4 <= wave) {
#pragma unroll
                    for (int ks = 0; ks < 4; ++ks) kfr[k4][ks] = *(const bf16x8*)(Kn + (tok0 + 16 * (kh * 4 + k4) + fr) * 768 + h * 128 + 32 * ks + 8 * g); }
                __builtin_amdgcn_sched_barrier(0);
#pragma unroll
                for (int k4 = 0; k4 < 4; ++k4) { const int kb = kh * 4 + k4;
                    f32x4 s = {0.f, 0.f, 0.f, 0.f};
                    if (kb <= wave) {
#pragma unroll
                        for (int ks = 0; ks < 4; ++ks) s = __builtin_amdgcn_mfma_f32_16x16x32_bf16(kfr[k4][ks], bq[ks], s, 0, 0, 0);
                        const f32x4 av = *(const LAS f32x4*)(sa + 16 * kb + 4 * g);
#pragma unroll
                        for (int r = 0; r < 4; ++r) { const int sidx = 16 * kb + 4 * g + r; const float wgt = sidx <= t ? expf(av[r] - Mt) : 0.f; s[r] *= wgt; den += s[r]; }
                    }
                    sw[kb] = s; }
                __builtin_amdgcn_sched_barrier(0);
            }
            den += __shfl_xor(den, 16); den += __shfl_xor(den, 32);
            den += winter * qn;
#pragma unroll
            for (int kp = 0; kp < 4; ++kp) {
                if (2 * kp <= wave) {
                    u32x4 pw; pw.x = cvtpk(sw[2 * kp][0], sw[2 * kp][1]); pw.y = cvtpk(sw[2 * kp][2], sw[2 * kp][3]); pw.z = cvtpk(sw[2 * kp + 1][0], sw[2 * kp + 1][1]); pw.w = cvtpk(sw[2 * kp + 1][2], sw[2 * kp + 1][3]);
                    const bf16x8 pb = __builtin_bit_cast(bf16x8, pw);
#pragma unroll
                    for (int vb = 0; vb < 16; ++vb) { const LAS unsigned char* vp = VTs + (16 * vb + fr) * LROW + (32 * kp + 4 * g) * 2;
                        u32x4 vw; const u32x2 lo = *(const LAS u32x2*)vp, hi = *(const LAS u32x2*)(vp + 32); vw.x = lo.x; vw.y = lo.y; vw.z = hi.x; vw.w = hi.y;
                        acc[vb] = __builtin_amdgcn_mfma_f32_16x16x32_bf16(__builtin_bit_cast(bf16x8, vw), pb, acc[vb], 0, 0, 0); }
                }
            }
            const float dinv = 1.0f / fmaxf(fabsf(den), expf(-mt));
            float ss = 0.f;
#pragma unroll
            for (int vb = 0; vb < 16; ++vb) { acc[vb] = acc[vb] * dinv; ss += (acc[vb][0] * acc[vb][0] + acc[vb][1] * acc[vb][1]) + (acc[vb][2] * acc[vb][2] + acc[vb][3] * acc[vb][3]); }
            ss += __shfl_xor(ss, 16); ss += __shfl_xor(ss, 32);
            const float rn = 1.0f / sqrtf(ss * (1.f / LDV) + EPS);
#pragma unroll
            for (int hv = 0; hv < 2; ++hv) {
                f32x4 gnv[8]; u32x2 owv[8];
#pragma unroll
                for (int i = 0; i < 8; ++i) { const int v = 16 * (hv * 8 + i) + 4 * g; gnv[i] = *(const f32x4*)(C.in(10) + h * LDV + v); owv[i] = *(const u32x2*)(On + tok * 1536 + h * LDV + v); }
                __builtin_amdgcn_sched_barrier(0);
#pragma unroll
                for (int i = 0; i < 8; ++i) { const int vb = hv * 8 + i; const int v = 16 * vb + 4 * g; const f32x4 gn = gnv[i]; const u32x2 ow = owv[i];
                    const f32x4 o = {acc[vb][0] * rn * gn[0] * bflo(ow.x), acc[vb][1] * rn * gn[1] * bfhi(ow.x), acc[vb][2] * rn * gn[2] * bflo(ow.y), acc[vb][3] * rn * gn[3] * bfhi(ow.y)};
                    u32x2 w; w.x = cvtpk(o[0], o[1]); w.y = cvtpk(o[2], o[3]);
                    *(u32x2*)(cat + tok * D + h * LDV + v) = w; }
            }
        }
        __syncthreads();
    }
}
constexpr int VROW = 528;
__device__ __forceinline__ void memattn_phase(const Ctx& C, int layer, const bf16_t* MQ, bf16_t* cat) {
    const float* mkv = WSP(float, WS_MEMKV) + (size_t)layer * 1024 * 1024; const float* qgain = C.in(6) + layer * MEMHD; const float* kgain = C.in(7) + layer * MEMHD;
    LAS unsigned char* Kms = C.lds; LAS unsigned char* VTm = C.lds + 256 * LROW;
    const int tid = C.tid, lane = C.lane, wave = C.wave, fr = lane & 15, g = lane >> 4;
    for (int u = C.bid; u < 256; u += C.G) {
        const int b = u >> 6, hh = (u >> 4) & 3, qc = u & 15;
        { const int slot = tid >> 1, hf = tid & 1; const float* kp = mkv + ((size_t)b * MEMS + slot) * 1024 + hh * MEMHD + hf * 64; const float* vp = kp + MEMW;
          f32x4 kv[16], vv[16]; float ss = 0.f;
#pragma unroll
          for (int i = 0; i < 16; ++i) { kv[i] = *(const f32x4*)(kp + 4 * i); vv[i] = *(const f32x4*)(vp + 4 * i); }
          __builtin_amdgcn_sched_barrier(0);
#pragma unroll
          for (int i = 0; i < 16; ++i) ss += (kv[i][0] * kv[i][0] + kv[i][1] * kv[i][1]) + (kv[i][2] * kv[i][2] + kv[i][3] * kv[i][3]);
          ss += __shfl_xor(ss, 1); const float rn = 1.0f / sqrtf(ss * (1.f / MEMHD) + EPS);
#pragma unroll
          for (int i = 0; i < 8; ++i) { const f32x4 g0 = *(const f32x4*)(kgain + hf * 64 + 8 * i), g1 = *(const f32x4*)(kgain + hf * 64 + 8 * i + 4);
              const f32x4 a = kv[2 * i] * rn * g0, c = kv[2 * i + 1] * rn * g1;
              u32x4 w; w.x = cvtpk(a[0], a[1]); w.y = cvtpk(a[2], a[3]); w.z = cvtpk(c[0], c[1]); w.w = cvtpk(c[2], c[3]);
              *(LAS u32x4*)(Kms + slot * LROW + (hf * 64 + 8 * i) * 2) = w; }
#pragma unroll
          for (int i = 0; i < 16; ++i) {
#pragma unroll
              for (int q = 0; q < 4; ++q) *(LAS unsigned short*)(VTm + (hf * 64 + 4 * i + q) * VROW + slot * 2) = f2bf(vv[i][q]); } }
        __syncthreads();
#pragma unroll 1
        for (int it = 0; it < 4; ++it) {
            const size_t tok = (size_t)b * SEQ + qc * 512 + wave * 64 + it * 16 + fr;
            u32x4 qv[4]; float ss = 0.f;
#pragma unroll
            for (int ks = 0; ks < 4; ++ks) { qv[ks] = *(const u32x4*)(MQ + tok * MEMW + hh * MEMHD + 32 * ks + 8 * g);
                ss += (bflo(qv[ks].x) * bflo(qv[ks].x) + bfhi(qv[ks].x) * bfhi(qv[ks].x)) + (bflo(qv[ks].y) * bflo(qv[ks].y) + bfhi(qv[ks].y) * bfhi(qv[ks].y))
                    + (bflo(qv[ks].z) * bflo(qv[ks].z) + bfhi(qv[ks].z) * bfhi(qv[ks].z)) + (bflo(qv[ks].w) * bflo(qv[ks].w) + bfhi(qv[ks].w) * bfhi(qv[ks].w)); }
            ss += __shfl_xor(ss, 16); ss += __shfl_xor(ss, 32);
            const float qs = (1.0f / sqrtf(ss * (1.f / MEMHD) + EPS)) * (0.08838834764831845f * LOG2E);
            bf16x8 bq[4];
#pragma unroll
            for (int ks = 0; ks < 4; ++ks) { const f32x4 g0 = *(const f32x4*)(qgain + 32 * ks + 8 * g), g1 = *(const f32x4*)(qgain + 32 * ks + 8 * g + 4); u32x4 w;
                w.x = cvtpk(bflo(qv[ks].x) * qs * g0[0], bfhi(qv[ks].x) * qs * g0[1]); w.y = cvtpk(bflo(qv[ks].y) * qs * g0[2], bfhi(qv[ks].y) * qs * g0[3]);
                w.z = cvtpk(bflo(qv[ks].z) * qs * g1[0], bfhi(qv[ks].z) * qs * g1[1]); w.w = cvtpk(bflo(qv[ks].w) * qs * g1[2], bfhi(qv[ks].w) * qs * g1[3]);
                bq[ks] = __builtin_bit_cast(bf16x8, w); }
            f32x4 sacc[16]; float mx = -INFINITY;
#pragma unroll
            for (int kb = 0; kb < 16; ++kb) { f32x4 s = {0.f, 0.f, 0.f, 0.f};
#pragma unroll
                for (int ks = 0; ks < 4; ++ks) { const bf16x8 kf = *(const LAS bf16x8*)(Kms + (16 * kb + fr) * LROW + (32 * ks + 8 * g) * 2); s = __builtin_amdgcn_mfma_f32_16x16x32_bf16(kf, bq[ks], s, 0, 0, 0); }
                sacc[kb] = s; mx = fmaxf(fmaxf(mx, fmaxf(s[0], s[1])), fmaxf(s[2], s[3])); asm volatile("" ::: "memory"); }
            mx = fmaxf(mx, __shfl_xor(mx, 16)); mx = fmaxf(mx, __shfl_xor(mx, 32));
            float sum = 0.f;
#pragma unroll
            for (int kb = 0; kb < 16; ++kb) {
#pragma unroll
                for (int r = 0; r < 4; ++r) { sacc[kb][r] = __builtin_amdgcn_exp2f(sacc[kb][r] - mx); sum += sacc[kb][r]; } }
            sum += __shfl_xor(sum, 16); sum += __shfl_xor(sum, 32);
            f32x4 oacc[8];
#pragma unroll
            for (int db = 0; db < 8; ++db) oacc[db] = (f32x4){0.f, 0.f, 0.f, 0.f};
#pragma unroll
            for (int kp = 0; kp < 8; ++kp) {
                u32x4 pw; pw.x = cvtpk(sacc[2 * kp][0], sacc[2 * kp][1]); pw.y = cvtpk(sacc[2 * kp][2], sacc[2 * kp][3]); pw.z = cvtpk(sacc[2 * kp + 1][0], sacc[2 * kp + 1][1]); pw.w = cvtpk(sacc[2 * kp + 1][2], sacc[2 * kp + 1][3]);
                const bf16x8 pb = __builtin_bit_cast(bf16x8, pw);
#pragma unroll
                for (int db = 0; db < 8; ++db) { const LAS unsigned char* vp = VTm + (16 * db + fr) * VROW + (32 * kp + 4 * g) * 2;
                    u32x4 vw; const u32x2 lo = *(const LAS u32x2*)vp, hi = *(const LAS u32x2*)(vp + 32); vw.x = lo.x; vw.y = lo.y; vw.z = hi.x; vw.w = hi.y;
                    oacc[db] = __builtin_amdgcn_mfma_f32_16x16x32_bf16(__builtin_bit_cast(bf16x8, vw), pb, oacc[db], 0, 0, 0); }
                asm volatile("" ::: "memory");
            }
            const float inv = 1.0f / sum;
#pragma unroll
            for (int db = 0; db < 8; ++db) { u32x2 w; w.x = cvtpk(oacc[db][0] * inv, oacc[db][1] * inv); w.y = cvtpk(oacc[db][2] * inv, oacc[db][3] * inv);
                if (layer == 1) *(unsigned*)((unsigned char*)cat + tok * D + 1536 + hh * MEMHD + 16 * db + 4 * g) = gm::pk_fp8x4(oacc[db][0] * inv * SC8, oacc[db][1] * inv * SC8, oacc[db][2] * inv * SC8, oacc[db][3] * inv * SC8);
                else *(u32x2*)(cat + tok * D + 1536 + hh * MEMHD + 16 * db + 4 * g) = w; }
        }
        __syncthreads();
    }
}
#include <hip/hip_bf16.h>
#include <cmath>
namespace attn_body {
using bf16=__hip_bfloat16;
using bf16x8=__attribute__((ext_vector_type(8)))short;
using s16x4=__attribute__((ext_vector_type(4)))short;
using f32x16=__attribute__((ext_vector_type(16)))float;
using u32x4=__attribute__((ext_vector_type(4)))unsigned;
constexpr int BATCH=4,NHEAD=12,SEQ=8192,D=64,DM=1536;
constexpr int NW=8,QBLK=32,QB=QBLK*NW,KVBLK=64,NQB=SEQ/QB;
constexpr int ATTN_PITCH=DM, ATTN_UNIT_ROWS=QB;
__device__ __forceinline__ int crow(int r,int hi){return (r&3)+8*(r>>2)+4*hi;}
#define SBAR() __builtin_amdgcn_sched_barrier(0)
__device__ __forceinline__ void cmask(f32x16&p0,f32x16&p1,int jb,int qrel,int hi){
  const float NEG=-INFINITY; int kb=64*jb+4*hi;
  #pragma unroll
  for(int r=0;r<16;++r){int kv=kb+(r&3)+8*(r>>2); if(kv>qrel)p0[r]=NEG; if(kv+32>qrel)p1[r]=NEG;}
}

constexpr int NSLOT=3, SLOTB=8192;
constexpr int LDS_K=0, LDS_V=NSLOT*SLOTB, LDS_WS=2*NSLOT*SLOTB, LDS_OST=LDS_WS+NW*64*4, LDS_BYTES=LDS_OST+NW*4096;
constexpr float C2=0.125f*1.4426950408889634f;
__device__ __forceinline__ void glds16(const void*gsrc,unsigned lds_dst){unsigned keep;
  asm volatile("s_mov_b32 %0, m0\n\ts_mov_b32 m0, %2\n\ts_nop 0\n\tglobal_load_lds_dwordx4 %1, off\n\ts_mov_b32 m0, %0":"=&s"(keep):"v"(gsrc),"s"(lds_dst):"memory");}
__device__ __forceinline__ float max3f(float a,float b,float c){float r;asm("v_max3_f32 %0, %1, %2, %3":"=v"(r):"v"(a),"v"(b),"v"(c));return r;}
__device__ __forceinline__ float max2f(float a,float b){float r;asm("v_max_f32_e32 %0, %1, %2":"=v"(r):"v"(a),"v"(b));return r;}
__device__ __forceinline__ float fadd_s(float a,float b){float r;asm("v_add_f32_e32 %0, %1, %2":"=v"(r):"v"(a),"v"(b));return r;}
__device__ __forceinline__ float fsub_s(float a,float b){float r;asm("v_sub_f32_e32 %0, %1, %2":"=v"(r):"v"(a),"v"(b));return r;}
typedef float f32x2_t __attribute__((ext_vector_type(2))); typedef __bf16 bf16x2_t __attribute__((ext_vector_type(2)));
__device__ __forceinline__ unsigned cvtpk_s(float lo,float hi){f32x2_t v={lo,hi};bf16x2_t b=__builtin_convertvector(v,bf16x2_t);return __builtin_bit_cast(unsigned,b);}
#define WAIT_BAR(N) asm volatile("s_waitcnt vmcnt(" #N ") lgkmcnt(0)\n\ts_barrier":::"memory")

__device__ __forceinline__ void qkt(f32x16&p0,f32x16&p1,const char*Kslot,const bf16x8*qr,const f32x16&negm,int r32,int hi){
  const char*kb=Kslot+hi*1024+r32*16;
  #pragma unroll
  for(int d0=0;d0<4;++d0){
    const bf16x8 b0=*reinterpret_cast<const bf16x8*>(kb+d0*2048);
    const bf16x8 b1=*reinterpret_cast<const bf16x8*>(kb+d0*2048+512);
    if(d0==0){p0=__builtin_amdgcn_mfma_f32_32x32x16_bf16(b0,qr[0],negm,0,0,0);p1=__builtin_amdgcn_mfma_f32_32x32x16_bf16(b1,qr[0],negm,0,0,0);}
    else{p0=__builtin_amdgcn_mfma_f32_32x32x16_bf16(b0,qr[d0],p0,0,0,0);p1=__builtin_amdgcn_mfma_f32_32x32x16_bf16(b1,qr[d0],p1,0,0,0);}}
}
typedef __attribute__((address_space(3))) const char* lds_cptr;
typedef short v4i16_t __attribute__((ext_vector_type(4)));
__device__ __forceinline__ void kload8(bf16x8*kf,lds_cptr kp){
  kf[0]=*(const __attribute__((address_space(3))) bf16x8*)(kp);      kf[1]=*(const __attribute__((address_space(3))) bf16x8*)(kp+512);
  kf[2]=*(const __attribute__((address_space(3))) bf16x8*)(kp+2048); kf[3]=*(const __attribute__((address_space(3))) bf16x8*)(kp+2560);
  kf[4]=*(const __attribute__((address_space(3))) bf16x8*)(kp+4096); kf[5]=*(const __attribute__((address_space(3))) bf16x8*)(kp+4608);
  kf[6]=*(const __attribute__((address_space(3))) bf16x8*)(kp+6144); kf[7]=*(const __attribute__((address_space(3))) bf16x8*)(kp+6656);
}
__device__ __forceinline__ void kload2(bf16x8*kf,lds_cptr kp,int j){ kf[2*j]=*(const __attribute__((address_space(3))) bf16x8*)(kp+j*2048); kf[2*j+1]=*(const __attribute__((address_space(3))) bf16x8*)(kp+j*2048+512); }
__device__ __forceinline__ s16x4 vtr(lds_cptr p){ return __builtin_bit_cast(s16x4,__builtin_amdgcn_ds_read_tr16_b64_v4i16((__attribute__((address_space(3))) v4i16_t*)p)); }
__device__ __forceinline__ float rowmax(const f32x16&p0,const f32x16&p1){
  float a=max3f(p0[0],p0[1],p1[0]),b=max3f(p0[2],p0[3],p1[1]);a=max3f(a,p1[2],p1[3]);
  #pragma unroll
  for(int r=4;r<16;r+=4){a=max3f(a,p0[r],p0[r+1]);b=max3f(b,p0[r+2],p0[r+3]);a=max3f(a,p1[r],p1[r+1]);b=max3f(b,p1[r+2],p1[r+3]);}
  const float m=max2f(a,b);
  auto rr=__builtin_amdgcn_permlane32_swap(__float_as_uint(m),__float_as_uint(m),false,false);
  return max2f(__uint_as_float(rr[0]),__uint_as_float(rr[1]));
}
__device__ __forceinline__ void pv(f32x16*o,int vb,bf16x8 pa0,bf16x8 pa1,bf16x8 pa2,bf16x8 pa3){
  #pragma unroll
  for(int d0=0;d0<2;++d0){s16x4 lo[4],hi[4];
    #pragma unroll
    for(int ks=0;ks<4;++ks){
      asm volatile("ds_read_b64_tr_b16 %0,%1 offset:%c2":"=&v"(lo[ks]):"v"(vb),"i"(d0*4096+ks*1024):"memory");
      asm volatile("ds_read_b64_tr_b16 %0,%1 offset:%c2":"=&v"(hi[ks]):"v"(vb),"i"(d0*4096+ks*1024+512):"memory");}
    asm volatile("s_waitcnt lgkmcnt(0)":::"memory");SBAR();
    #define PK(k) (bf16x8){lo[k][0],lo[k][1],lo[k][2],lo[k][3],hi[k][0],hi[k][1],hi[k][2],hi[k][3]}
    o[d0]=__builtin_amdgcn_mfma_f32_32x32x16_bf16(pa0,PK(0),o[d0],0,0,0);
    o[d0]=__builtin_amdgcn_mfma_f32_32x32x16_bf16(pa1,PK(1),o[d0],0,0,0);
    o[d0]=__builtin_amdgcn_mfma_f32_32x32x16_bf16(pa2,PK(2),o[d0],0,0,0);
    o[d0]=__builtin_amdgcn_mfma_f32_32x32x16_bf16(pa3,PK(3),o[d0],0,0,0);
    #undef PK
  }
}

#ifndef ATTN_STORE16
#define ATTN_STORE16(p,v) (*(u32x4*)(p)=(v))
#endif
template<int THRL> __device__ __forceinline__ void attn_unit(int b,int qcol,int vcol,int qb,const bf16*Q,const bf16*__restrict__ K,const bf16*__restrict__ V,bf16*O,char*shm){
  const int tid=threadIdx.x,lane=tid&63,r32=lane&31,hi=lane>>5; const int wid=__builtin_amdgcn_readfirstlane(tid>>6);
  const long rowbase=(long)b*SEQ; const int q0=qb*QB;
  const bf16*Qw=Q+(rowbase+q0+wid*QBLK)*DM+qcol;
  const bf16*Kh=K+rowbase*DM+qcol,*Vh=V+rowbase*DM+vcol;
  const unsigned lds0=(unsigned)(uintptr_t)shm;
  float*wsf=(float*)(shm+LDS_WS)+wid*64;
  const bf16*ksrc=Kh+(long)lane*DM+wid*8;
  const bf16*vsrc=Vh+(long)(16*(wid&3)+(lane>>2))*DM+(wid>>2)*32+(lane&3)*8;
  const unsigned kdst=lds0+LDS_K+wid*1024, vdst=lds0+LDS_V+wid*1024;
  #define DMA_K(t,slot) glds16(ksrc+(long)(t)*KVBLK*DM,(unsigned)__builtin_amdgcn_readfirstlane(kdst+(slot)))
  #define DMA_V(t,slot) glds16(vsrc+(long)(t)*KVBLK*DM,(unsigned)__builtin_amdgcn_readfirstlane(vdst+(slot)))
  const int vb0=(int)(lds0+LDS_V)+((lane>>4)&1)*32+(lane&3)*8+(4*hi+((lane&15)>>2))*64;
  const char*Kbase=shm+LDS_K; bf16x8 kf[8];
  const lds_cptr shm3=(lds_cptr)shm; const lds_cptr kp0=shm3+LDS_K+hi*1024+r32*16; const lds_cptr vp0=shm3+LDS_V+((lane>>4)&1)*32+(lane&3)*8+(4*hi+((lane&15)>>2))*64;
  const int NT=(q0+QB)/KVBLK;
  DMA_K(0,0);DMA_V(0,0);DMA_K(1,SLOTB);
  bf16x8 qr[4];
  #pragma unroll
  for(int d0=0;d0<4;++d0)qr[d0]=*reinterpret_cast<const bf16x8*>(&Qw[(long)r32*DM+d0*16+hi*8]);
  float mhat=0.f,l_reg=0.f;f32x16 o[2];o[0]=f32x16{};o[1]=f32x16{};f32x16 negm=f32x16{};asm volatile("":"+v"(negm));
  const int qrel=wid*QBLK+r32;
  #define CMASK(P0,P1,t) do{int jb_=(t)-(NT-4); if(jb_>=0)cmask(P0,P1,jb_,qrel,hi);}while(0)
  bool resc=false;
  #define START(P0,P1) do{ const float rm=rowmax(P0,P1); resc=false; \
    { const float dl=rm; mhat=fadd_s(mhat,dl); \
      _Pragma("unroll") for(int r=0;r<16;++r){P0[r]=fsub_s(P0[r],dl);P1[r]=fsub_s(P1[r],dl);} \
      _Pragma("unroll") for(int r=0;r<16;++r)negm[r]=-mhat; asm volatile("":"+v"(negm)); } \
    _Pragma("unroll") for(int r=0;r<16;++r)P0[r]=__builtin_amdgcn_exp2f(P0[r]); }while(0)
  #define RESC() do{ if(resc){ asm volatile("s_waitcnt lgkmcnt(0)":::"memory"); \
      _Pragma("unroll") for(int d_=0;d_<2;++d_) _Pragma("unroll") for(int r=0;r<16;++r)o[d_][r]*=wsf[crow(r,hi)]; } }while(0)
  f32x16 pA0,pA1,pB0,pB1;
  int sl_prev=0,sl_cur=0,sl_next=SLOTB;
  #define ROT() do{sl_prev=sl_cur;sl_cur=sl_next;sl_next=(sl_next==(NSLOT-1)*SLOTB)?0:sl_next+SLOTB;}while(0)
  DMA_K(2,2*SLOTB);
  WAIT_BAR(3);
  qkt(pA0,pA1,Kbase,qr,negm,r32,hi);asm volatile("s_nop 15\n\ts_nop 7":"+v"(pA0),"+v"(pA1));CMASK(pA0,pA1,0);
  START(pA0,pA1);
  _Pragma("unroll") for(int r=0;r<16;++r)pA1[r]=__builtin_amdgcn_exp2f(pA1[r]);
  WAIT_BAR(0);
  DMA_K(3,0);DMA_V(1,SLOTB);
  ROT();
  kload8(kf,kp0+sl_cur);
  WAIT_BAR(2);
  s16x4 vlo[8],vhi[8]; u32x4 pw0,pw1,pw2,pw3;
  #define PKW(P,B) cvtpk_s(P[B],P[B+1])
  #define PAF(k) __builtin_bit_cast(bf16x8,pw##k)
  #define VFR(i) (bf16x8){vlo[i][0],vlo[i][1],vlo[i][2],vlo[i][3],vhi[i][0],vhi[i][1],vhi[i][2],vhi[i][3]}
  #define PIN(x) asm volatile("":"+v"(x))
  #define MX3(a,b,c) __builtin_fmaxf(__builtin_fmaxf((a),(b)),(c))
  #define GAPA(MF,A0,A1,A2,A3,W0,W1,PW) do{ MF; sacc+=A0; sacc+=A1; sacc+=A2; sacc+=A3; PIN(sacc); W0; W1; PIN(PW); SBAR(); }while(0)
  #define EX(v) __builtin_amdgcn_exp2f(v)
  #define GAPB(MF,X,B) do{ MF; X[B]=EX(X[B]); X[B+1]=EX(X[B+1]); X[B+2]=EX(X[B+2]); X[B+3]=EX(X[B+3]); PIN(X); SBAR(); }while(0)
  #define VRD(i) do{ vlo[i]=vtr(vp_+(((i)>>2)*4096+((i)&3)*1024)); vhi[i]=vtr(vp_+(((i)>>2)*4096+((i)&3)*1024+512)); }while(0)
  #define KRD(G,j) do{ if(G){ kload2(kf,kp0+sl_next,j); SBAR(); } }while(0)
  #define STEP(C0,C1,P0,P1,t,GK,GV,GL) do{ SBAR(); \
    const lds_cptr vp_=vp0+sl_prev; \
    VRD(0); SBAR(); float sacc=(P0[0]+P0[1]); \
    GAPA(C0=__builtin_amdgcn_mfma_f32_32x32x16_bf16(kf[0],qr[0],negm,0,0,0), P0[2],P0[3],P0[4],P0[5],     pw0[0]=PKW(P0,0), pw0[1]=PKW(P0,2), pw0); \
    VRD(4); SBAR(); GAPA(C1=__builtin_amdgcn_mfma_f32_32x32x16_bf16(kf[1],qr[0],negm,0,0,0), P0[6],P0[7],P0[8],P0[9],     pw0[2]=PKW(P0,4), pw0[3]=PKW(P0,6), pw0); \
    VRD(1); SBAR(); GAPA(C0=__builtin_amdgcn_mfma_f32_32x32x16_bf16(kf[2],qr[1],C0,0,0,0),   P0[10],P0[11],P0[12],P0[13], pw1[0]=PKW(P0,8), pw1[1]=PKW(P0,10), pw1); \
    VRD(5); SBAR(); GAPA(C1=__builtin_amdgcn_mfma_f32_32x32x16_bf16(kf[3],qr[1],C1,0,0,0),   P0[14],P0[15],P1[0],P1[1],   pw1[2]=PKW(P0,12),pw1[3]=PKW(P0,14), pw1); \
    VRD(2); SBAR(); GAPA(C0=__builtin_amdgcn_mfma_f32_32x32x16_bf16(kf[4],qr[2],C0,0,0,0),   P1[2],P1[3],P1[4],P1[5],     pw2[0]=PKW(P1,0), pw2[1]=PKW(P1,2), pw2); \
    VRD(6); SBAR(); GAPA(C1=__builtin_amdgcn_mfma_f32_32x32x16_bf16(kf[5],qr[2],C1,0,0,0),   P1[6],P1[7],P1[8],P1[9],     pw2[2]=PKW(P1,4), pw2[3]=PKW(P1,6), pw2); \
    VRD(3); SBAR(); GAPA(C0=__builtin_amdgcn_mfma_f32_32x32x16_bf16(kf[6],qr[3],C0,0,0,0),   P1[10],P1[11],P1[12],P1[13], pw3[0]=PKW(P1,8), pw3[1]=PKW(P1,10), pw3); \
    VRD(7); SBAR(); GAPA(C1=__builtin_amdgcn_mfma_f32_32x32x16_bf16(kf[7],qr[3],C1,0,0,0),   P1[14],P1[15],0.f,0.f,       pw3[2]=PKW(P1,12),pw3[3]=PKW(P1,14), pw3); \
    l_reg+=sacc; \
    if(GK){DMA_K((t)+3,sl_cur);} if(GV){DMA_V((t)+1,sl_next);} \
    CMASK(C0,C1,t); \
    { float a=MX3(C0[0],C0[1],C1[0]),b=MX3(C0[2],C0[3],C1[1]); a=MX3(a,C1[2],C1[3]); \
      _Pragma("unroll") for(int r=4;r<16;r+=4){a=MX3(a,C0[r],C0[r+1]);b=MX3(b,C0[r+2],C0[r+3]);a=MX3(a,C1[r],C1[r+1]);b=MX3(b,C1[r+2],C1[r+3]);} \
      float rm=__builtin_fmaxf(a,b); { auto rr=__builtin_amdgcn_permlane32_swap(__float_as_uint(rm),__float_as_uint(rm),false,false); rm=__builtin_fmaxf(__uint_as_float(rr[0]),__uint_as_float(rr[1])); } \
      resc=false; \
      if(__builtin_expect(__any(rm>(float)THRL),0)){ const float dl=__builtin_fmaxf(rm,0.f); mhat+=dl; \
        _Pragma("unroll") for(int r=0;r<16;++r){C0[r]-=dl;C1[r]-=dl;} \
        _Pragma("unroll") for(int r=0;r<16;++r)negm[r]=-mhat; asm volatile("":"+v"(negm)); \
        const float f=__builtin_amdgcn_exp2f(-dl); l_reg*=f; if(hi==0)wsf[r32]=f; resc=true; } } \
    SBAR(); \
    GAPB(o[0]=__builtin_amdgcn_mfma_f32_32x32x16_bf16(PAF(0),VFR(0),o[0],0,0,0), C0,0); \
    GAPB(o[1]=__builtin_amdgcn_mfma_f32_32x32x16_bf16(PAF(0),VFR(4),o[1],0,0,0), C0,4); \
    KRD(GL,0); GAPB(o[0]=__builtin_amdgcn_mfma_f32_32x32x16_bf16(PAF(1),VFR(1),o[0],0,0,0), C0,8); \
    KRD(GL,1); GAPB(o[1]=__builtin_amdgcn_mfma_f32_32x32x16_bf16(PAF(1),VFR(5),o[1],0,0,0), C0,12); \
    KRD(GL,2); GAPB(o[0]=__builtin_amdgcn_mfma_f32_32x32x16_bf16(PAF(2),VFR(2),o[0],0,0,0), C1,0); \
    KRD(GL,3); GAPB(o[1]=__builtin_amdgcn_mfma_f32_32x32x16_bf16(PAF(2),VFR(6),o[1],0,0,0), C1,4); \
    GAPB(o[0]=__builtin_amdgcn_mfma_f32_32x32x16_bf16(PAF(3),VFR(3),o[0],0,0,0), C1,8); \
    GAPB(o[1]=__builtin_amdgcn_mfma_f32_32x32x16_bf16(PAF(3),VFR(7),o[1],0,0,0), C1,12); \
    }while(0)
  int t=1;
  #undef CMASK
  #define CMASK(P0,P1,t) do{}while(0)
  for(;t+5<NT;t+=2){
    STEP(pB0,pB1,pA0,pA1,t,true,true,true);     WAIT_BAR(2); RESC(); ROT();
    STEP(pA0,pA1,pB0,pB1,t+1,true,true,true);   WAIT_BAR(2); RESC(); ROT();
  }
  #undef CMASK
  #define CMASK(P0,P1,t) do{int jb_=(t)-(NT-4); if(jb_>=0)cmask(P0,P1,jb_,qrel,hi);}while(0)
  #define ENDW(tt) do{ if((tt)+3<NT){WAIT_BAR(2);} else if((tt)+2<NT){WAIT_BAR(1);} else {WAIT_BAR(0);} }while(0)
  for(;t+1<NT;t+=2){
    STEP(pB0,pB1,pA0,pA1,t,(t+3<NT),(t+1<NT),(t+1<NT));       ENDW(t);   RESC(); ROT();
    STEP(pA0,pA1,pB0,pB1,t+1,(t+4<NT),(t+2<NT),(t+2<NT));     ENDW(t+1); RESC(); ROT();
  }
  STEP(pB0,pB1,pA0,pA1,NT-1,false,false,false); RESC();
  { float sacc=pB0[0]+pB0[1]; _Pragma("unroll") for(int r=2;r<16;++r)sacc+=pB0[r]; _Pragma("unroll") for(int r=0;r<16;++r)sacc+=pB1[r]; l_reg+=sacc;
    pw0=(u32x4){PKW(pB0,0),PKW(pB0,2),PKW(pB0,4),PKW(pB0,6)};pw1=(u32x4){PKW(pB0,8),PKW(pB0,10),PKW(pB0,12),PKW(pB0,14)};pw2=(u32x4){PKW(pB1,0),PKW(pB1,2),PKW(pB1,4),PKW(pB1,6)};pw3=(u32x4){PKW(pB1,8),PKW(pB1,10),PKW(pB1,12),PKW(pB1,14)};
    SBAR(); pv(o,vb0+sl_cur,PAF(0),PAF(1),PAF(2),PAF(3)); }
  #undef PKW
  #undef PAF
  #undef VFR
  #undef PIN
  #undef MX3
  #undef GAPA
  #undef GAPB
  #undef EX
  #undef VRD
  #undef KRD
  #undef STEP
  #undef ENDW
  {auto rr=__builtin_amdgcn_permlane32_swap(__float_as_uint(l_reg),__float_as_uint(l_reg),false,false);l_reg=__uint_as_float(rr[0])+__uint_as_float(rr[1]);}
  if(hi==0)wsf[32+r32]=l_reg;asm volatile("s_waitcnt lgkmcnt(0)":::"memory");
  float rli[16];
  #pragma unroll
  for(int r=0;r<16;++r)rli[r]=__builtin_amdgcn_rcpf(wsf[32+crow(r,hi)]);
  bf16*Ow=O+(rowbase+q0+wid*QBLK)*DM+vcol;
  { bf16*stg=(bf16*)(shm+LDS_OST)+wid*2048;
    #pragma unroll
    for(int r=0;r<16;++r){const int orow=crow(r,hi);
      #pragma unroll
      for(int d0=0;d0<2;++d0)stg[orow*64+d0*32+r32]=__float2bfloat16(o[d0][r]*rli[r]);}
    asm volatile("s_waitcnt lgkmcnt(0)":::"memory");
    #pragma unroll
    for(int i=0;i<4;++i){const int row=i*8+(lane>>3),ch=lane&7; const u32x4 v=*(const u32x4*)(stg+row*64+ch*8); ATTN_STORE16(Ow+(long)row*DM+ch*8,v);} }
  asm volatile("s_waitcnt lgkmcnt(0)\n\ts_barrier":::"memory");
  #undef DMA_K
  #undef DMA_V
  #undef CMASK
  #undef START
  #undef RESC
  #undef ROT
}
constexpr int ATTN_LDS_BYTES=LDS_BYTES;
template<int THRL=8> __device__ __forceinline__ void diff_attn_phase(char*lds,const bf16*Q,const bf16*K,const bf16*V,bf16*O1,bf16*O2,int G,int bid,int vcu){
  const bool bal=(G==256);
  for(int i=0;;++i){
    int vhd,qb;
    if(bal){ if(i>=24)break; const int rr=i>>2,ii=i&3,s=vcu&7; vhd=rr*32+(vcu>>3); qb=(ii==0)?s:(ii==1)?15-s:(ii==2)?16+s:31-s; }
    else{ const int id=bid+i*G; if(id>=192*NQB)break; vhd=id/NQB; qb=NQB-1-(id%NQB); }
    const int vh=vhd&1,c=(vhd>>1)&1,bh=vhd>>2,b=bh/NHEAD,h=bh%NHEAD;
    attn_unit<THRL>(b,h*128+64*c,h*128+64*vh,qb,Q,K,V,c?O2:O1,lds);
  }
}
#undef SBAR
#undef WAIT_BAR
}
namespace attn2 {
using bf16=__hip_bfloat16;
using bf16x8=__attribute__((ext_vector_type(8)))short;
using s16x4=__attribute__((ext_vector_type(4)))short;
using f32x16=__attribute__((ext_vector_type(16)))float;
using u32x4=__attribute__((ext_vector_type(4)))unsigned;
constexpr int NHEAD=12,SEQ=8192,D=64,DM=1536,OPITCH=2048;
constexpr int NW=8,QBLK=32,QB=QBLK*NW,KVBLK=64,NQB=SEQ/QB;
__device__ __forceinline__ int crow(int r,int hi){return (r&3)+8*(r>>2)+4*hi;}
#define SBAR() __builtin_amdgcn_sched_barrier(0)
__device__ __forceinline__ void cmask(f32x16&p0,f32x16&p1,int jb,int qrel,int hi){
  const float NEG=-INFINITY; int kb=64*jb+4*hi;
  #pragma unroll
  for(int r=0;r<16;++r){int kv=kb+(r&3)+8*(r>>2); if(kv>qrel)p0[r]=NEG; if(kv+32>qrel)p1[r]=NEG;}
}
constexpr int NSLOT=3, KSLOT=8192, VSLOT=16384;
constexpr int LDS_K=0, LDS_V=NSLOT*KSLOT, LDS_WS=LDS_V+NSLOT*VSLOT, LDS_OST=LDS_WS+NW*64*4, LDS_BYTES=LDS_OST+NW*8192;
__device__ __forceinline__ void glds16(const void*gsrc,unsigned lds_dst){unsigned keep;
  asm volatile("s_mov_b32 %0, m0\n\ts_mov_b32 m0, %2\n\ts_nop 0\n\tglobal_load_lds_dwordx4 %1, off\n\ts_mov_b32 m0, %0":"=&s"(keep):"v"(gsrc),"s"(lds_dst):"memory");}
typedef float f32x2_t __attribute__((ext_vector_type(2))); typedef __bf16 bf16x2_t __attribute__((ext_vector_type(2)));
__device__ __forceinline__ unsigned cvtpk_s(float lo,float hi){f32x2_t v={lo,hi};bf16x2_t b=__builtin_convertvector(v,bf16x2_t);return __builtin_bit_cast(unsigned,b);}
#define WAIT_BAR(N) asm volatile("s_waitcnt vmcnt(" #N ") lgkmcnt(0)\n\ts_barrier":::"memory")
__device__ __forceinline__ void qkt(f32x16&p0,f32x16&p1,const char*Kslot,const bf16x8*qr,int r32,int hi){
  const char*kb=Kslot+hi*1024+r32*16; const f32x16 z=f32x16{};
  #pragma unroll
  for(int d0=0;d0<4;++d0){
    const bf16x8 b0=*reinterpret_cast<const bf16x8*>(kb+d0*2048);
    const bf16x8 b1=*reinterpret_cast<const bf16x8*>(kb+d0*2048+512);
    if(d0==0){p0=__builtin_amdgcn_mfma_f32_32x32x16_bf16(b0,qr[0],z,0,0,0);p1=__builtin_amdgcn_mfma_f32_32x32x16_bf16(b1,qr[0],z,0,0,0);}
    else{p0=__builtin_amdgcn_mfma_f32_32x32x16_bf16(b0,qr[d0],p0,0,0,0);p1=__builtin_amdgcn_mfma_f32_32x32x16_bf16(b1,qr[d0],p1,0,0,0);}}
}
typedef __attribute__((address_space(3))) const char* lds_cptr;
typedef short v4i16_t __attribute__((ext_vector_type(4)));
__device__ __forceinline__ void kload8(bf16x8*kf,lds_cptr kp){
  kf[0]=*(const __attribute__((address_space(3))) bf16x8*)(kp);      kf[1]=*(const __attribute__((address_space(3))) bf16x8*)(kp+512);
  kf[2]=*(const __attribute__((address_space(3))) bf16x8*)(kp+2048); kf[3]=*(const __attribute__((address_space(3))) bf16x8*)(kp+2560);
  kf[4]=*(const __attribute__((address_space(3))) bf16x8*)(kp+4096); kf[5]=*(const __attribute__((address_space(3))) bf16x8*)(kp+4608);
  kf[6]=*(const __attribute__((address_space(3))) bf16x8*)(kp+6144); kf[7]=*(const __attribute__((address_space(3))) bf16x8*)(kp+6656);
}
__device__ __forceinline__ void kload2(bf16x8*kf,lds_cptr kp,int j){ kf[2*j]=*(const __attribute__((address_space(3))) bf16x8*)(kp+j*2048); kf[2*j+1]=*(const __attribute__((address_space(3))) bf16x8*)(kp+j*2048+512); }
__device__ __forceinline__ s16x4 vtr(lds_cptr p){ return __builtin_bit_cast(s16x4,__builtin_amdgcn_ds_read_tr16_b64_v4i16((__attribute__((address_space(3))) v4i16_t*)p)); }
__device__ __forceinline__ void pv4(f32x16*o,int vb,bf16x8 pa0,bf16x8 pa1,bf16x8 pa2,bf16x8 pa3){
  #pragma unroll
  for(int d0=0;d0<4;++d0){s16x4 lo[4],hi[4];
    #pragma unroll
    for(int ks=0;ks<4;++ks){
      asm volatile("ds_read_b64_tr_b16 %0,%1 offset:%c2":"=&v"(lo[ks]):"v"(vb),"i"(d0*4096+ks*1024):"memory");
      asm volatile("ds_read_b64_tr_b16 %0,%1 offset:%c2":"=&v"(hi[ks]):"v"(vb),"i"(d0*4096+ks*1024+512):"memory");}
    asm volatile("s_waitcnt lgkmcnt(0)":::"memory");SBAR();
    #define PK(k) (bf16x8){lo[k][0],lo[k][1],lo[k][2],lo[k][3],hi[k][0],hi[k][1],hi[k][2],hi[k][3]}
    o[d0]=__builtin_amdgcn_mfma_f32_32x32x16_bf16(pa0,PK(0),o[d0],0,0,0);
    o[d0]=__builtin_amdgcn_mfma_f32_32x32x16_bf16(pa1,PK(1),o[d0],0,0,0);
    o[d0]=__builtin_amdgcn_mfma_f32_32x32x16_bf16(pa2,PK(2),o[d0],0,0,0);
    o[d0]=__builtin_amdgcn_mfma_f32_32x32x16_bf16(pa3,PK(3),o[d0],0,0,0);
    #undef PK
  }
}
__device__ __forceinline__ void attn_unit(int b,int qcol,int vcol,int qb,int comp,float lam,const float*subln,int ocol,const bf16*Q,const bf16*__restrict__ K,const bf16*__restrict__ V,bf16*OUT,char*shm,bool first,bool has_next,int nb,int nqcol,int nvcol){
  int tid=threadIdx.x; asm volatile("":"+v"(tid));
  const int lane=tid&63,r32=lane&31,hi=lane>>5; const int wid=__builtin_amdgcn_readfirstlane(tid>>6);
  const long rowbase=(long)b*SEQ; const int q0=qb*QB;
  const bf16*Qw=Q+(rowbase+q0+wid*QBLK)*DM+qcol;
  const bf16*Kh=K+rowbase*DM+qcol,*Vh=V+rowbase*DM+vcol;
  const unsigned lds0=(unsigned)(uintptr_t)shm;
  const bf16*ksrc=Kh+(long)lane*DM+wid*8;
  const bf16*vsrc=Vh+(long)(16*(wid&3)+(lane>>2))*DM+(wid>>2)*32+(lane&3)*8;
  const unsigned kdst=lds0+LDS_K+wid*1024, vdst=lds0+LDS_V+wid*1024;
  #define DMA_K(t,slot) glds16(ksrc+(long)(t)*KVBLK*DM,(unsigned)__builtin_amdgcn_readfirstlane(kdst+(slot)))
  #define DMA_V(t,slot) do{ glds16(vsrc+(long)(t)*KVBLK*DM,(unsigned)__builtin_amdgcn_readfirstlane(vdst+2*(slot))); glds16(vsrc+64+(long)(t)*KVBLK*DM,(unsigned)__builtin_amdgcn_readfirstlane(vdst+8192+2*(slot))); }while(0)
  const int vb0=(int)(lds0+LDS_V)+((lane>>4)&1)*32+(lane&3)*8+(4*hi+((lane&15)>>2))*64;
  const char*Kbase=shm+LDS_K; bf16x8 kf[8];
  const lds_cptr shm3=(lds_cptr)shm; const lds_cptr kp0=shm3+LDS_K+hi*1024+r32*16; const lds_cptr vp0=shm3+LDS_V+((lane>>4)&1)*32+(lane&3)*8+(4*hi+((lane&15)>>2))*64;
  const int NT=(q0+QB)/KVBLK;
  if(first){DMA_K(0,0);DMA_V(0,0);DMA_K(1,KSLOT);}
  bf16x8 qr[4];
  #pragma unroll
  for(int d0=0;d0<4;++d0)qr[d0]=*reinterpret_cast<const bf16x8*>(&Qw[(long)r32*DM+d0*16+hi*8]);
  float l_reg=0.f;f32x16 o[4];o[0]=f32x16{};o[1]=f32x16{};o[2]=f32x16{};o[3]=f32x16{};
  const int qrel=wid*QBLK+r32;
  #define CMASK(P0,P1,t) do{int jb_=(t)-(NT-4); if(jb_>=0)cmask(P0,P1,jb_,qrel,hi);}while(0)
  f32x16 pA0,pA1,pB0,pB1;
  int sl_prev=0,sl_cur=0,sl_next=KSLOT;
  #define ROT() do{sl_prev=sl_cur;sl_cur=sl_next;sl_next=(sl_next==(NSLOT-1)*KSLOT)?0:sl_next+KSLOT;}while(0)
  DMA_K(2,2*KSLOT);
  WAIT_BAR(4);
  qkt(pA0,pA1,Kbase,qr,r32,hi);asm volatile("s_nop 15\n\ts_nop 7":"+v"(pA0),"+v"(pA1));CMASK(pA0,pA1,0);
  _Pragma("unroll") for(int r=0;r<16;++r){pA0[r]=__builtin_amdgcn_exp2f(pA0[r]);pA1[r]=__builtin_amdgcn_exp2f(pA1[r]);}
  WAIT_BAR(0);
  DMA_K(3,0);DMA_V(1,KSLOT);
  ROT();
  kload8(kf,kp0+sl_cur);
  WAIT_BAR(3);
  s16x4 vlo[8],vhi[8]; u32x4 pw0,pw1,pw2,pw3;
  const f32x16 zero16=f32x16{};
  #define PKW(P,B) cvtpk_s(P[B],P[B+1])
  #define PAF(k) __builtin_bit_cast(bf16x8,pw##k)
  #define VFR(i) (bf16x8){vlo[i][0],vlo[i][1],vlo[i][2],vlo[i][3],vhi[i][0],vhi[i][1],vhi[i][2],vhi[i][3]}
  #define PIN(x) asm volatile("":"+v"(x))
  #define GAPA(MF,A0,A1,A2,A3,W0,W1,PW) do{ MF; sacc+=A0; sacc+=A1; sacc+=A2; sacc+=A3; PIN(sacc); W0; W1; PIN(PW); SBAR(); }while(0)
  #define EX(v) __builtin_amdgcn_exp2f(v)
  #define GAPB(MF,X,B) do{ MF; X[B]=EX(X[B]); X[B+1]=EX(X[B+1]); PIN(X); SBAR(); }while(0)
  #define VRD(i) do{ vlo[i]=vtr(vp_+(((i)>>2)*4096+((i)&3)*1024)); vhi[i]=vtr(vp_+(((i)>>2)*4096+((i)&3)*1024+512)); }while(0)
  #define VRD2(i) do{ vlo[i]=vtr(vp_+((((i)>>2)+2)*4096+((i)&3)*1024)); vhi[i]=vtr(vp_+((((i)>>2)+2)*4096+((i)&3)*1024+512)); SBAR(); }while(0)
  #define KRD(G,j) do{ if(G){ kload2(kf,kp0+sl_next,j); SBAR(); } }while(0)
  #define STEP(C0,C1,P0,P1,t,GK,GV,GL) do{ SBAR(); \
    const lds_cptr vp_=vp0+2*sl_prev; \
    VRD(0); SBAR(); float sacc=(P0[0]+P0[1]); \
    GAPA(C0=__builtin_amdgcn_mfma_f32_32x32x16_bf16(kf[0],qr[0],zero16,0,0,0), P0[2],P0[3],P0[4],P0[5],     pw0[0]=PKW(P0,0), pw0[1]=PKW(P0,2), pw0); \
    VRD(4); SBAR(); GAPA(C1=__builtin_amdgcn_mfma_f32_32x32x16_bf16(kf[1],qr[0],zero16,0,0,0), P0[6],P0[7],P0[8],P0[9],     pw0[2]=PKW(P0,4), pw0[3]=PKW(P0,6), pw0); \
    VRD(1); SBAR(); GAPA(C0=__builtin_amdgcn_mfma_f32_32x32x16_bf16(kf[2],qr[1],C0,0,0,0),   P0[10],P0[11],P0[12],P0[13], pw1[0]=PKW(P0,8), pw1[1]=PKW(P0,10), pw1); \
    VRD(5); SBAR(); GAPA(C1=__builtin_amdgcn_mfma_f32_32x32x16_bf16(kf[3],qr[1],C1,0,0,0),   P0[14],P0[15],P1[0],P1[1],   pw1[2]=PKW(P0,12),pw1[3]=PKW(P0,14), pw1); \
    VRD(2); SBAR(); GAPA(C0=__builtin_amdgcn_mfma_f32_32x32x16_bf16(kf[4],qr[2],C0,0,0,0),   P1[2],P1[3],P1[4],P1[5],     pw2[0]=PKW(P1,0), pw2[1]=PKW(P1,2), pw2); \
    VRD(6); SBAR(); GAPA(C1=__builtin_amdgcn_mfma_f32_32x32x16_bf16(kf[5],qr[2],C1,0,0,0),   P1[6],P1[7],P1[8],P1[9],     pw2[2]=PKW(P1,4), pw2[3]=PKW(P1,6), pw2); \
    VRD(3); SBAR(); GAPA(C0=__builtin_amdgcn_mfma_f32_32x32x16_bf16(kf[6],qr[3],C0,0,0,0),   P1[10],P1[11],P1[12],P1[13], pw3[0]=PKW(P1,8), pw3[1]=PKW(P1,10), pw3); \
    VRD(7); SBAR(); GAPA(C1=__builtin_amdgcn_mfma_f32_32x32x16_bf16(kf[7],qr[3],C1,0,0,0),   P1[14],P1[15],0.f,0.f,       pw3[2]=PKW(P1,12),pw3[3]=PKW(P1,14), pw3); \
    l_reg+=sacc; \
    if(GK){DMA_K((t)+3,sl_cur);} if(GV){DMA_V((t)+1,sl_next);} \
    CMASK(C0,C1,t); \
    SBAR(); \
    GAPB(o[0]=__builtin_amdgcn_mfma_f32_32x32x16_bf16(PAF(0),VFR(0),o[0],0,0,0), C0,0); \
    VRD2(0); GAPB(o[1]=__builtin_amdgcn_mfma_f32_32x32x16_bf16(PAF(0),VFR(4),o[1],0,0,0), C0,2); \
    VRD2(4); KRD(GL,0); GAPB(o[0]=__builtin_amdgcn_mfma_f32_32x32x16_bf16(PAF(1),VFR(1),o[0],0,0,0), C0,4); \
    VRD2(1); KRD(GL,1); GAPB(o[1]=__builtin_amdgcn_mfma_f32_32x32x16_bf16(PAF(1),VFR(5),o[1],0,0,0), C0,6); \
    VRD2(5); KRD(GL,2); GAPB(o[0]=__builtin_amdgcn_mfma_f32_32x32x16_bf16(PAF(2),VFR(2),o[0],0,0,0), C0,8); \
    VRD2(2); KRD(GL,3); GAPB(o[1]=__builtin_amdgcn_mfma_f32_32x32x16_bf16(PAF(2),VFR(6),o[1],0,0,0), C0,10); \
    VRD2(6); GAPB(o[0]=__builtin_amdgcn_mfma_f32_32x32x16_bf16(PAF(3),VFR(3),o[0],0,0,0), C0,12); \
    VRD2(3); GAPB(o[1]=__builtin_amdgcn_mfma_f32_32x32x16_bf16(PAF(3),VFR(7),o[1],0,0,0), C0,14); \
    VRD2(7); \
    GAPB(o[2]=__builtin_amdgcn_mfma_f32_32x32x16_bf16(PAF(0),VFR(0),o[2],0,0,0), C1,0); \
    GAPB(o[3]=__builtin_amdgcn_mfma_f32_32x32x16_bf16(PAF(0),VFR(4),o[3],0,0,0), C1,2); \
    GAPB(o[2]=__builtin_amdgcn_mfma_f32_32x32x16_bf16(PAF(1),VFR(1),o[2],0,0,0), C1,4); \
    GAPB(o[3]=__builtin_amdgcn_mfma_f32_32x32x16_bf16(PAF(1),VFR(5),o[3],0,0,0), C1,6); \
    GAPB(o[2]=__builtin_amdgcn_mfma_f32_32x32x16_bf16(PAF(2),VFR(2),o[2],0,0,0), C1,8); \
    GAPB(o[3]=__builtin_amdgcn_mfma_f32_32x32x16_bf16(PAF(2),VFR(6),o[3],0,0,0), C1,10); \
    GAPB(o[2]=__builtin_amdgcn_mfma_f32_32x32x16_bf16(PAF(3),VFR(3),o[2],0,0,0), C1,12); \
    GAPB(o[3]=__builtin_amdgcn_mfma_f32_32x32x16_bf16(PAF(3),VFR(7),o[3],0,0,0), C1,14); \
    }while(0)
  int t=1;
  if(wid>=4)__builtin_amdgcn_s_setprio(1);
  #undef CMASK
  #define CMASK(P0,P1,t) do{}while(0)
  for(;t+5<NT;t+=2){
    STEP(pB0,pB1,pA0,pA1,t,true,true,true);     WAIT_BAR(3); ROT();
    STEP(pA0,pA1,pB0,pB1,t+1,true,true,true);   WAIT_BAR(3); ROT();
  }
  #undef CMASK
  #define CMASK(P0,P1,t) do{int jb_=(t)-(NT-4); if(jb_>=0)cmask(P0,P1,jb_,qrel,hi);}while(0)
  #define ENDW(tt) do{ if((tt)+3<NT){WAIT_BAR(3);} else if((tt)+2<NT){WAIT_BAR(2);} else {WAIT_BAR(0);} }while(0)
  for(;t+1<NT;t+=2){
    STEP(pB0,pB1,pA0,pA1,t,(t+3<NT),(t+1<NT),(t+1<NT));       ENDW(t);   ROT();
    STEP(pA0,pA1,pB0,pB1,t+1,(t+4<NT),(t+2<NT),(t+2<NT));     ENDW(t+1); ROT();
  }
  STEP(pB0,pB1,pA0,pA1,NT-1,false,false,false);
  __builtin_amdgcn_s_setprio(0);
  { float sacc=pB0[0]+pB0[1]; _Pragma("unroll") for(int r=2;r<16;++r)sacc+=pB0[r]; _Pragma("unroll") for(int r=0;r<16;++r)sacc+=pB1[r]; l_reg+=sacc;
    pw0=(u32x4){PKW(pB0,0),PKW(pB0,2),PKW(pB0,4),PKW(pB0,6)};pw1=(u32x4){PKW(pB0,8),PKW(pB0,10),PKW(pB0,12),PKW(pB0,14)};pw2=(u32x4){PKW(pB1,0),PKW(pB1,2),PKW(pB1,4),PKW(pB1,6)};pw3=(u32x4){PKW(pB1,8),PKW(pB1,10),PKW(pB1,12),PKW(pB1,14)};
    SBAR(); pv4(o,vb0+2*sl_cur,PAF(0),PAF(1),PAF(2),PAF(3)); }
  asm volatile("s_waitcnt lgkmcnt(0)\n\ts_barrier":::"memory");
  if(has_next){ const long nrow=(long)nb*SEQ; const bf16*nk=K+nrow*DM+nqcol+(long)lane*DM+wid*8; const bf16*nv=V+nrow*DM+nvcol+(long)(16*(wid&3)+(lane>>2))*DM+(wid>>2)*32+(lane&3)*8;
    glds16(nk,(unsigned)__builtin_amdgcn_readfirstlane(kdst)); glds16(nv,(unsigned)__builtin_amdgcn_readfirstlane(vdst)); glds16(nv+64,(unsigned)__builtin_amdgcn_readfirstlane(vdst+8192)); glds16(nk+(long)KVBLK*DM,(unsigned)__builtin_amdgcn_readfirstlane(kdst+KSLOT)); }
  #undef PKW
  #undef PAF
  #undef VFR
  #undef PIN
  #undef GAPA
  #undef GAPB
  #undef EX
  #undef VRD
  #undef VRD2
  #undef KRD
  #undef STEP
  #undef ENDW
  {auto rr=__builtin_amdgcn_permlane32_swap(__float_as_uint(l_reg),__float_as_uint(l_reg),false,false);l_reg=__uint_as_float(rr[0])+__uint_as_float(rr[1]);}
  { int tz=threadIdx.x; asm volatile("":"+v"(tz)); const int lane2=tz&63,r2=lane2&31,hi2=lane2>>5,wid2=tz>>6;
    float*wsf2=(float*)(shm+LDS_WS)+wid2*64;
    if(hi2==0)wsf2[32+r2]=l_reg;asm volatile("s_waitcnt lgkmcnt(0)":::"memory");
    float rli[16];
    #pragma unroll
    for(int r=0;r<16;++r)rli[r]=__builtin_amdgcn_rcpf(wsf2[32+crow(r,hi2)]);
    bf16*stg=(bf16*)(shm+LDS_OST)+wid2*4096;
    if(comp==0){
      #pragma unroll
      for(int r=0;r<16;++r){const int orow=crow(r,hi2);
        #pragma unroll
        for(int d0=0;d0<4;++d0)stg[orow*128+d0*32+r2]=__float2bfloat16(o[d0][r]*rli[r]);}
    } else {
      float sg[4];
      #pragma unroll
      for(int d0=0;d0<4;++d0)sg[d0]=subln[d0*32+r2]*(1.0f-0.35550906759310784f);
      #pragma unroll
      for(int r=0;r<16;++r){const int orow=crow(r,hi2); float ss=0.f;
        #pragma unroll
        for(int d0=0;d0<4;++d0){const float o1=__bfloat162float(stg[orow*128+d0*32+r2]); const float dv=o1-lam*(o[d0][r]*rli[r]); o[d0][r]=dv; ss+=dv*dv;}
        ss+=__shfl_xor(ss,1);ss+=__shfl_xor(ss,2);ss+=__shfl_xor(ss,4);ss+=__shfl_xor(ss,8);ss+=__shfl_xor(ss,16);
        const float rn=__builtin_amdgcn_rsqf(ss*(1.f/128.f)+1e-6f);
        #pragma unroll
        for(int d0=0;d0<4;++d0)stg[orow*128+d0*32+r2]=__float2bfloat16(o[d0][r]*rn*sg[d0]);}
      asm volatile("s_waitcnt lgkmcnt(0)":::"memory");
      unsigned char*Ow=(unsigned char*)OUT+(rowbase+q0+wid2*QBLK)*OPITCH+ocol;
      #pragma unroll
      for(int i=0;i<8;++i){const int row=i*4+(lane2>>4),ch=lane2&15; const u32x4 v=*(const u32x4*)(stg+row*128+ch*8);
        u32x2 w8; w8.x=gm::pk_fp8x4(bflo(v.x)*16.f,bfhi(v.x)*16.f,bflo(v.y)*16.f,bfhi(v.y)*16.f); w8.y=gm::pk_fp8x4(bflo(v.z)*16.f,bfhi(v.z)*16.f,bflo(v.w)*16.f,bfhi(v.w)*16.f);
        *(u32x2*)(Ow+(long)row*OPITCH+ch*8)=w8;} }
  }
  asm volatile("s_waitcnt lgkmcnt(0)\n\ts_barrier":::"memory");
  #undef DMA_K
  #undef DMA_V
  #undef CMASK
  #undef ROT
}
__device__ __forceinline__ void diff_attn_phase(char*lds,const bf16*Q,const bf16*K,const bf16*V,bf16*OUT,float lam,const float*subln,int G,int bid,int vcu){
  const bool bal=(G==256);
  auto unit=[&](int i,int&hd,int&qb,int&c)->bool{ const int item=i>>1; c=i&1;
    if(bal){ if(i>=12)return false;
      if(item<4){ hd=vcu>>3; const int s=vcu&7; qb=(item==0)?s:(item==1)?15-s:(item==2)?16+s:31-s; }
      else{ hd=32+(vcu>>4); const int s=vcu&15; qb=(item==4)?s:31-s; } }
    else{ const int id=bid+item*G; if(id>=48*NQB)return false; hd=id/NQB; qb=NQB-1-(id%NQB); }
    return true; };
  int hd,qb,c; bool ok=unit(0,hd,qb,c);
  for(int i=0;ok;++i){
    int nhd=0,nqb=0,nc=0; const bool hn=unit(i+1,nhd,nqb,nc);
    const int b=hd/NHEAD,h=hd%NHEAD,nbb=nhd/NHEAD,nh=nhd%NHEAD;
    attn_unit(b,h*128+64*c,h*128,qb,c,lam,subln,h*128,Q,K,V,OUT,lds,i==0,hn,nbb,nh*128+64*nc,nh*128);
    hd=nhd;qb=nqb;c=nc;ok=hn;
  }
}
#undef SBAR
#undef WAIT_BAR
}
__device__ __forceinline__ void subln_phase(const Ctx& C) {
    const bf16_t* O1 = WSP(bf16_t, WS_BIG + BG_O1); const bf16_t* O2 = WSP(bf16_t, WS_BIG + BG_O2); bf16_t* cat = WSP(bf16_t, WS_S1);
    const int lane = C.lane;
    const float p01 = wave_sum(C.in(17)[lane] * C.in(17)[64 + lane]), p23 = wave_sum(C.in(17)[128 + lane] * C.in(17)[192 + lane]);
    const float lam = expf(p01) - expf(p23) + LAMBDA_INIT;
    const int sub = C.tid & 15;
    const f32x4 g0 = *(const f32x4*)(C.in(18) + 8 * sub), g1 = *(const f32x4*)(C.in(18) + 8 * sub + 4);
    const int NGRP = T * DH;
    for (int grp = (C.vcu * 512 + C.tid) >> 4; grp < NGRP; grp += (C.G * 512) >> 4) {
        const size_t off = (size_t)grp * DDV + 8 * sub;
        const u32x4 a = *(const u32x4*)(O1 + off), b = *(const u32x4*)(O2 + off);
        float v[8] = {bflo(a.x) - lam * bflo(b.x), bfhi(a.x) - lam * bfhi(b.x), bflo(a.y) - lam * bflo(b.y), bfhi(a.y) - lam * bfhi(b.y),
                      bflo(a.z) - lam * bflo(b.z), bfhi(a.z) - lam * bfhi(b.z), bflo(a.w) - lam * bflo(b.w), bfhi(a.w) - lam * bfhi(b.w)};
        float ss = 0.f;
#pragma unroll
        for (int i = 0; i < 8; ++i) ss += v[i] * v[i];
        ss += __shfl_xor(ss, 1); ss += __shfl_xor(ss, 2); ss += __shfl_xor(ss, 4); ss += __shfl_xor(ss, 8);
        const float rn = (1.0f / sqrtf(ss * (1.f / DDV) + EPS)) * (1.0f - LAMBDA_INIT);
        u32x4 w; w.x = cvtpk(v[0] * rn * g0[0], v[1] * rn * g0[1]); w.y = cvtpk(v[2] * rn * g0[2], v[3] * rn * g0[3]); w.z = cvtpk(v[4] * rn * g1[0], v[5] * rn * g1[1]); w.w = cvtpk(v[6] * rn * g1[2], v[7] * rn * g1[3]);
        const int tok = grp / DH, h = grp % DH;
        *(u32x4*)(cat + (size_t)tok * D + h * DDV + 8 * sub) = w;
    }
}
#ifndef MK_PROBE
#define MK_PROBE 0
#endif
#define REPN(k) ((MK_PROBE == (k)) ? 3 : 1)
#ifndef MK_N_LAUNCHES
#define MK_N_LAUNCHES 1
#endif
constexpr int NPHASE = 19;
struct Args { const void* in[28]; float* out; unsigned char* ws; int ph_lo, ph_hi; };
__global__ void __launch_bounds__(512, 2) yoco_fwd(Args args) {
    extern __shared__ __attribute__((aligned(16))) unsigned char lds_raw[];
    Ctx C;
    C.lds = (LAS unsigned char*)lds_raw;
    C.tid = threadIdx.x; C.lane = C.tid & 63; C.wave = __builtin_amdgcn_readfirstlane(C.tid >> 6);
    C.G = gridDim.x; C.bid = blockIdx.x; C.vcu = (C.G % 8 == 0) ? (C.bid % 8) * (C.G / 8) + C.bid / 8 : C.bid;
    C.ka = (karg_t)__builtin_amdgcn_kernarg_segment_ptr();
    C.out = args.out; C.ws = args.ws;
    volatile LAS unsigned* MISC = (volatile LAS unsigned*)(C.lds + MISC_OFF);
    for (int u = C.tid; u < 256; u += 512) MISC[u] = 0u;
    __syncthreads();
    unsigned* ctl = (unsigned*)(C.ws + WS_CTL);
    XcdBarrier bar; bar.bar = ctl + CW_BAR; bar.x = 0; bar.st = nullptr;
    const int lo = args.ph_lo, hi = args.ph_hi;
    if (hi - lo > 1) bar = xcd_barrier_post(ctl + CW_BAR, MISC + 8);
#ifndef MK_PHASE_MASK
#define MK_PHASE_MASK 0xFFFFFFFFu
#endif
#ifndef MK_DYN
#define MK_DYN 0
#endif
#define TKT(k) ((MK_DYN && (C.G % 8 == 0)) ? ctl + 32768 + (k) * 512 : (unsigned*)nullptr)
#define TSLOT ((LAS int*)(C.lds + MISC_OFF + 640))
#define IN(k) (((MK_PHASE_MASK >> (k)) & 1u) && lo <= (k) && (k) < hi)
#define SEAM(k) do { if (IN(k) && IN((k) + 1)) xcd_barrier(bar); } while (0)
    unsigned char* big = C.ws + WS_BIG;
    float* rstd = WSP(float, WS_RSTD);

    if (IN(0)) { p0_prologue(C);
#if MK_PROBE == 1
        xcd_barrier(bar); p0_prologue(C);
#endif
#if MK_PROBE == 24
        for (int q = 0; q < 16; ++q) xcd_barrier(bar);
#endif

    } SEAM(0);
    if (IN(1)) { ProbInA P; P.pm0 = 0;
        P.ord.init(T / 256, 6, C.G, C.bid, TKT(1), TSLOT);
 P.xb = (const char*)(C.ws + WS_S0); P.w = (const char*)(C.ws + WS_WINA); P.big = big; P.rstd = rstd; gm::gemm_phase(C.lds, P);
        { ProbInA8 Q; Q.ord.init(T / 256, 14, C.G, C.bid, TKT(1), TSLOT); Q.a = (const char*)(C.ws + WS_X8); Q.w = (const char*)(C.ws + WS_WINA + (size_t)3072 * D * 2); Q.big = big; Q.rstd = rstd; gm::gemm_phase8(C.lds, Q); }
    }
    if (MK_N_LAUNCHES != 1) { SEAM(1); }
    if (IN(2)) for (int rep = 0; rep < REPN(20); ++rep) {
        const int nmk = C.G > 64 ? 32 : 0;
        if (C.bid < 32 || nmk == 0) { ProbMemKV P; P.G = nmk ? 32 : C.G; P.c = C.bid; P.memb = (const char*)(C.ws + WS_MEMB); P.w = (const char*)(C.ws + WS_WMEM); P.outp = WSP(float, WS_MEMKV); P.rstd = WSP(float, WS_MISC + MS_RSTDMEM); gm::gemm_phase(C.lds, P); }
        if (C.bid >= nmk) gates_phase(C, (C.bid - nmk) * 8 + C.wave, (C.G - nmk) * 8);
    } SEAM(2);
    if (IN(3)) { mlstm_a(C); } SEAM(3);
    if (IN(4)) { mlstm_b(C); } SEAM(4);
    if (IN(5)) {
#ifndef SKIP_MLC
 mlstm_c(C);
#endif
#ifndef SKIP_MA
 memattn_phase(C, 0, WSP(bf16_t, WS_BIG + BG_MQ), WSP(bf16_t, WS_S1));
#endif
 }
 SEAM(5);
    if (IN(6)) { ProbOut<false> P; P.ord.init(T / 256, D / 256, C.G, C.bid, TKT(6), TSLOT); P.a = (const char*)(C.ws + WS_S1); P.w = (const char*)(C.ws + WS_WOUTA); P.resid = WSP(bf16_t, WS_S0);
        P.outp = WSP(bf16_t, WS_S2); gm::gemm_phase(C.lds, P); } SEAM(6);
    if (IN(7)) { router_phase(C, 0, WSP(bf16_t, WS_S2), rstd + T, 0);
#if MK_PROBE == 26
        xcd_barrier(bar); router_phase(C, 0, WSP(bf16_t, WS_S2), rstd + T, 2); xcd_barrier(bar); router_phase(C, 0, WSP(bf16_t, WS_S2), rstd + T, 3);
#endif
    } SEAM(7);
    if (IN(8)) { moe_tables(C, 0); ProbGU8 P; P.G = C.G; P.c = C.bid; P.tb = moe_tb(C.lds); P.xb = (const char*)(C.ws + WS_X8); P.w = (const char*)(C.ws + WS_WGU); P.ltok = WSP(int, WS_LIST); P.lrs = WSP(float, WS_LIST + 8 * MiB); P.act = C.ws + WS_BIG + BG_ACT;
#if MK_PROBE == 42
        int nr_ = 2; asm volatile("" : "+s"(nr_)); for (int rep_ = 0; rep_ < nr_; ++rep_)
#endif
        gm::gemm_phase8(C.lds, P); } SEAM(8);
    if (IN(9)) { moe_tables(C, 0); ProbDown8 P; P.G = C.G; P.c = C.bid; P.tb = moe_tb(C.lds); P.act = (const char*)(C.ws + WS_BIG + BG_ACT); P.w = (const char*)(C.ws + WS_WD); P.lw = WSP(float, WS_LIST + 4 * MiB); P.yb = WSP(bf16_t, WS_BIG + BG_YB);
#if MK_PROBE == 43
        int nr_ = 2; asm volatile("" : "+s"(nr_)); for (int rep_ = 0; rep_ < nr_; ++rep_)
#endif
        gm::gemm_phase8(C.lds, P); } SEAM(9);
    if (IN(10)) { moe_tables(C, 0); for (int rep = 0; rep < REPN(21); ++rep) combine_phase<false>(C, WSP(bf16_t, WS_S2), WSP(bf16_t, WS_BIG + BG_YB), WSP(bf16_t, WS_S0), rstd + 2 * T, nullptr); } SEAM(10);
    if (IN(11)) { ProbL1F8 P; P.ord.init(T / 256, NL1 / 256, C.G, C.bid, TKT(11), TSLOT); P.a = (const char*)(C.ws + WS_X8); P.w = (const char*)(C.ws + WS_WL1); P.big = big; P.rstd = rstd + 2 * T;
        P.pos = (const int*)C.in(2); P.kgain = C.in(14); P.qgain = C.in(16);
        gm::gemm_phase8(C.lds, P); } SEAM(11);
    if (IN(12)) {
        float lam; { const float* lv = C.in(17); const float p01 = wave_sum(lv[C.lane] * lv[64 + C.lane]), p23 = wave_sum(lv[128 + C.lane] * lv[192 + C.lane]); lam = expf(p01) - expf(p23) + LAMBDA_INIT; }
#if MK_PROBE == 41
        int nr_ = 2; asm volatile("" : "+s"(nr_)); for (int rep_ = 0; rep_ < nr_; ++rep_)
#endif
        attn2::diff_attn_phase((char*)lds_raw, (const attn2::bf16*)(big + BG_QR), (const attn2::bf16*)(big + BG_KR), (const attn2::bf16*)(big + BG_VN), (attn2::bf16*)(C.ws + WS_S1), lam, C.in(18), C.G, C.bid, C.vcu);
        __syncthreads();
        memattn_phase(C, 1, WSP(bf16_t, WS_BIG + BG_MQ2), WSP(bf16_t, WS_S1));
    } if (IN(12) && IN(14)) xcd_barrier(bar);
    if (IN(14)) { ProbOut8 P; P.ord.init(T / 256, D / 256, C.G, C.bid, TKT(14), TSLOT); P.a = (const char*)(C.ws + WS_S1); P.w = (const char*)(C.ws + WS_WOUTB); P.resid = WSP(bf16_t, WS_S0); P.outp = WSP(bf16_t, WS_S2); gm::gemm_phase8(C.lds, P); } SEAM(14);
    if (IN(15)) { router_phase(C, 1, WSP(bf16_t, WS_S2), rstd + 3 * T, 1); } SEAM(15);
    if (IN(16)) { moe_tables(C, 1); ProbGU8 P; P.G = C.G; P.c = C.bid; P.tb = moe_tb(C.lds); P.xb = (const char*)(C.ws + WS_X8); P.w = (const char*)(C.ws + WS_WGU + (size_t)128 * MiB); P.ltok = WSP(int, WS_LIST); P.lrs = WSP(float, WS_LIST + 8 * MiB); P.act = C.ws + WS_BIG + BG_ACT; gm::gemm_phase8(C.lds, P); } SEAM(16);
    if (IN(17)) { moe_tables(C, 1); ProbDown8 P; P.G = C.G; P.c = C.bid; P.tb = moe_tb(C.lds); P.act = (const char*)(C.ws + WS_BIG + BG_ACT); P.w = (const char*)(C.ws + WS_WD + (size_t)64 * MiB); P.lw = WSP(float, WS_LIST + 4 * MiB); P.yb = WSP(bf16_t, WS_BIG + BG_YB); gm::gemm_phase8(C.lds, P); } SEAM(17);
    if (IN(18)) { moe_tables(C, 1); for (int rep = 0; rep < REPN(23); ++rep) combine_phase<true>(C, WSP(bf16_t, WS_S2), WSP(bf16_t, WS_BIG + BG_YB), nullptr, nullptr, C.out); }
#undef IN
#undef SEAM
}

extern "C" void kernel_launch(void* const* d_in, const int* in_sizes, int n_in, void* d_out, int out_size, void* d_ws, size_t ws_size, hipStream_t stream) {
    static int grid = 0;
    if (grid == 0) {
        if (n_in != 28 || out_size != T * D || ws_size < WS_END8) { fprintf(stderr, "kernel_launch: unexpected shapes: n_in %d out %d ws %zu (need %zu)\n", n_in, out_size, ws_size, (size_t)WS_END8); grid = -1; return; }
        int dev = 0, cus = 0, per_cu = 0;
        if (hipGetDevice(&dev) != hipSuccess || hipDeviceGetAttribute(&cus, hipDeviceAttributeMultiprocessorCount, dev) != hipSuccess) { grid = -1; return; }
        if (hipFuncSetAttribute((const void*)yoco_fwd, hipFuncAttributeMaxDynamicSharedMemorySize, LDS_BYTES) != hipSuccess) { fprintf(stderr, "kernel_launch: hipFuncSetAttribute failed\n"); grid = -1; return; }
        if (hipOccupancyMaxActiveBlocksPerMultiprocessor(&per_cu, (const void*)yoco_fwd, 512, LDS_BYTES) != hipSuccess || per_cu < 1) { fprintf(stderr, "kernel_launch: occupancy query says %d\n", per_cu); (void)hipGetLastError(); if (per_cu < 1) { grid = -1; return; } }
        grid = cus;
    }
    if (grid < 0) return;
    hipMemsetAsync((char*)d_ws + WS_CTL, 0, CTL_BYTES, stream);
    Args a{};
    for (int i = 0; i < 28; ++i) a.in[i] = d_in[i];
    a.out = (float*)d_out; a.ws = (unsigned char*)d_ws;
#if MK_N_LAUNCHES == 1
    a.ph_lo = 0; a.ph_hi = NPHASE;
    hipLaunchKernelGGL(yoco_fwd, dim3(grid), dim3(512), LDS_BYTES, stream, a);
#else
    for (int p = 0; p < NPHASE; ++p) { a.ph_lo = p; a.ph_hi = p + 1; hipLaunchKernelGGL(yoco_fwd, dim3(grid), dim3(512), LDS_BYTES, stream, a); }
#endif
}
```
